# Optimizing an MI355X kernel written in HIP

```python
import jax, jax.numpy as jnp
from jax import lax
import numpy as np

D_MODEL = 1024
BATCH = 4
SEQ = 4096
DEPTH = 4

CHUNK = 64
N_MIXERS = 2
FOX_HEADS = 16
FOX_HEAD_DIM = D_MODEL // FOX_HEADS
FOX_Q_BLOCK = 128
FOX_IN = 3 * D_MODEL + FOX_HEADS
GLA_HEADS = 4
GLA_KEY_DIM = D_MODEL // 2
GLA_VAL_DIM = D_MODEL
GLA_DK = GLA_KEY_DIM // GLA_HEADS
GLA_DV = GLA_VAL_DIM // GLA_HEADS
GLA_GATE_RANK = 16
GLA_GATE_TAU = 16.0
GLA_IN = 2 * GLA_KEY_DIM + GLA_VAL_DIM + GLA_GATE_RANK + GLA_VAL_DIM
D_FF = 4 * D_MODEL
EPS = 1e-6
N_FOX_LAYERS = (DEPTH + 1) // 2
N_GLA_LAYERS = DEPTH // 2

kernel_name = 'fox_gla_hybrid_trunk'


def rms_norm(x, g):
    xf = x.astype(jnp.float32)
    y = xf * lax.rsqrt(jnp.mean(xf * xf, axis=-1, keepdims=True) + EPS)
    return (y * g.astype(jnp.float32)).astype(x.dtype)


def fox_mixer(h, w_in, b_f, w_out):
    B, S, _ = h.shape
    H, HD, QB = FOX_HEADS, FOX_HEAD_DIM, FOX_Q_BLOCK
    proj = h @ w_in
    q, k, v, f_logit = jnp.split(proj, [D_MODEL, 2 * D_MODEL, 3 * D_MODEL], axis=-1)
    q = q.reshape(B, S, H, HD)
    k = k.reshape(B, S, H, HD)
    v = v.reshape(B, S, H, HD)
    log_f = jax.nn.log_sigmoid((f_logit + b_f).astype(jnp.float32))
    c = jnp.cumsum(log_f, axis=1).transpose(0, 2, 1)
    nqb = S // QB
    q_blocks = q.reshape(B, nqb, QB, H, HD).transpose(1, 0, 3, 2, 4)
    cq_blocks = c.reshape(B, H, nqb, QB).transpose(2, 0, 1, 3)
    t_blocks = jnp.arange(S).reshape(nqb, QB)
    k_pos = jnp.arange(S)
    scale = HD ** -0.5

    def block(args):
        qb, cqb, tb = args
        logits = jnp.einsum('bhqd,bshd->bhqs', qb, k).astype(jnp.float32) * scale
        logits = logits + cqb[..., :, None] - c[:, :, None, :]
        mask = k_pos[None, :] <= tb[:, None]
        logits = jnp.where(mask, logits, -jnp.inf)
        p = jax.nn.softmax(logits, axis=-1)
        return jnp.einsum('bhqs,bshd->bqhd', p.astype(v.dtype), v)

    o = lax.map(block, (q_blocks, cq_blocks, t_blocks))
    o = o.transpose(1, 0, 2, 3, 4).reshape(B, S, D_MODEL)
    return o @ w_out


def gla_mixer(h, w_in, w_gate_up, b_gate, g_norm, w_out):
    B, S, _ = h.shape
    H, DK, DV, C = GLA_HEADS, GLA_DK, GLA_DV, CHUNK
    n = S // C
    proj = h @ w_in
    splits = [GLA_KEY_DIM, 2 * GLA_KEY_DIM, 2 * GLA_KEY_DIM + GLA_VAL_DIM,
              2 * GLA_KEY_DIM + GLA_VAL_DIM + GLA_GATE_RANK]
    q, k, v, z_lr, r = jnp.split(proj, splits, axis=-1)
    g = jax.nn.log_sigmoid((z_lr @ w_gate_up + b_gate).astype(jnp.float32)) / GLA_GATE_TAU

    def to_chunks(t, d):
        return t.astype(jnp.float32).reshape(B, n, C, H, d).transpose(1, 0, 3, 2, 4)

    qc = to_chunks(q, DK) * (DK ** -0.5)
    kc = to_chunks(k, DK)
    vc = to_chunks(v, DV)
    bc = jnp.cumsum(to_chunks(g, DK), axis=3)
    causal = jnp.tril(jnp.ones((C, C), dtype=bool))

    def step(state, inp):
        qj, kj, vj, bj = inp
        diff = bj[:, :, :, None, :] - bj[:, :, None, :, :]
        decay = jnp.exp(jnp.where(causal[:, :, None], diff, -jnp.inf))
        attn = jnp.einsum('bhtk,bhsk,bhtsk->bhts', qj, kj, decay)
        o = jnp.einsum('bhts,bhsv->bhtv', attn, vj) + \
            jnp.einsum('bhtk,bhkv->bhtv', qj * jnp.exp(bj), state)
        b_last = bj[:, :, -1, :]
        k_dec = kj * jnp.exp(b_last[:, :, None, :] - bj)
        state = state * jnp.exp(b_last)[..., None] + jnp.einsum('bhsk,bhsv->bhkv', k_dec, vj)
        return state, o

    state0 = jnp.zeros((B, H, DK, DV), jnp.float32)
    _, o = lax.scan(step, state0, (qc, kc, vc, bc))
    o = o.transpose(1, 0, 3, 2, 4).reshape(B, S, H, DV)
    o = o * lax.rsqrt(jnp.mean(o * o, axis=-1, keepdims=True) + EPS) * g_norm.astype(jnp.float32)
    o = o * jax.nn.silu(r.astype(jnp.float32)).reshape(B, S, H, DV)
    return o.reshape(B, S, D_MODEL).astype(h.dtype) @ w_out


def sqrelu_mlp(h, w_up, w_down):
    return jnp.square(jax.nn.relu(h @ w_up)) @ w_down


def setup_inputs(seed: int = 0) -> dict:
    key = jax.random.key(seed)
    ks = jax.random.split(key, 14)
    D = D_MODEL
    nrm = jax.random.normal
    x = nrm(ks[0], (BATCH, SEQ, D), jnp.float32)
    fox_w_in = nrm(ks[1], (N_FOX_LAYERS, D, FOX_IN), jnp.float32) * D ** -0.5
    fox_b_f = jax.random.uniform(ks[2], (N_FOX_LAYERS, FOX_HEADS), jnp.float32, 0.0, 3.0)
    fox_w_out = nrm(ks[3], (N_FOX_LAYERS, D, D), jnp.float32) * D ** -0.5
    gla_w_in = nrm(ks[4], (N_GLA_LAYERS, D, GLA_IN), jnp.float32) * D ** -0.5
    gla_w_gate_up = nrm(ks[5], (N_GLA_LAYERS, GLA_GATE_RANK, GLA_KEY_DIM), jnp.float32) * GLA_GATE_RANK ** -0.5
    gla_b_gate = 0.1 * nrm(ks[6], (N_GLA_LAYERS, GLA_KEY_DIM), jnp.float32)
    gla_norm_g = 1.0 + 0.05 * nrm(ks[7], (N_GLA_LAYERS, GLA_DV), jnp.float32)
    gla_w_out = nrm(ks[8], (N_GLA_LAYERS, GLA_VAL_DIM, D), jnp.float32) * GLA_VAL_DIM ** -0.5
    mlp_w_up = nrm(ks[9], (DEPTH, D, D_FF), jnp.float32) * D ** -0.5
    mlp_w_down = nrm(ks[10], (DEPTH, D_FF, D), jnp.float32) * D_FF ** -0.5
    norm_mix_g = 1.0 + 0.05 * nrm(ks[11], (DEPTH, D), jnp.float32)
    norm_mlp_g = 1.0 + 0.05 * nrm(ks[12], (DEPTH, D), jnp.float32)
    norm_final_g = 1.0 + 0.05 * nrm(ks[13], (D,), jnp.float32)
    return {'x': x, 'fox_w_in': fox_w_in, 'fox_b_f': fox_b_f, 'fox_w_out': fox_w_out,
            'gla_w_in': gla_w_in, 'gla_w_gate_up': gla_w_gate_up, 'gla_b_gate': gla_b_gate,
            'gla_norm_g': gla_norm_g, 'gla_w_out': gla_w_out,
            'mlp_w_up': mlp_w_up, 'mlp_w_down': mlp_w_down,
            'norm_mix_g': norm_mix_g, 'norm_mlp_g': norm_mlp_g, 'norm_final_g': norm_final_g}


def reference(x, fox_w_in, fox_b_f, fox_w_out, gla_w_in, gla_w_gate_up, gla_b_gate,
              gla_norm_g, gla_w_out, mlp_w_up, mlp_w_down, norm_mix_g, norm_mlp_g,
              norm_final_g):
    h = x
    for i in range(DEPTH):
        j = i // N_MIXERS
        hn = rms_norm(h, norm_mix_g[i])
        if i % N_MIXERS == 0:
            h = h + fox_mixer(hn, fox_w_in[j], fox_b_f[j], fox_w_out[j])
        else:
            h = h + gla_mixer(hn, gla_w_in[j], gla_w_gate_up[j], gla_b_gate[j],
                              gla_norm_g[j], gla_w_out[j])
        h = h + sqrelu_mlp(rms_norm(h, norm_mlp_g[i]), mlp_w_up[i], mlp_w_down[i])
    return rms_norm(h, norm_final_g)
```

```cpp
#include <hip/hip_cooperative_groups.h>
#include <hip/hip_runtime.h>
#include <cstdio>
#include <cstdint>
namespace pg8 {
#define PG8_LAS __attribute__((address_space(3)))
typedef unsigned short bf16_t;
typedef short bf16x8 __attribute__((ext_vector_type(8)));
typedef float f32x4 __attribute__((ext_vector_type(4)));
typedef unsigned u32x4 __attribute__((ext_vector_type(4)));
constexpr int BM = 256, BK = 64, HALF = 128, HTB = HALF * BK * 2  , STAGE_BYTES = 8 * HTB, NXCD = 8, WGM = 8;

__host__ __device__ __forceinline__ int lds_byte(int r, int c) { const int st = (r >> 4) * 2 + (c >> 5), rr = r & 15, cc = c & 31, ob = rr * 64 + cc * 2; return st * 1024 + (ob ^ (((ob >> 9) & 1) << 5)); }
__host__ __device__ __forceinline__ void stage_rc(int b, int& R, int& C) { const int st = b / 1024, sb = b % 1024, swz = sb ^ (((sb >> 9) & 1) << 5); R = (st >> 1) * 16 + swz / 64; C = (st & 1) * 32 + (swz % 64) / 2; }
__host__ __device__ __forceinline__ int perm32(int rho) { const int n = rho >> 4, i = rho & 15; return 8 * (i >> 2) + 4 * n + (i & 3); }

struct Unit { int pm, pn; };
struct Gemm { const bf16_t* A; const bf16_t* Bt; int M, N, K; };

struct StaticOrder {
    int nM, nN, nwg, G, c;
    __host__ __device__ void init(int M, int N, int G_, int c_) { nM = M / BM; nN = N / BM; nwg = nM * nN; G = G_; c = c_; }
    __host__ __device__ bool next(int i, Unit& u) const {
        const long L = (long)i * G + c; if (L >= nwg) return false;
        int wgid = (int)L; { const int q = nwg / NXCD, r = nwg % NXCD, xcd = wgid % NXCD, off = wgid / NXCD; wgid = (xcd < r ? xcd * (q + 1) : r * (q + 1) + (xcd - r) * q) + off; }
        const int nig = WGM * nN, gid = wgid / nig, fm = gid * WGM, gsz = (nM - fm) < WGM ? (nM - fm) : WGM;
        u.pm = fm + ((wgid % nig) % gsz); u.pn = (wgid % nig) / gsz; return true;
    }
    __device__ __forceinline__ void a_ready(const Unit&) const {}
    __device__ __forceinline__ void done(const Unit&) const {}
};

__device__ __forceinline__ unsigned cvt_pk_bf16(float lo, float hi) { unsigned r; asm volatile("v_cvt_pk_bf16_f32 %0, %1, %2" : "=v"(r) : "v"(lo), "v"(hi)); return r; }
typedef float f32x2 __attribute__((ext_vector_type(2)));
typedef unsigned u32x2 __attribute__((ext_vector_type(2)));
__device__ __forceinline__ float row_rstd(const float* ssqp, int row) {
    const f32x4* p = (const f32x4*)(ssqp + (size_t)row * 16);
    const f32x4 a = p[0], b = p[1], c = p[2], d = p[3];
    const f32x4 s = (a + b) + (c + d);
    const float t = (s[0] + s[1]) + (s[2] + s[3]);
    return __builtin_amdgcn_rsqf(t * (1.0f / 1024.0f) + 1e-6f);
}
template <int ACT> struct EpiScaleBf16 {
    static constexpr bool PERM = true, AFTER_DRAIN = false;
    bf16_t* O; int ldc; const float* ssqp; int split_cols; size_t split_stride; float scale0;
    __device__ __forceinline__ void operator()(const f32x4 (&acc)[2][2][4][2], const Unit& u, int wr, int wc, int fr, int fq) const {
        const int row0 = u.pm * BM + wr * 64 + fr; int colt = u.pn * BM; bf16_t* base = O;
        float sc = 1.f; if (split_cols) { const int t = colt / split_cols; base += (size_t)t * split_stride; colt -= t * split_cols; if (t == 0) sc = scale0; }
        const int col0 = colt + wc * 32 + 8 * fq;
        f32x4 pq[2][4]; float rsv[2][4];
#pragma unroll
        for (int ai = 0; ai < 2; ++ai)
#pragma unroll
            for (int m = 0; m < 4; ++m) pq[ai][m] = *(const f32x4*)(ssqp + (size_t)(row0 + ai * HALF + m * 16) * 16 + 4 * fq);
#pragma unroll
        for (int ai = 0; ai < 2; ++ai)
#pragma unroll
            for (int m = 0; m < 4; ++m) { float t = (pq[ai][m][0] + pq[ai][m][1]) + (pq[ai][m][2] + pq[ai][m][3]); t += __shfl_xor(t, 16); t += __shfl_xor(t, 32);
                rsv[ai][m] = __builtin_amdgcn_rsqf(t * (1.0f / 1024.0f) + 1e-6f) * sc; }
#pragma unroll
        for (int ai = 0; ai < 2; ++ai)
#pragma unroll
            for (int m = 0; m < 4; ++m) { const int row = row0 + ai * HALF + m * 16; const float rs = rsv[ai][m]; bf16_t* rowp = base + (size_t)row * ldc + col0;
#pragma unroll
                for (int bj = 0; bj < 2; ++bj) { f32x4 v0 = acc[ai][bj][m][0] * rs, v1 = acc[ai][bj][m][1] * rs;
                    if (ACT == 2) {
#pragma unroll
                        for (int e = 0; e < 4; ++e) { const float a = __builtin_fmaxf(v0[e], 0.f), b = __builtin_fmaxf(v1[e], 0.f); v0[e] = a * a; v1[e] = b * b; } }
                    u32x4 w; w.x = cvt_pk_bf16(v0[0], v0[1]); w.y = cvt_pk_bf16(v0[2], v0[3]); w.z = cvt_pk_bf16(v1[0], v1[1]); w.w = cvt_pk_bf16(v1[2], v1[3]);
                    *(u32x4*)(rowp + bj * HALF) = w; } }
    }
};
struct EpiRes {
    static constexpr bool PERM = false, AFTER_DRAIN = false;
    const float* base; float* out; bf16_t* hb; float* ssqp; int ldc;
    __device__ __forceinline__ void operator()(const f32x4 (&acc)[2][2][4][2], const Unit& u, int wr, int wc, int fr, int fq) const {
        const int col0 = u.pn * BM + wc * 32 + 4 * fq;
#pragma unroll
        for (int ai = 0; ai < 2; ++ai)
#pragma unroll
            for (int m = 0; m < 4; ++m) { const int r = u.pm * BM + ai * HALF + wr * 64 + m * 16 + fr; const size_t off = (size_t)r * ldc + col0; float q = 0.f;
#pragma unroll
                for (int bj = 0; bj < 2; ++bj)
#pragma unroll
                    for (int n = 0; n < 2; ++n) { const f32x4 bs = *(const f32x4*)(base + off + bj * HALF + n * 16); const f32x4 o = bs + acc[ai][bj][m][n];
                        *(f32x4*)(out + off + bj * HALF + n * 16) = o; q += (o[0] * o[0] + o[1] * o[1]) + (o[2] * o[2] + o[3] * o[3]);
                        u32x2 w; w.x = cvt_pk_bf16(o[0], o[1]); w.y = cvt_pk_bf16(o[2], o[3]); *(u32x2*)(hb + off + bj * HALF + n * 16) = w; }
                q += __shfl_xor(q, 16); q += __shfl_xor(q, 32);
                if (fq == 0) ssqp[(size_t)r * 16 + u.pn * 4 + wc] = q;
                if (m & 1) asm volatile("" ::: "memory"); }
    }
};

template <class Epi, class Sched, bool ALIGN_EPI = false, bool SP2 = false>
__device__ __forceinline__ void gemm_phase(PG8_LAS unsigned char* lds, const Gemm g, const Sched& S, const Epi& E) {
    int tid = threadIdx.x; asm volatile("" : "+v"(tid)); const int wid = __builtin_amdgcn_readfirstlane(tid >> 6), lane = tid & 63, wr = wid >> 2, wc = wid & 3, fr = lane & 15, fq = lane >> 4;
    const int K = g.K, nt = K / BK;
    unsigned voffA[2], voffB[2];
#pragma unroll
    for (int i = 0; i < 2; ++i) { int R, C; stage_rc(tid * 16 + i * 8192, R, C); const int Rb = Epi::PERM ? ((R & ~31) + perm32(R & 31)) : R;
        voffA[i] = (unsigned)(R * K + C) * 2u; voffB[i] = (unsigned)(Rb * K + C) * 2u; }
    const size_t kstep = (size_t)(BK * 2);
    const size_t hstep = (size_t)HALF * K * 2;
    const size_t tstep = 2 * hstep;
    const unsigned ldsw = (unsigned)wid * 1024u;
    const int aoff = lds_byte(wr * 64 + fr, fq * 8), boff = lds_byte(wc * 32 + fr, fq * 8);
#define PG8_SA(b, h) (((b) * 2 + (h)) * HTB)
#define PG8_SB(b, h) ((4 + (b) * 2 + (h)) * HTB)
#define PG8_STAGE(bufoff, gbase, voff) do { _Pragma("unroll") for (int _i = 0; _i < 2; ++_i) \
        __builtin_amdgcn_global_load_lds((const unsigned*)((const char*)(gbase) + (voff)[_i]), (PG8_LAS unsigned*)(lds + (bufoff) + ldsw + _i * 8192), 16, 0, 0); } while (0)
#define PG8_LDA(dst, b, h) do { _Pragma("unroll") for (int m = 0; m < 4; ++m) _Pragma("unroll") for (int k = 0; k < 2; ++k) dst[m][k] = *(const PG8_LAS bf16x8*)(lds + PG8_SA(b, h) + aoff + m * 2048 + k * 1024); } while (0)
#define PG8_LDB(dst, b, h) do { _Pragma("unroll") for (int n = 0; n < 2; ++n) _Pragma("unroll") for (int k = 0; k < 2; ++k) dst[n][k] = *(const PG8_LAS bf16x8*)(lds + PG8_SB(b, h) + boff + n * 2048 + k * 1024); } while (0)
#define PG8_MMA(ai, bj, At, Bt) do { __builtin_amdgcn_s_setprio(1); _Pragma("unroll") for (int m = 0; m < 4; ++m) _Pragma("unroll") for (int n = 0; n < 2; ++n) _Pragma("unroll") for (int k = 0; k < 2; ++k) \
        acc[ai][bj][m][n] = __builtin_amdgcn_mfma_f32_16x16x32_bf16(Bt[n][k], At[m][k], acc[ai][bj][m][n], 0, 0, 0); __builtin_amdgcn_s_setprio(0); } while (0)
#define PG8_WAIT_V(n) asm volatile("s_waitcnt vmcnt(" #n ")" ::: "memory")
#define PG8_WAIT_L(n) asm volatile("s_waitcnt lgkmcnt(" #n ")" ::: "memory")
#define PG8_BAR __builtin_amdgcn_s_barrier()
#define PG8_SCHED __builtin_amdgcn_sched_barrier(0)
    Unit cur, nxt; int ui = 0;
    if (!S.next(0, cur)) return;
    f32x4 acc[2][2][4][2];
#pragma unroll
    for (int a = 0; a < 2; ++a)
#pragma unroll
        for (int b = 0; b < 2; ++b)
#pragma unroll
            for (int m = 0; m < 4; ++m)
#pragma unroll
                for (int n = 0; n < 2; ++n) acc[a][b][m][n] = (f32x4){0.f, 0.f, 0.f, 0.f};
    bf16x8 At[4][2], B0[2][2], B1[2][2];
    const char* cA = (const char*)g.A + (size_t)cur.pm * tstep; const char* cB = (const char*)g.Bt + (size_t)cur.pn * tstep;
    S.a_ready(cur);
    if constexpr (SP2) {
        PG8_STAGE(PG8_SB(0, 0), cB, voffB); PG8_STAGE(PG8_SB(0, 1), cB + hstep, voffB); PG8_STAGE(PG8_SA(0, 0), cA, voffA); PG8_STAGE(PG8_SA(0, 1), cA + hstep, voffA);
        if (wr == 1) PG8_BAR;
        PG8_WAIT_V(2); PG8_BAR;
        PG8_STAGE(PG8_SB(1, 0), cB + kstep, voffB); PG8_STAGE(PG8_SA(1, 0), cA + kstep, voffA); PG8_STAGE(PG8_SB(1, 1), cB + hstep + kstep, voffB);
        PG8_WAIT_V(6); PG8_BAR;
    } else {
        PG8_STAGE(PG8_SB(0, 0), cB, voffB); PG8_STAGE(PG8_SA(0, 0), cA, voffA); PG8_STAGE(PG8_SB(0, 1), cB + hstep, voffB); PG8_STAGE(PG8_SA(0, 1), cA + hstep, voffA);
        if (wr == 1) PG8_BAR;
        PG8_WAIT_V(4); PG8_BAR;
        PG8_STAGE(PG8_SB(1, 0), cB + kstep, voffB); PG8_STAGE(PG8_SA(1, 0), cA + kstep, voffA); PG8_STAGE(PG8_SB(1, 1), cB + hstep + kstep, voffB);
        PG8_WAIT_V(6); PG8_BAR;
    }
    for (;;) {
        const bool has_next = S.next(ui + 1, nxt);
        const char* nA = has_next ? (const char*)g.A + (size_t)nxt.pm * tstep : cA; const char* nB = has_next ? (const char*)g.Bt + (size_t)nxt.pn * tstep : cB;
        for (int t = 0; t < nt; t += 2) {
            const bool last = (t == nt - 2);
            const char* a1 = cA + (size_t)(t + 1) * kstep;
            const char* a2 = last ? nA : cA + (size_t)(t + 2) * kstep; const char* b2 = last ? nB : cB + (size_t)(t + 2) * kstep;
            const char* a3 = a2 + kstep; const char* b3 = b2 + kstep;
            if (last && has_next) S.a_ready(nxt);
            if constexpr (SP2) {
            PG8_LDB(B0, 0, 0); PG8_LDB(B1, 0, 1); PG8_SCHED; PG8_LDA(At, 0, 0); PG8_STAGE(PG8_SA(1, 1), a1 + hstep, voffA);
            PG8_WAIT_V(8); PG8_WAIT_L(0); PG8_BAR; PG8_MMA(0, 0, At, B0); PG8_MMA(0, 1, At, B1); PG8_BAR; PG8_SCHED;
            PG8_LDA(At, 0, 1); PG8_STAGE(PG8_SB(0, 0), b2, voffB); PG8_STAGE(PG8_SB(0, 1), b2 + hstep, voffB); PG8_STAGE(PG8_SA(0, 0), a2, voffA);
            PG8_WAIT_V(8); PG8_WAIT_L(0); PG8_BAR; PG8_MMA(1, 0, At, B0); PG8_MMA(1, 1, At, B1); PG8_BAR; PG8_SCHED;
            PG8_LDB(B0, 1, 0); PG8_LDB(B1, 1, 1); PG8_SCHED; PG8_LDA(At, 1, 0); PG8_STAGE(PG8_SA(0, 1), a2 + hstep, voffA);
            PG8_WAIT_V(8); PG8_WAIT_L(0); PG8_BAR; PG8_MMA(0, 0, At, B0); PG8_MMA(0, 1, At, B1); PG8_BAR; PG8_SCHED;
            PG8_LDA(At, 1, 1); PG8_STAGE(PG8_SB(1, 0), b3, voffB); PG8_STAGE(PG8_SB(1, 1), b3 + hstep, voffB); PG8_STAGE(PG8_SA(1, 0), a3, voffA);
            PG8_WAIT_V(8); PG8_WAIT_L(0); PG8_BAR; PG8_MMA(1, 0, At, B0); PG8_MMA(1, 1, At, B1); PG8_BAR; PG8_SCHED;
            } else {
            PG8_LDB(B0, 0, 0); PG8_SCHED; PG8_LDA(At, 0, 0); PG8_STAGE(PG8_SA(1, 1), a1 + hstep, voffA);
            PG8_WAIT_L(8); PG8_BAR; PG8_WAIT_L(0); PG8_MMA(0, 0, At, B0); PG8_BAR; PG8_SCHED;
            PG8_LDB(B1, 0, 1); PG8_STAGE(PG8_SB(0, 0), b2, voffB);
            PG8_BAR; PG8_WAIT_L(0); PG8_MMA(0, 1, At, B1); PG8_BAR;
            PG8_LDA(At, 0, 1); PG8_STAGE(PG8_SA(0, 0), a2, voffA);
            PG8_BAR; PG8_WAIT_L(0); PG8_MMA(1, 0, At, B0); PG8_BAR; PG8_SCHED;
            PG8_STAGE(PG8_SB(0, 1), b2 + hstep, voffB);
            PG8_WAIT_V(6); PG8_BAR; PG8_MMA(1, 1, At, B1); PG8_BAR;
            PG8_LDB(B0, 1, 0); PG8_SCHED; PG8_LDA(At, 1, 0); PG8_STAGE(PG8_SA(0, 1), a2 + hstep, voffA);
            PG8_WAIT_L(8); PG8_BAR; PG8_WAIT_L(0); PG8_MMA(0, 0, At, B0); PG8_BAR; PG8_SCHED;
            PG8_LDB(B1, 1, 1); PG8_STAGE(PG8_SB(1, 0), b3, voffB);
            PG8_BAR; PG8_WAIT_L(0); PG8_MMA(0, 1, At, B1); PG8_BAR;
            PG8_LDA(At, 1, 1); PG8_STAGE(PG8_SA(1, 0), a3, voffA);
            PG8_BAR; PG8_WAIT_L(0); PG8_MMA(1, 0, At, B0); PG8_BAR; PG8_SCHED;
            PG8_STAGE(PG8_SB(1, 1), b3 + hstep, voffB);
            PG8_WAIT_V(6); PG8_BAR; PG8_MMA(1, 1, At, B1); PG8_BAR;
            }
        }
        if constexpr (ALIGN_EPI) { if (wr == 0) PG8_BAR; }
        if constexpr (!Epi::AFTER_DRAIN) { E(acc, cur, wr, wc, fr, fq); S.done(cur); }
        if (!has_next) break;
#pragma unroll
        for (int a = 0; a < 2; ++a)
#pragma unroll
            for (int b = 0; b < 2; ++b)
#pragma unroll
                for (int m = 0; m < 4; ++m)
#pragma unroll
                    for (int n = 0; n < 2; ++n) acc[a][b][m][n] = (f32x4){0.f, 0.f, 0.f, 0.f};
        cur = nxt; cA = nA; cB = nB; ++ui;
        if constexpr (ALIGN_EPI) { if (wr == 1) PG8_BAR; }
    }
    PG8_WAIT_V(0);
    if constexpr (!ALIGN_EPI) { if (wr == 0) PG8_BAR; }
    PG8_BAR;
    if constexpr (Epi::AFTER_DRAIN) { E.fused(acc, cur, wr, wc, fr, fq, lds, wid, lane); S.done(cur); }
#undef PG8_SA
#undef PG8_SB
#undef PG8_STAGE
#undef PG8_LDA
#undef PG8_LDB
#undef PG8_MMA
#undef PG8_WAIT_V
#undef PG8_WAIT_L
#undef PG8_BAR
#undef PG8_SCHED
}
}

#ifndef PG8_SP2
#define PG8_SP2 true
#endif
#ifndef PG8_ALIGN
#define PG8_ALIGN true
#endif
#include <hip/hip_bf16.h>
#include <cmath>
namespace attn_body {
using bf16=__hip_bfloat16;
using bf16x8=__attribute__((ext_vector_type(8)))short;
using s16x4=__attribute__((ext_vector_type(4)))short;
using f32x16=__attribute__((ext_vector_type(16)))float;
using u32x4=__attribute__((ext_vector_type(4)))unsigned;
constexpr int BATCH=4,NHEAD=16,SEQ=4096,D=64,DM=NHEAD*D;
constexpr int NW=8,QBLK=32,QB=QBLK*NW,KVBLK=64,NQB=SEQ/QB;
constexpr int ATTN_PITCH=DM, ATTN_UNIT_ROWS=QB;
__device__ __forceinline__ int crow(int r,int hi){return (r&3)+8*(r>>2)+4*hi;}
#define SBAR() __builtin_amdgcn_sched_barrier(0)
__device__ __forceinline__ void cmask(f32x16&p0,f32x16&p1,int jb,int qrel,int hi){
  const float NEG=-INFINITY; int kb=64*jb+4*hi;
  #pragma unroll
  for(int r=0;r<16;++r){int kv=kb+(r&3)+8*(r>>2); if(kv>qrel)p0[r]=NEG; if(kv+32>qrel)p1[r]=NEG;}
}

constexpr int NSLOT=3, SLOTB=8192;
constexpr int LDS_K=0, LDS_V=NSLOT*SLOTB, LDS_WS=2*NSLOT*SLOTB, LDS_OST=LDS_WS+NW*64*4, LDS_BYTES=LDS_OST+NW*4096;
constexpr float C2=0.125f*1.4426950408889634f;
__device__ __forceinline__ void glds16(const void*gsrc,unsigned lds_dst){unsigned keep;
  asm volatile("s_mov_b32 %0, m0\n\ts_mov_b32 m0, %2\n\ts_nop 0\n\tglobal_load_lds_dwordx4 %1, off\n\ts_mov_b32 m0, %0":"=&s"(keep):"v"(gsrc),"s"(lds_dst):"memory");}
__device__ __forceinline__ float max3f(float a,float b,float c){float r;asm("v_max3_f32 %0, %1, %2, %3":"=v"(r):"v"(a),"v"(b),"v"(c));return r;}
__device__ __forceinline__ float max2f(float a,float b){float r;asm("v_max_f32_e32 %0, %1, %2":"=v"(r):"v"(a),"v"(b));return r;}
__device__ __forceinline__ float fadd_s(float a,float b){float r;asm("v_add_f32_e32 %0, %1, %2":"=v"(r):"v"(a),"v"(b));return r;}
__device__ __forceinline__ float fsub_s(float a,float b){float r;asm("v_sub_f32_e32 %0, %1, %2":"=v"(r):"v"(a),"v"(b));return r;}
typedef float f32x2_t __attribute__((ext_vector_type(2))); typedef __bf16 bf16x2_t __attribute__((ext_vector_type(2)));
__device__ __forceinline__ unsigned cvtpk_s(float lo,float hi){f32x2_t v={lo,hi};bf16x2_t b=__builtin_convertvector(v,bf16x2_t);return __builtin_bit_cast(unsigned,b);}
#define WAIT_BAR(N) asm volatile("s_waitcnt vmcnt(" #N ") lgkmcnt(0)\n\ts_barrier":::"memory")

__device__ __forceinline__ void qkt(f32x16&p0,f32x16&p1,const char*Kslot,const bf16x8*qr,int r32,int hi){
  const char*kb=Kslot+hi*1024+r32*16;
  #pragma unroll
  for(int d0=0;d0<4;++d0){
    const bf16x8 b0=*reinterpret_cast<const bf16x8*>(kb+d0*2048);
    const bf16x8 b1=*reinterpret_cast<const bf16x8*>(kb+d0*2048+512);
    {p0=__builtin_amdgcn_mfma_f32_32x32x16_bf16(b0,qr[d0],p0,0,0,0);p1=__builtin_amdgcn_mfma_f32_32x32x16_bf16(b1,qr[d0],p1,0,0,0);}}
}
typedef __attribute__((address_space(3))) const char* lds_cptr;
typedef short v4i16_t __attribute__((ext_vector_type(4)));
__device__ __forceinline__ void kload8(bf16x8*kf,lds_cptr kp){
  kf[0]=*(const __attribute__((address_space(3))) bf16x8*)(kp);      kf[1]=*(const __attribute__((address_space(3))) bf16x8*)(kp+512);
  kf[2]=*(const __attribute__((address_space(3))) bf16x8*)(kp+2048); kf[3]=*(const __attribute__((address_space(3))) bf16x8*)(kp+2560);
  kf[4]=*(const __attribute__((address_space(3))) bf16x8*)(kp+4096); kf[5]=*(const __attribute__((address_space(3))) bf16x8*)(kp+4608);
  kf[6]=*(const __attribute__((address_space(3))) bf16x8*)(kp+6144); kf[7]=*(const __attribute__((address_space(3))) bf16x8*)(kp+6656);
}
__device__ __forceinline__ void kload2(bf16x8*kf,lds_cptr kp,int j){ kf[2*j]=*(const __attribute__((address_space(3))) bf16x8*)(kp+j*2048); kf[2*j+1]=*(const __attribute__((address_space(3))) bf16x8*)(kp+j*2048+512); }
__device__ __forceinline__ s16x4 vtr(lds_cptr p){ return __builtin_bit_cast(s16x4,__builtin_amdgcn_ds_read_tr16_b64_v4i16((__attribute__((address_space(3))) v4i16_t*)p)); }
__device__ __forceinline__ float rowmax(const f32x16&p0,const f32x16&p1){
  float a=max3f(p0[0],p0[1],p1[0]),b=max3f(p0[2],p0[3],p1[1]);a=max3f(a,p1[2],p1[3]);
  #pragma unroll
  for(int r=4;r<16;r+=4){a=max3f(a,p0[r],p0[r+1]);b=max3f(b,p0[r+2],p0[r+3]);a=max3f(a,p1[r],p1[r+1]);b=max3f(b,p1[r+2],p1[r+3]);}
  const float m=max2f(a,b);
  auto rr=__builtin_amdgcn_permlane32_swap(__float_as_uint(m),__float_as_uint(m),false,false);
  return max2f(__uint_as_float(rr[0]),__uint_as_float(rr[1]));
}
__device__ __forceinline__ void pv(f32x16*o,int vb,bf16x8 pa0,bf16x8 pa1,bf16x8 pa2,bf16x8 pa3){
  #pragma unroll
  for(int d0=0;d0<2;++d0){s16x4 lo[4],hi[4];
    #pragma unroll
    for(int ks=0;ks<4;++ks){
      asm volatile("ds_read_b64_tr_b16 %0,%1 offset:%c2":"=&v"(lo[ks]):"v"(vb),"i"(d0*4096+ks*1024):"memory");
      asm volatile("ds_read_b64_tr_b16 %0,%1 offset:%c2":"=&v"(hi[ks]):"v"(vb),"i"(d0*4096+ks*1024+512):"memory");}
    asm volatile("s_waitcnt lgkmcnt(0)":::"memory");SBAR();
    #define PK(k) (bf16x8){lo[k][0],lo[k][1],lo[k][2],lo[k][3],hi[k][0],hi[k][1],hi[k][2],hi[k][3]}
    o[d0]=__builtin_amdgcn_mfma_f32_32x32x16_bf16(pa0,PK(0),o[d0],0,0,0);
    o[d0]=__builtin_amdgcn_mfma_f32_32x32x16_bf16(pa1,PK(1),o[d0],0,0,0);
    o[d0]=__builtin_amdgcn_mfma_f32_32x32x16_bf16(pa2,PK(2),o[d0],0,0,0);
    o[d0]=__builtin_amdgcn_mfma_f32_32x32x16_bf16(pa3,PK(3),o[d0],0,0,0);
    #undef PK
  }
}

#ifndef ATTN_STORE16
#define ATTN_STORE16(p,v) (*(u32x4*)(p)=(v))
#endif
typedef __attribute__((address_space(3))) const float* lds_cfptr;
typedef float f32x4a __attribute__((ext_vector_type(4)));
#define BIASINIT(C0,C1,t) do{ const lds_cfptr cb_=ckl+64*(t)+4*hi; \
    { f32x4a v_[4]; _Pragma("unroll") for(int j_=0;j_<4;++j_) v_[j_]=*(const __attribute__((address_space(3))) f32x4a*)(cb_+8*j_); \
      _Pragma("unroll") for(int j_=0;j_<4;++j_) _Pragma("unroll") for(int i_=0;i_<4;++i_) C0[4*j_+i_]=nm-v_[j_][i_]; } \
    SBAR(); \
    { f32x4a v_[4]; _Pragma("unroll") for(int j_=0;j_<4;++j_) v_[j_]=*(const __attribute__((address_space(3))) f32x4a*)(cb_+32+8*j_); \
      _Pragma("unroll") for(int j_=0;j_<4;++j_) _Pragma("unroll") for(int i_=0;i_<4;++i_) C1[4*j_+i_]=nm-v_[j_][i_]; } }while(0)
template<int THRL> __device__ __forceinline__ void attn_unit(int b,int h,int qb,const bf16*Q,const bf16*__restrict__ K,const bf16*__restrict__ V,bf16*O,char*shm,lds_cfptr ckl){
  int tid=threadIdx.x; asm volatile("":"+v"(tid)); const int lane=tid&63,r32=lane&31,hi=lane>>5; const int wid=__builtin_amdgcn_readfirstlane(tid>>6);
  const long rowbase=(long)b*SEQ; const int q0=qb*QB;
  const bf16*Qw=Q+(rowbase+q0+wid*QBLK)*DM+h*D;
  const bf16*Kh=K+rowbase*DM+h*D,*Vh=V+rowbase*DM+h*D;
  const unsigned lds0=(unsigned)(uintptr_t)shm;
  float*wsf=(float*)(shm+LDS_WS)+wid*64;
  const bf16*ksrc=Kh+(long)lane*DM+wid*8;
  const bf16*vsrc=Vh+(long)(16*(wid&3)+(lane>>2))*DM+(wid>>2)*32+(lane&3)*8;
  const unsigned kdst=lds0+LDS_K+wid*1024, vdst=lds0+LDS_V+wid*1024;
  #define DMA_K(t,slot) glds16(ksrc+(long)(t)*KVBLK*DM,(unsigned)__builtin_amdgcn_readfirstlane(kdst+(slot)))
  #define DMA_V(t,slot) glds16(vsrc+(long)(t)*KVBLK*DM,(unsigned)__builtin_amdgcn_readfirstlane(vdst+(slot)))
  const int vb0=(int)(lds0+LDS_V)+((lane>>4)&1)*32+(lane&3)*8+(4*hi+((lane&15)>>2))*64;
  const char*Kbase=shm+LDS_K; bf16x8 kf[8];
  const lds_cptr shm3=(lds_cptr)shm; const lds_cptr kp0=shm3+LDS_K+hi*1024+r32*16; const lds_cptr vp0=shm3+LDS_V+((lane>>4)&1)*32+(lane&3)*8+(4*hi+((lane&15)>>2))*64;
  const int NT=(q0+QB)/KVBLK;
  DMA_K(0,0);DMA_V(0,0);DMA_K(1,SLOTB);
  bf16x8 qr[4];
  #pragma unroll
  for(int d0=0;d0<4;++d0)qr[d0]=*reinterpret_cast<const bf16x8*>(&Qw[(long)r32*DM+d0*16+hi*8]);
  float mhat=0.f,l_reg=0.f;f32x16 o[2];o[0]=f32x16{};o[1]=f32x16{};
  const int qrel=wid*QBLK+r32; float nm=ckl[q0+qrel];
  #define CMASK(P0,P1,t) do{int jb_=(t)-(NT-4); if(jb_>=0)cmask(P0,P1,jb_,qrel,hi);}while(0)
  bool resc=false;
  #define START(P0,P1) do{ const float rm=rowmax(P0,P1); resc=false; \
    { const float dl=__builtin_fmaxf(rm,0.f); mhat=fadd_s(mhat,dl); nm=fsub_s(nm,dl); \
      _Pragma("unroll") for(int r=0;r<16;++r){P0[r]=fsub_s(P0[r],dl);P1[r]=fsub_s(P1[r],dl);} } \
    _Pragma("unroll") for(int r=0;r<16;++r)P0[r]=__builtin_amdgcn_exp2f(P0[r]); }while(0)
  #define RESC() do{ if(resc){ asm volatile("s_waitcnt lgkmcnt(0)":::"memory"); \
      _Pragma("unroll") for(int d_=0;d_<2;++d_) _Pragma("unroll") for(int r=0;r<16;++r)o[d_][r]*=wsf[crow(r,hi)]; } }while(0)
  f32x16 pA0,pA1,pB0,pB1;
  int sl_prev=0,sl_cur=0,sl_next=SLOTB;
  #define ROT() do{sl_prev=sl_cur;sl_cur=sl_next;sl_next=(sl_next==(NSLOT-1)*SLOTB)?0:sl_next+SLOTB;}while(0)
  DMA_K(2,2*SLOTB);
  WAIT_BAR(3);
  BIASINIT(pA0,pA1,0); qkt(pA0,pA1,Kbase,qr,r32,hi);asm volatile("s_nop 15\n\ts_nop 7":"+v"(pA0),"+v"(pA1));CMASK(pA0,pA1,0);
  START(pA0,pA1);
  _Pragma("unroll") for(int r=0;r<16;++r)pA1[r]=__builtin_amdgcn_exp2f(pA1[r]);
  WAIT_BAR(0);
  DMA_K(3,0);DMA_V(1,SLOTB);
  ROT();
  kload8(kf,kp0+sl_cur);
  WAIT_BAR(2);
  s16x4 vlo[8],vhi[8]; u32x4 pw0,pw1,pw2,pw3;
  #define PKW(P,B) cvtpk_s(P[B],P[B+1])
  #define PAF(k) __builtin_bit_cast(bf16x8,pw##k)
  #define VFR(i) (bf16x8){vlo[i][0],vlo[i][1],vlo[i][2],vlo[i][3],vhi[i][0],vhi[i][1],vhi[i][2],vhi[i][3]}
  #define PIN(x) asm volatile("":"+v"(x))
  #define MX3(a,b,c) __builtin_fmaxf(__builtin_fmaxf((a),(b)),(c))
  #define GAPA(MF,A0,A1,A2,A3,W0,W1,PW) do{ MF; sacc+=A0; sacc+=A1; sacc+=A2; sacc+=A3; PIN(sacc); W0; W1; PIN(PW); SBAR(); }while(0)
  #define EX(v) __builtin_amdgcn_exp2f(v)
  #define GAPB(MF,X,B) do{ MF; X[B]=EX(X[B]); X[B+1]=EX(X[B+1]); X[B+2]=EX(X[B+2]); X[B+3]=EX(X[B+3]); PIN(X); SBAR(); }while(0)
  #define VRD(i) do{ vlo[i]=vtr(vp_+(((i)>>2)*4096+((i)&3)*1024)); vhi[i]=vtr(vp_+(((i)>>2)*4096+((i)&3)*1024+512)); }while(0)
  #define KRD(G,j) do{ if(G){ kload2(kf,kp0+sl_next,j); SBAR(); } }while(0)
  #define STEP(C0,C1,P0,P1,t,GK,GV,GL) do{ SBAR(); \
    BIASINIT(C0,C1,t); SBAR(); \
    const lds_cptr vp_=vp0+sl_prev; \
    VRD(0); SBAR(); float sacc=(P0[0]+P0[1]); \
    GAPA(C0=__builtin_amdgcn_mfma_f32_32x32x16_bf16(kf[0],qr[0],C0,0,0,0), P0[2],P0[3],P0[4],P0[5],     pw0[0]=PKW(P0,0), pw0[1]=PKW(P0,2), pw0); \
    VRD(4); SBAR(); GAPA(C1=__builtin_amdgcn_mfma_f32_32x32x16_bf16(kf[1],qr[0],C1,0,0,0), P0[6],P0[7],P0[8],P0[9],     pw0[2]=PKW(P0,4), pw0[3]=PKW(P0,6), pw0); \
    VRD(1); SBAR(); GAPA(C0=__builtin_amdgcn_mfma_f32_32x32x16_bf16(kf[2],qr[1],C0,0,0,0),   P0[10],P0[11],P0[12],P0[13], pw1[0]=PKW(P0,8), pw1[1]=PKW(P0,10), pw1); \
    VRD(5); SBAR(); GAPA(C1=__builtin_amdgcn_mfma_f32_32x32x16_bf16(kf[3],qr[1],C1,0,0,0),   P0[14],P0[15],P1[0],P1[1],   pw1[2]=PKW(P0,12),pw1[3]=PKW(P0,14), pw1); \
    VRD(2); SBAR(); GAPA(C0=__builtin_amdgcn_mfma_f32_32x32x16_bf16(kf[4],qr[2],C0,0,0,0),   P1[2],P1[3],P1[4],P1[5],     pw2[0]=PKW(P1,0), pw2[1]=PKW(P1,2), pw2); \
    VRD(6); SBAR(); GAPA(C1=__builtin_amdgcn_mfma_f32_32x32x16_bf16(kf[5],qr[2],C1,0,0,0),   P1[6],P1[7],P1[8],P1[9],     pw2[2]=PKW(P1,4), pw2[3]=PKW(P1,6), pw2); \
    VRD(3); SBAR(); GAPA(C0=__builtin_amdgcn_mfma_f32_32x32x16_bf16(kf[6],qr[3],C0,0,0,0),   P1[10],P1[11],P1[12],P1[13], pw3[0]=PKW(P1,8), pw3[1]=PKW(P1,10), pw3); \
    VRD(7); SBAR(); GAPA(C1=__builtin_amdgcn_mfma_f32_32x32x16_bf16(kf[7],qr[3],C1,0,0,0),   P1[14],P1[15],0.f,0.f,       pw3[2]=PKW(P1,12),pw3[3]=PKW(P1,14), pw3); \
    l_reg+=sacc; \
    if(GK){DMA_K((t)+3,sl_cur);} if(GV){DMA_V((t)+1,sl_next);} \
    CMASK(C0,C1,t); \
    { float a=MX3(C0[0],C0[1],C1[0]),b=MX3(C0[2],C0[3],C1[1]); a=MX3(a,C1[2],C1[3]); \
      _Pragma("unroll") for(int r=4;r<16;r+=4){a=MX3(a,C0[r],C0[r+1]);b=MX3(b,C0[r+2],C0[r+3]);a=MX3(a,C1[r],C1[r+1]);b=MX3(b,C1[r+2],C1[r+3]);} \
      float rm=__builtin_fmaxf(a,b); { auto rr=__builtin_amdgcn_permlane32_swap(__float_as_uint(rm),__float_as_uint(rm),false,false); rm=__builtin_fmaxf(__uint_as_float(rr[0]),__uint_as_float(rr[1])); } \
      resc=false; \
      if(__builtin_expect(__any(rm>(float)THRL),0)){ const float dl=__builtin_fmaxf(rm,0.f); mhat+=dl; nm-=dl; \
        _Pragma("unroll") for(int r=0;r<16;++r){C0[r]-=dl;C1[r]-=dl;} \
        const float f=__builtin_amdgcn_exp2f(-dl); l_reg*=f; if(hi==0)wsf[r32]=f; resc=true; } } \
    SBAR(); \
    GAPB(o[0]=__builtin_amdgcn_mfma_f32_32x32x16_bf16(PAF(0),VFR(0),o[0],0,0,0), C0,0); \
    GAPB(o[1]=__builtin_amdgcn_mfma_f32_32x32x16_bf16(PAF(0),VFR(4),o[1],0,0,0), C0,4); \
    KRD(GL,0); GAPB(o[0]=__builtin_amdgcn_mfma_f32_32x32x16_bf16(PAF(1),VFR(1),o[0],0,0,0), C0,8); \
    KRD(GL,1); GAPB(o[1]=__builtin_amdgcn_mfma_f32_32x32x16_bf16(PAF(1),VFR(5),o[1],0,0,0), C0,12); \
    KRD(GL,2); GAPB(o[0]=__builtin_amdgcn_mfma_f32_32x32x16_bf16(PAF(2),VFR(2),o[0],0,0,0), C1,0); \
    KRD(GL,3); GAPB(o[1]=__builtin_amdgcn_mfma_f32_32x32x16_bf16(PAF(2),VFR(6),o[1],0,0,0), C1,4); \
    GAPB(o[0]=__builtin_amdgcn_mfma_f32_32x32x16_bf16(PAF(3),VFR(3),o[0],0,0,0), C1,8); \
    GAPB(o[1]=__builtin_amdgcn_mfma_f32_32x32x16_bf16(PAF(3),VFR(7),o[1],0,0,0), C1,12); \
    }while(0)
  int t=1;
  #undef CMASK
  #define CMASK(P0,P1,t) do{}while(0)
  for(;t+5<NT;t+=2){
    STEP(pB0,pB1,pA0,pA1,t,true,true,true);     WAIT_BAR(2); RESC(); ROT();
    STEP(pA0,pA1,pB0,pB1,t+1,true,true,true);   WAIT_BAR(2); RESC(); ROT();
  }
  #undef CMASK
  #define CMASK(P0,P1,t) do{int jb_=(t)-(NT-4); if(jb_>=0)cmask(P0,P1,jb_,qrel,hi);}while(0)
  #define ENDW(tt) do{ if((tt)+3<NT){WAIT_BAR(2);} else if((tt)+2<NT){WAIT_BAR(1);} else {WAIT_BAR(0);} }while(0)
  for(;t+1<NT;t+=2){
    STEP(pB0,pB1,pA0,pA1,t,(t+3<NT),(t+1<NT),(t+1<NT));       ENDW(t);   RESC(); ROT();
    STEP(pA0,pA1,pB0,pB1,t+1,(t+4<NT),(t+2<NT),(t+2<NT));     ENDW(t+1); RESC(); ROT();
  }
  STEP(pB0,pB1,pA0,pA1,NT-1,false,false,false); RESC();
  { float sacc=pB0[0]+pB0[1]; _Pragma("unroll") for(int r=2;r<16;++r)sacc+=pB0[r]; _Pragma("unroll") for(int r=0;r<16;++r)sacc+=pB1[r]; l_reg+=sacc;
    pw0=(u32x4){PKW(pB0,0),PKW(pB0,2),PKW(pB0,4),PKW(pB0,6)};pw1=(u32x4){PKW(pB0,8),PKW(pB0,10),PKW(pB0,12),PKW(pB0,14)};pw2=(u32x4){PKW(pB1,0),PKW(pB1,2),PKW(pB1,4),PKW(pB1,6)};pw3=(u32x4){PKW(pB1,8),PKW(pB1,10),PKW(pB1,12),PKW(pB1,14)};
    SBAR(); pv(o,vb0+sl_cur,PAF(0),PAF(1),PAF(2),PAF(3)); }
  #undef PKW
  #undef PAF
  #undef VFR
  #undef PIN
  #undef MX3
  #undef GAPA
  #undef GAPB
  #undef EX
  #undef VRD
  #undef KRD
  #undef STEP
  #undef ENDW
  {auto rr=__builtin_amdgcn_permlane32_swap(__float_as_uint(l_reg),__float_as_uint(l_reg),false,false);l_reg=__uint_as_float(rr[0])+__uint_as_float(rr[1]);}
  if(hi==0)wsf[32+r32]=l_reg;asm volatile("s_waitcnt lgkmcnt(0)":::"memory");
  float rli[16];
  #pragma unroll
  for(int r=0;r<16;++r)rli[r]=__builtin_amdgcn_rcpf(wsf[32+crow(r,hi)]);
  bf16*Ow=O+(rowbase+q0+wid*QBLK)*DM+h*D;
  { bf16*stg=(bf16*)(shm+LDS_OST)+wid*2048;
    #pragma unroll
    for(int r=0;r<16;++r){const int orow=crow(r,hi);
      #pragma unroll
      for(int d0=0;d0<2;++d0)stg[orow*64+d0*32+r32]=__float2bfloat16(o[d0][r]*rli[r]);}
    asm volatile("s_waitcnt lgkmcnt(0)":::"memory");
    #pragma unroll
    for(int i=0;i<4;++i){const int row=i*8+(lane>>3),ch=lane&7; const u32x4 v=*(const u32x4*)(stg+row*64+ch*8); ATTN_STORE16(Ow+(long)row*DM+ch*8,v);} }
  asm volatile("s_waitcnt lgkmcnt(0)\n\ts_barrier":::"memory");
  #undef DMA_K
  #undef DMA_V
  #undef CMASK
  #undef START
  #undef RESC
  #undef ROT
}
constexpr int ATTN_LDS_BYTES=LDS_BYTES;
struct AttnTensors { const bf16* Q; const bf16* K; const bf16* V; bf16* O; };
struct AttnUnit { int bh; int qb; };
#undef BIASINIT
#undef SBAR
#undef WAIT_BAR
}
namespace cg = cooperative_groups;
constexpr int NWAVES = 8;
constexpr int BATCH = 4, SEQ = 4096, D = 1024, M = BATCH * SEQ, FF = 4096, DEPTH = 4, NIN = 3072, WIN_LD = 3088;
constexpr int N_PHASES = 26;
#ifndef MK_ONE_LAUNCH
#define MK_ONE_LAUNCH 1
#endif
constexpr size_t MiB = 1u << 20;
constexpr size_t WS_SSQ = 0;
constexpr size_t WS_SMALL = 1 * MiB;
constexpr size_t WS_EB = 2 * MiB;
constexpr size_t WS_W = 4 * MiB, W_STRIDE = 25 * MiB;
constexpr size_t W_IN = 0, W_SM = 6 * MiB, W_O = 7 * MiB, W_UP = 9 * MiB, W_DN = 17 * MiB;
constexpr size_t WS_HB = 54 * MiB;
constexpr size_t WS_Q = 86 * MiB, WS_K = 118 * MiB, WS_V = 150 * MiB, WS_LS = 182 * MiB;
constexpr size_t WS_U = 86 * MiB;
constexpr size_t WS_END = 246 * MiB;
constexpr int LDS_BYTES = 147456;
constexpr int CKL_OFF = 86016;
static_assert(attn_body::ATTN_LDS_BYTES <= CKL_OFF && CKL_OFF + 16384 <= 131072, "LDS map");

#define LAS __attribute__((address_space(3)))
typedef unsigned short bf16;
typedef unsigned v4u __attribute__((ext_vector_type(4)));
typedef unsigned v2u __attribute__((ext_vector_type(2)));
typedef float f32x4 __attribute__((ext_vector_type(4)));
typedef short bf16x8 __attribute__((ext_vector_type(8)));
#define LDS_WAIT() asm volatile("s_waitcnt lgkmcnt(0)" ::: "memory")
__device__ __forceinline__ unsigned pk2(float lo, float hi) { return pg8::cvt_pk_bf16(lo, hi); }
__device__ __forceinline__ float bf2f(unsigned short v) { return __uint_as_float((unsigned)v << 16); }
__device__ __forceinline__ float bflo(unsigned w) { return __uint_as_float(w << 16); }
__device__ __forceinline__ float bfhi(unsigned w) { return __uint_as_float(w & 0xffff0000u); }
__device__ __forceinline__ float log_sigmoid(float x) { return __builtin_fminf(x, 0.f) - log1pf(__expf(-__builtin_fabsf(x))); }
__device__ __forceinline__ float wave_sum(float v) {
#pragma unroll
    for (int o = 1; o < 64; o <<= 1) v += __shfl_xor(v, o);
    return v;
}

struct Args { const float* in[14]; float* out; unsigned char* ws; int ph_lo, ph_hi; };

__device__ __forceinline__ void transpose_item(const float* W, int ldw, int src_col0, const float* gain, bf16* WT, int K, int dst_row0, int nblk, LAS float* scr, int item, int lane) {
    const int kb = item / nblk, nb = item % nblk, k0 = 64 * kb, n0 = 32 * nb;
#pragma unroll 8
    for (int i = 0; i < 32; ++i) { const int kk = 2 * i + (lane >> 5); float w = W[(size_t)(k0 + kk) * ldw + src_col0 + n0 + (lane & 31)]; if (gain) w *= gain[k0 + kk]; scr[kk * 33 + (lane & 31)] = w; }
    LDS_WAIT(); asm volatile("" ::: "memory");
    const int c = lane & 7;
#pragma unroll
    for (int j = 0; j < 4; ++j) { const int n = (lane >> 3) + 8 * j; const LAS float* s = scr + (8 * c) * 33 + n;
        v4u o; o.x = pk2(s[0 * 33], s[1 * 33]); o.y = pk2(s[2 * 33], s[3 * 33]); o.z = pk2(s[4 * 33], s[5 * 33]); o.w = pk2(s[6 * 33], s[7 * 33]);
        *(v4u*)(WT + (size_t)(dst_row0 + n0 + n) * K + k0 + 8 * c) = o; }
    LDS_WAIT(); asm volatile("" ::: "memory");
}

__device__ __forceinline__ void convert_layer_weights(const Args& a, int L, LAS unsigned char* lds, int gw, int NGW, int wave, int lane) {
    LAS float* scr = (LAS float*)(lds + wave * 16384);
    unsigned char* wb = a.ws + WS_W + (size_t)(L & 1) * W_STRIDE;
    const int j = L >> 1; const bool fox = (L & 1) == 0;
    const float* Win = (fox ? a.in[1] : a.in[4]) + (size_t)j * D * WIN_LD;
    const float* Wo = (fox ? a.in[3] : a.in[8]) + (size_t)j * D * D;
    const float* Wup = a.in[9] + (size_t)L * D * FF; const float* Wdn = a.in[10] + (size_t)L * FF * D;
    const float* gmix = a.in[11] + L * D; const float* gmlp = a.in[12] + L * D;
    const int colB = fox ? 2048 : 2064, colS = fox ? 3072 : 2048;
    constexpr int I_A = 16 * 64, I_B = 16 * 32, I_O = 16 * 32, I_U = 16 * 128, I_D = 64 * 32, NITEMS = I_A + I_B + I_O + I_U + I_D;
    for (int it = gw; it < NITEMS; it += NGW) {
        int r = it;
        if (r < I_A) { transpose_item(Win, WIN_LD, 0, gmix, (bf16*)(wb + W_IN), D, 0, 64, scr, r, lane); continue; } r -= I_A;
        if (r < I_B) { transpose_item(Win, WIN_LD, colB, gmix, (bf16*)(wb + W_IN), D, 2048, 32, scr, r, lane); continue; } r -= I_B;
        if (r < I_O) { transpose_item(Wo, D, 0, nullptr, (bf16*)(wb + W_O), D, 0, 32, scr, r, lane); continue; } r -= I_O;
        if (r < I_U) { transpose_item(Wup, FF, 0, gmlp, (bf16*)(wb + W_UP), D, 0, 128, scr, r, lane); continue; } r -= I_U;
        transpose_item(Wdn, D, 0, nullptr, (bf16*)(wb + W_DN), FF, 0, 32, scr, r, lane);
    }
    bf16* wsm = (bf16*)(wb + W_SM);
    for (int e = gw * 64 + lane; e < 16 * D; e += NGW * 64) { const int k = e >> 4, n = e & 15; wsm[n * D + k] = (bf16)(pk2(Win[(size_t)k * WIN_LD + colS + n] * gmix[k], 0.f) & 0xffffu); }
}

namespace gla {
constexpr int H = 4, DK = 128, DV = 256, C = 64, NCH = SEQ / C;
constexpr int VT_LD = 72, KT_LD = 72, QT_LD = 136;
__device__ __forceinline__ f32x4 mfma16(bf16x8 a, bf16x8 b, f32x4 c) { return __builtin_amdgcn_mfma_f32_16x16x32_bf16(a, b, c, 0, 0, 0); }
__device__ __forceinline__ void stage_vT(const bf16* vsrc, LAS bf16* VT, int tid) {
#pragma unroll
    for (int c = 0; c < 4; ++c) { const int idx = tid + 512 * c, t = idx >> 5, d8 = idx & 31; const v4u w = *(const v4u*)(vsrc + (size_t)t * 1024 + d8 * 8);
        LAS bf16* p = VT + (d8 * 8) * VT_LD + t;
        p[0 * VT_LD] = (bf16)(w.x & 0xffffu); p[1 * VT_LD] = (bf16)(w.x >> 16); p[2 * VT_LD] = (bf16)(w.y & 0xffffu); p[3 * VT_LD] = (bf16)(w.y >> 16);
        p[4 * VT_LD] = (bf16)(w.z & 0xffffu); p[5 * VT_LD] = (bf16)(w.z >> 16); p[6 * VT_LD] = (bf16)(w.w & 0xffffu); p[7 * VT_LD] = (bf16)(w.w >> 16); }
}
__device__ __forceinline__ void g1_unit(int u, bf16* QK, const bf16* V, const float* zlr, const float* wg, const float* bg, bf16* LS, float* EB, LAS unsigned char* lds, int tid, int wave, int lane) {
    const int b = u >> 8, j = (u >> 2) & 63, h = u & 3, lsid = (b * 4 + h) * 64 + j; const size_t tok0 = (size_t)b * SEQ + 64 * j;
    LAS bf16* KT = (LAS bf16*)lds; LAS bf16* VT = (LAS bf16*)(lds + 18432); LAS float* ZL = (LAS float*)(lds + 55296); LAS float* TOT = (LAS float*)(lds + 59392); LAS float* EBL = (LAS float*)(lds + 61440);
    const int d = tid & 127, tq = tid >> 7;
    if (tid < 256) ((LAS f32x4*)ZL)[tid] = ((const f32x4*)(zlr + tok0 * 16))[tid];
    float w[16];
#pragma unroll
    for (int r = 0; r < 16; ++r) w[r] = wg[r * 512 + h * 128 + d];
    const float bgd = bg[h * 128 + d];
    stage_vT(V + tok0 * 1024 + h * 256, VT, tid);
    __syncthreads();
    float bc[16]; float run = 0.f;
#pragma unroll
    for (int i = 0; i < 16; ++i) { const int t = 16 * tq + i; float z = bgd;
#pragma unroll
        for (int r4 = 0; r4 < 4; ++r4) { const f32x4 zz = ((const LAS f32x4*)ZL)[t * 4 + r4]; z += zz[0] * w[4 * r4] + zz[1] * w[4 * r4 + 1] + zz[2] * w[4 * r4 + 2] + zz[3] * w[4 * r4 + 3]; }
        run += log_sigmoid(z) * (1.0f / 16.0f); bc[i] = run; }
    TOT[tq * 128 + d] = run;
    __syncthreads();
    float pre = 0.f, blast = 0.f;
#pragma unroll
    for (int q = 0; q < 4; ++q) { const float tv = TOT[q * 128 + d]; if (q < tq) pre += tv; blast += tv; }
    const float eblast = __expf(blast);
    if (tq == 0) { EB[(size_t)lsid * 128 + d] = eblast; EBL[d] = eblast; }
    unsigned kpk[8];
    bf16* qp = QK + tok0 * 1024 + h * 128 + d;
#pragma unroll
    for (int i = 0; i < 16; i += 2) {
        float kt2[2];
#pragma unroll
        for (int e = 0; e < 2; ++e) { const int t = 16 * tq + i + e; const float bb = bc[i + e] + pre; const float eb = __expf(bb);
            const float qv = bf2f(qp[(size_t)t * 1024]), kv = bf2f(qp[(size_t)t * 1024 + 512]);
            const float qt = qv * eb * 0.08838834764831845f, kt = kv * __builtin_amdgcn_rcpf(eb);
            const unsigned pq = pk2(qt, kt); qp[(size_t)t * 1024] = (bf16)(pq & 0xffffu); qp[(size_t)t * 1024 + 512] = (bf16)(pq >> 16); kt2[e] = kt; }
        kpk[i >> 1] = pk2(kt2[0], kt2[1]); }
    { LAS v4u* kd = (LAS v4u*)(KT + d * KT_LD + 16 * tq); kd[0] = (v4u){kpk[0], kpk[1], kpk[2], kpk[3]}; kd[1] = (v4u){kpk[4], kpk[5], kpk[6], kpk[7]}; }
    __syncthreads();
    const int fr = lane & 15, fq = lane >> 4;
    f32x4 acc[2][8];
#pragma unroll
    for (int mt = 0; mt < 2; ++mt)
#pragma unroll
        for (int nt = 0; nt < 8; ++nt) acc[mt][nt] = (f32x4){0.f, 0.f, 0.f, 0.f};
#pragma unroll
    for (int ks = 0; ks < 2; ++ks) { bf16x8 vf[2];
#pragma unroll
        for (int mt = 0; mt < 2; ++mt) vf[mt] = *(const LAS bf16x8*)(VT + (32 * wave + 16 * mt + fr) * VT_LD + ks * 32 + fq * 8);
#pragma unroll
        for (int nt = 0; nt < 8; ++nt) { const bf16x8 kf = *(const LAS bf16x8*)(KT + (16 * nt + fr) * KT_LD + ks * 32 + fq * 8);
#pragma unroll
            for (int mt = 0; mt < 2; ++mt) acc[mt][nt] = mfma16(kf, vf[mt], acc[mt][nt]); } }
    bf16* lsp = LS + (size_t)lsid * 32768;
#pragma unroll
    for (int nt = 0; nt < 8; ++nt) { const f32x4 e4 = *(const LAS f32x4*)(EBL + 16 * nt + 4 * fq);
#pragma unroll
        for (int mt = 0; mt < 2; ++mt) { const f32x4 v = acc[mt][nt] * e4; v2u o; o.x = pk2(v[0], v[1]); o.y = pk2(v[2], v[3]);
            *(v2u*)(lsp + (size_t)(32 * wave + 16 * mt + fr) * 128 + 16 * nt + 4 * fq) = o; } }
    __syncthreads();
}
__device__ __forceinline__ void g2_scan(bf16* LS, const float* EB, int gtid, int nthreads) {
    for (int e = gtid; e < 16 * 8192; e += nthreads) { const int bh = e >> 13, off = (e & 8191) * 4;
        bf16* base = LS + (size_t)bh * 64 * 32768 + off; const float* ebp = EB + (size_t)bh * 64 * 128 + (off & 127);
        f32x4 S = (f32x4){0.f, 0.f, 0.f, 0.f};
#pragma unroll 9
        for (int j = 0; j < 63; ++j) { const v2u l = *(const v2u*)(base + (size_t)j * 32768); const f32x4 a = *(const f32x4*)(ebp + j * 128);
            S[0] = a[0] * S[0] + bflo(l.x); S[1] = a[1] * S[1] + bfhi(l.x); S[2] = a[2] * S[2] + bflo(l.y); S[3] = a[3] * S[3] + bfhi(l.y);
            v2u o; o.x = pk2(S[0], S[1]); o.y = pk2(S[2], S[3]); *(v2u*)(base + (size_t)j * 32768) = o; } }
}
__device__ __forceinline__ void g3_unit(int u, const bf16* QK, const bf16* V, bf16* R, const bf16* LS, const float* gnorm, LAS unsigned char* lds, int tid, int wave, int lane) {
    const int b = u >> 8, j = (u >> 2) & 63, h = u & 3, lsid = (b * 4 + h) * 64 + j; const size_t tok0 = (size_t)b * SEQ + 64 * j;
    LAS bf16* QT = (LAS bf16*)lds; LAS bf16* KT = (LAS bf16*)(lds + 17408); LAS bf16* VT = (LAS bf16*)(lds + 34816); LAS bf16* AT = (LAS bf16*)(lds + 71680); LAS float* RS = (LAS float*)(lds + 80896);
#pragma unroll
    for (int c = 0; c < 2; ++c) { const int idx = tid + 512 * c, t = idx >> 4, c8 = idx & 15; const bf16* src = QK + (tok0 + t) * 1024 + h * 128 + c8 * 8;
        *(LAS v4u*)(QT + t * QT_LD + c8 * 8) = *(const v4u*)src; *(LAS v4u*)(KT + t * QT_LD + c8 * 8) = *(const v4u*)(src + 512); }
    stage_vT(V + tok0 * 1024 + h * 256, VT, tid);
    __syncthreads();
    const int fr = lane & 15, fq = lane >> 4, tm = wave >> 1, hh = wave & 1;
#pragma unroll
    for (int e = 0; e < 2; ++e) { const int sn = 2 * hh + e; f32x4 a = (f32x4){0.f, 0.f, 0.f, 0.f};
        if (sn <= tm) {
#pragma unroll
            for (int ks = 0; ks < 4; ++ks) { const bf16x8 qf = *(const LAS bf16x8*)(QT + (16 * tm + fr) * QT_LD + ks * 32 + fq * 8); const bf16x8 kf = *(const LAS bf16x8*)(KT + (16 * sn + fr) * QT_LD + ks * 32 + fq * 8);
                a = mfma16(kf, qf, a); }
#pragma unroll
            for (int i = 0; i < 4; ++i) if (16 * sn + 4 * fq + i > 16 * tm + fr) a[i] = 0.f; }
        v2u o; o.x = pk2(a[0], a[1]); o.y = pk2(a[2], a[3]); *(LAS v2u*)(AT + (16 * tm + fr) * VT_LD + 16 * sn + 4 * fq) = o; }
    __syncthreads();
    f32x4 acc[8];
#pragma unroll
    for (int nt = 0; nt < 8; ++nt) acc[nt] = (f32x4){0.f, 0.f, 0.f, 0.f};
#pragma unroll
    for (int ks = 0; ks < 2; ++ks) { const bf16x8 af = *(const LAS bf16x8*)(AT + (16 * tm + fr) * VT_LD + ks * 32 + fq * 8);
#pragma unroll
        for (int nt = 0; nt < 8; ++nt) { const bf16x8 vf = *(const LAS bf16x8*)(VT + (128 * hh + 16 * nt + fr) * VT_LD + ks * 32 + fq * 8); acc[nt] = mfma16(vf, af, acc[nt]); } }
    if (j > 0) { const bf16* sp = LS + (size_t)(lsid - 1) * 32768 + (size_t)(128 * hh + fr) * 128 + fq * 8;
#pragma unroll
        for (int ks = 0; ks < 4; ++ks) { const bf16x8 qf = *(const LAS bf16x8*)(QT + (16 * tm + fr) * QT_LD + ks * 32 + fq * 8);
#pragma unroll
            for (int nt = 0; nt < 8; ++nt) { const bf16x8 sf = *(const bf16x8*)(sp + (size_t)nt * 16 * 128 + ks * 32); acc[nt] = mfma16(sf, qf, acc[nt]); } } }
    float ss = 0.f;
#pragma unroll
    for (int nt = 0; nt < 8; ++nt) ss += (acc[nt][0] * acc[nt][0] + acc[nt][1] * acc[nt][1]) + (acc[nt][2] * acc[nt][2] + acc[nt][3] * acc[nt][3]);
    ss += __shfl_xor(ss, 16); ss += __shfl_xor(ss, 32);
    if (fq == 0) RS[(16 * tm + fr) * 2 + hh] = ss;
    __syncthreads();
    const float rinv = __builtin_amdgcn_rsqf((RS[(16 * tm + fr) * 2] + RS[(16 * tm + fr) * 2 + 1]) * (1.0f / 256.0f) + 1e-6f);
    bf16* rp = R + (tok0 + 16 * tm + fr) * 1024 + h * 256 + 128 * hh + 4 * fq;
#pragma unroll
    for (int nt = 0; nt < 8; ++nt) { const f32x4 gn = *(const f32x4*)(gnorm + 128 * hh + 16 * nt + 4 * fq); const v2u rw = *(const v2u*)(rp + 16 * nt);
        const float r0 = bflo(rw.x), r1 = bfhi(rw.x), r2 = bflo(rw.y), r3 = bfhi(rw.y);
        const float o0 = acc[nt][0] * rinv * gn[0] * r0 * __builtin_amdgcn_rcpf(1.f + __expf(-r0)), o1 = acc[nt][1] * rinv * gn[1] * r1 * __builtin_amdgcn_rcpf(1.f + __expf(-r1));
        const float o2 = acc[nt][2] * rinv * gn[2] * r2 * __builtin_amdgcn_rcpf(1.f + __expf(-r2)), o3 = acc[nt][3] * rinv * gn[3] * r3 * __builtin_amdgcn_rcpf(1.f + __expf(-r3));
        v2u o; o.x = pk2(o0, o1); o.y = pk2(o2, o3); *(v2u*)(rp + 16 * nt) = o; }
    __syncthreads();
}
}

#define SEAM() do { if (ph + 1 < hi) grid.sync(); } while (0)
template <int L> __device__ __forceinline__ void run_layer(const Args& args, cg::grid_group& grid, LAS unsigned char* lds, unsigned char* lds_raw, int lo, int hi) {
    const int G = gridDim.x, bx = blockIdx.x, vcu = (G % 8 == 0) ? (bx % 8) * (G / 8) + bx / 8 : bx, NGW = G * NWAVES;
    unsigned char* ws = args.ws;
    float* ssqp = (float*)(ws + WS_SSQ); float* smallb = (float*)(ws + WS_SMALL); float* EB = (float*)(ws + WS_EB);
    bf16* HB = (bf16*)(ws + WS_HB); bf16* QB = (bf16*)(ws + WS_Q); bf16* KB = (bf16*)(ws + WS_K); bf16* VB = (bf16*)(ws + WS_V); bf16* LS = (bf16*)(ws + WS_LS); bf16* UB = (bf16*)(ws + WS_U);
    float* Hres = args.out;
    int ph = 1 + (L / 2) * 12 + (L % 2) * 5;
#define THREAD_VARS() int tid = threadIdx.x; asm volatile("" : "+v"(tid)); const int lane = tid & 63, wave = __builtin_amdgcn_readfirstlane(tid >> 6), gw = vcu * NWAVES + wave; (void)lane; (void)gw

        const bool fox = (L & 1) == 0; const int jl = L >> 1;
        unsigned char* wb = ws + WS_W + (size_t)(L & 1) * W_STRIDE;
        if (ph >= lo && ph < hi) { THREAD_VARS();
            if (L == 1 || L == 2) { convert_layer_weights(args, L + 1, lds, gw, NGW, wave, lane); __syncthreads(); }
            pg8::Gemm g{HB, (const bf16*)(wb + W_IN), M, NIN, D}; pg8::StaticOrder S; S.init(M, NIN, G, bx);
            pg8::EpiScaleBf16<0> E{QB, D, ssqp, D, (size_t)(WS_K - WS_Q) / 2, fox ? attn_body::C2 : 1.0f};
            pg8::gemm_phase<pg8::EpiScaleBf16<0>, pg8::StaticOrder, PG8_ALIGN, PG8_SP2>(lds, g, S, E);
            const bf16* wsm = (const bf16*)(wb + W_SM); const int fr = lane & 15, fq = lane >> 4;
            for (int task = gw; task < M / 16; task += NGW) { const int row = task * 16 + fr;
                const bf16* ap = HB + (size_t)row * D + fq * 8; const bf16* bp = wsm + fr * D + fq * 8; f32x4 acc = (f32x4){0.f, 0.f, 0.f, 0.f};
#pragma unroll 8
                for (int s = 0; s < 32; ++s) { const bf16x8 av = *(const bf16x8*)(ap + s * 32); const bf16x8 bv = *(const bf16x8*)(bp + s * 32); acc = __builtin_amdgcn_mfma_f32_16x16x32_bf16(bv, av, acc, 0, 0, 0); }
                const float rs = pg8::row_rstd(ssqp, row); *(f32x4*)(smallb + (size_t)row * 16 + 4 * fq) = acc * rs; }
            SEAM();
        }
        ++ph;
        if (fox) {
            if (ph >= lo && ph < hi) { THREAD_VARS();
                LAS float* ckl = (LAS float*)(lds + CKL_OFF); LAS float* wtot = (LAS float*)(lds + CKL_OFF + 16384);
                const float* bf_ = args.in[2] + jl * 16;
                for (int w = vcu; w < 256; w += G) { const int bh = w >> 2, s4 = w & 3, b = bh >> 4, h = bh & 15;
                    __syncthreads();
                    { const float bfh = bf_[h]; const float* fp = smallb + ((size_t)b * SEQ + 8 * tid) * 16 + h; float v[8]; float run = 0.f;
#pragma unroll
                        for (int i = 0; i < 8; ++i) { run += log_sigmoid(fp[i * 16] + bfh); v[i] = run; }
                        float tot = run;
#pragma unroll
                        for (int o = 1; o < 64; o <<= 1) { const float t = __shfl_up(tot, o); if (lane >= o) tot += t; }
                        if (lane == 63) wtot[wave] = tot;
                        __syncthreads();
                        float basev = tot - run;
                        for (int w2 = 0; w2 < wave; ++w2) basev += wtot[w2];
#pragma unroll
                        for (int i = 0; i < 8; ++i) ckl[8 * tid + i] = (basev + v[i]) * 1.4426950408889634f;
                        __syncthreads(); }
#pragma nounroll
                    for (int i = 0; i < 4; ++i) { const int qb = (i == 0) ? s4 : (i == 1) ? 7 - s4 : (i == 2) ? 8 + s4 : 15 - s4;
                        attn_body::attn_unit<8>(b, h, qb, (const attn_body::bf16*)QB, (const attn_body::bf16*)KB, (const attn_body::bf16*)VB, (attn_body::bf16*)QB, (char*)lds_raw, (attn_body::lds_cfptr)ckl); } }
                SEAM();
            }
            ++ph;
        } else {
            if (ph >= lo && ph < hi) { THREAD_VARS();
                for (int u = bx; u < 1024; u += G) gla::g1_unit(u, QB, KB, smallb, args.in[5] + (size_t)jl * 16 * 512, args.in[6] + jl * 512, LS, EB, lds, tid, wave, lane);
                SEAM();
            }
            ++ph;
            if (ph >= lo && ph < hi) { THREAD_VARS(); gla::g2_scan(LS, EB, bx * 512 + tid, G * 512); SEAM(); }
            ++ph;
            if (ph >= lo && ph < hi) { THREAD_VARS();
                for (int u = bx; u < 1024; u += G) gla::g3_unit(u, QB, KB, VB, LS, args.in[7] + jl * 256, lds, tid, wave, lane);
                SEAM();
            }
            ++ph;
        }
        if (ph >= lo && ph < hi) { THREAD_VARS();
            pg8::Gemm g{fox ? QB : VB, (const bf16*)(wb + W_O), M, D, D}; pg8::StaticOrder S; S.init(M, D, G, bx);
            pg8::EpiRes E{L == 0 ? args.in[0] : Hres, Hres, HB, ssqp, D};
            pg8::gemm_phase<pg8::EpiRes, pg8::StaticOrder, PG8_ALIGN, PG8_SP2>(lds, g, S, E);
            SEAM();
        }
        ++ph;
        if (ph >= lo && ph < hi) { THREAD_VARS();
            pg8::Gemm g{HB, (const bf16*)(wb + W_UP), M, FF, D}; pg8::StaticOrder S; S.init(M, FF, G, bx);
            pg8::EpiScaleBf16<2> E{UB, FF, ssqp, 0, 0, 1.f};
            pg8::gemm_phase<pg8::EpiScaleBf16<2>, pg8::StaticOrder, PG8_ALIGN, PG8_SP2>(lds, g, S, E);
            SEAM();
        }
        ++ph;
        if (ph >= lo && ph < hi) { THREAD_VARS();
            pg8::Gemm g{UB, (const bf16*)(wb + W_DN), M, D, FF}; pg8::StaticOrder S; S.init(M, D, G, bx);
            pg8::EpiRes E{Hres, Hres, HB, ssqp, D};
            pg8::gemm_phase<pg8::EpiRes, pg8::StaticOrder, PG8_ALIGN, PG8_SP2>(lds, g, S, E);
            SEAM();
        }
        ++ph;
    }
#undef SEAM
#undef THREAD_VARS
__global__ void __launch_bounds__(NWAVES * 64, 2) fwd_megakernel(Args args) {
    extern __shared__ __attribute__((aligned(16))) unsigned char lds_raw[];
    cg::grid_group grid = cg::this_grid();
    LAS unsigned char* lds = (LAS unsigned char*)lds_raw;
    const int tid = threadIdx.x, lane = tid & 63, wave = __builtin_amdgcn_readfirstlane(tid >> 6);
    const int G = gridDim.x, bx = blockIdx.x, vcu = (G % 8 == 0) ? (bx % 8) * (G / 8) + bx / 8 : bx;
    const int gw = vcu * NWAVES + wave, NGW = G * NWAVES;
    unsigned char* ws = args.ws;
    float* ssqp = (float*)(ws + WS_SSQ); float* smallb = (float*)(ws + WS_SMALL); float* EB = (float*)(ws + WS_EB);
    bf16* HB = (bf16*)(ws + WS_HB); bf16* QB = (bf16*)(ws + WS_Q); bf16* KB = (bf16*)(ws + WS_K); bf16* VB = (bf16*)(ws + WS_V); bf16* LS = (bf16*)(ws + WS_LS); bf16* UB = (bf16*)(ws + WS_U);
    float* Hres = args.out;
    const int lo = args.ph_lo, hi = args.ph_hi;
    int ph = 0;
#define SEAM() do { if (ph + 1 < hi) grid.sync(); } while (0)

    if (ph >= lo && ph < hi) {
        convert_layer_weights(args, 0, lds, gw, NGW, wave, lane);
        convert_layer_weights(args, 1, lds, gw, NGW, wave, lane);
        const float* x = args.in[0];
        for (int m = gw; m < M; m += NGW) { const f32x4* xr = (const f32x4*)(x + (size_t)m * D) + lane; f32x4 v[4]; float s = 0.f;
#pragma unroll
            for (int jj = 0; jj < 4; ++jj) { v[jj] = xr[64 * jj]; s += (v[jj][0] * v[jj][0] + v[jj][1] * v[jj][1]) + (v[jj][2] * v[jj][2] + v[jj][3] * v[jj][3]); }
            s = wave_sum(s);
            v2u* o8 = (v2u*)(HB + (size_t)m * D) + lane;
#pragma unroll
            for (int jj = 0; jj < 4; ++jj) { v2u o; o.x = pk2(v[jj][0], v[jj][1]); o.y = pk2(v[jj][2], v[jj][3]); o8[64 * jj] = o; }
            if (lane < 16) ssqp[(size_t)m * 16 + lane] = (lane == 0) ? s : 0.f; }
        SEAM();
    }
    ++ph;

    run_layer<0>(args, grid, lds, lds_raw, lo, hi); run_layer<1>(args, grid, lds, lds_raw, lo, hi); run_layer<2>(args, grid, lds, lds_raw, lo, hi); run_layer<3>(args, grid, lds, lds_raw, lo, hi);
    ph = N_PHASES - 1;
    if (ph >= lo && ph < hi) {
        const float* gf = args.in[13];
        for (int m = gw; m < M; m += NGW) { f32x4* xr = (f32x4*)(Hres + (size_t)m * D) + lane; const float rs = pg8::row_rstd(ssqp, m);
#pragma unroll
            for (int jj = 0; jj < 4; ++jj) { const f32x4 gv = ((const f32x4*)gf)[64 * jj + lane]; xr[64 * jj] = xr[64 * jj] * rs * gv; } }
    }
#undef SEAM
}

extern "C" void kernel_launch(void* const* d_in, const int* in_sizes, int n_in, void* d_out, int out_size, void* d_ws, size_t ws_size, hipStream_t stream) {
    static int grid = 0;
    if (grid == 0) {
        if (n_in != 14 || out_size != M * D || ws_size < WS_END) { fprintf(stderr, "kernel_launch: unexpected shapes (n_in %d, out %d, ws %zu)\n", n_in, out_size, ws_size); grid = -1; return; }
        int dev = 0, cus = 0, per_cu = 0;
        (void)hipGetDevice(&dev); (void)hipDeviceGetAttribute(&cus, hipDeviceAttributeMultiprocessorCount, dev);
        if (hipFuncSetAttribute((const void*)fwd_megakernel, hipFuncAttributeMaxDynamicSharedMemorySize, LDS_BYTES) != hipSuccess) { fprintf(stderr, "kernel_launch: hipFuncSetAttribute failed\n"); grid = -1; return; }
        if (hipOccupancyMaxActiveBlocksPerMultiprocessor(&per_cu, (const void*)fwd_megakernel, NWAVES * 64, LDS_BYTES) != hipSuccess || per_cu < 1) { fprintf(stderr, "kernel_launch: occupancy query says %d blocks per CU\n", per_cu); per_cu = 1; }
        (void)hipGetLastError();
        grid = cus * (per_cu < 1 ? 1 : per_cu);
        if (grid > 256) grid = 256;
    }
    if (grid < 0) return;
    Args a{};
    for (int i = 0; i < 14; ++i) a.in[i] = (const float*)d_in[i];
    a.out = (float*)d_out; a.ws = (unsigned char*)d_ws;
#if MK_ONE_LAUNCH
    a.ph_lo = 0; a.ph_hi = N_PHASES;
    void* kargs[] = {&a};
    hipError_t e = hipLaunchCooperativeKernel((const void*)fwd_megakernel, dim3(grid), dim3(NWAVES * 64), kargs, LDS_BYTES, stream);
    if (e != hipSuccess) fprintf(stderr, "kernel_launch: cooperative launch failed: %s (grid %d)\n", hipGetErrorString(e), grid);
#else
    for (int p = 0; p < N_PHASES; ++p) { a.ph_lo = p; a.ph_hi = p + 1; hipLaunchKernelGGL(fwd_megakernel, dim3(grid), dim3(NWAVES * 64), LDS_BYTES, stream, a); }
#endif
}
```

```cpp
#include <hip/hip_cooperative_groups.h>
#include <hip/hip_runtime.h>
#include <cstdio>
#include <cstdint>
namespace pg8 {
#define PG8_LAS __attribute__((address_space(3)))
typedef unsigned short bf16_t;
typedef short bf16x8 __attribute__((ext_vector_type(8)));
typedef float f32x4 __attribute__((ext_vector_type(4)));
typedef unsigned u32x4 __attribute__((ext_vector_type(4)));
constexpr int BM = 256, BK = 64, HALF = 128, HTB = HALF * BK * 2  , STAGE_BYTES = 8 * HTB, NXCD = 8, WGM = 8;

__host__ __device__ __forceinline__ int lds_byte(int r, int c) { const int st = (r >> 4) * 2 + (c >> 5), rr = r & 15, cc = c & 31, ob = rr * 64 + cc * 2; return st * 1024 + (ob ^ (((ob >> 9) & 1) << 5)); }
__host__ __device__ __forceinline__ void stage_rc(int b, int& R, int& C) { const int st = b / 1024, sb = b % 1024, swz = sb ^ (((sb >> 9) & 1) << 5); R = (st >> 1) * 16 + swz / 64; C = (st & 1) * 32 + (swz % 64) / 2; }
__host__ __device__ __forceinline__ int perm32(int rho) { const int n = rho >> 4, i = rho & 15; return 8 * (i >> 2) + 4 * n + (i & 3); }

struct Unit { int pm, pn; };
struct Gemm { const bf16_t* A; const bf16_t* Bt; int M, N, K; };

struct StaticOrder {
    int nM, nN, nwg, G, c;
    __host__ __device__ void init(int M, int N, int G_, int c_) { nM = M / BM; nN = N / BM; nwg = nM * nN; G = G_; c = c_; }
    __host__ __device__ bool next(int i, Unit& u) const {
        const long L = (long)i * G + c; if (L >= nwg) return false;
        int wgid = (int)L; { const int q = nwg / NXCD, r = nwg % NXCD, xcd = wgid % NXCD, off = wgid / NXCD; wgid = (xcd < r ? xcd * (q + 1) : r * (q + 1) + (xcd - r) * q) + off; }
        const int nig = WGM * nN, gid = wgid / nig, fm = gid * WGM, gsz = (nM - fm) < WGM ? (nM - fm) : WGM;
        u.pm = fm + ((wgid % nig) % gsz); u.pn = (wgid % nig) / gsz; return true;
    }
    __device__ __forceinline__ void a_ready(const Unit&) const {}
    __device__ __forceinline__ void done(const Unit&) const {}
};

__device__ __forceinline__ unsigned cvt_pk_bf16(float lo, float hi) { unsigned r; asm volatile("v_cvt_pk_bf16_f32 %0, %1, %2" : "=v"(r) : "v"(lo), "v"(hi)); return r; }
typedef float f32x2 __attribute__((ext_vector_type(2)));
typedef unsigned u32x2 __attribute__((ext_vector_type(2)));
__device__ __forceinline__ float row_rstd(const float* ssqp, int row) {
    const f32x4* p = (const f32x4*)(ssqp + (size_t)row * 16);
    const f32x4 a = p[0], b = p[1], c = p[2], d = p[3];
    const f32x4 s = (a + b) + (c + d);
    const float t = (s[0] + s[1]) + (s[2] + s[3]);
    return __builtin_amdgcn_rsqf(t * (1.0f / 1024.0f) + 1e-6f);
}
template <int ACT> struct EpiScaleBf16 {
    static constexpr bool PERM = true, AFTER_DRAIN = false;
    bf16_t* O; int ldc; const float* ssqp; int split_cols; size_t split_stride; float scale0;
    __device__ __forceinline__ void operator()(const f32x4 (&acc)[2][2][4][2], const Unit& u, int wr, int wc, int fr, int fq) const {
        const int row0 = u.pm * BM + wr * 64 + fr; int colt = u.pn * BM; bf16_t* base = O;
        float sc = 1.f; if (split_cols) { const int t = colt / split_cols; base += (size_t)t * split_stride; colt -= t * split_cols; if (t == 0) sc = scale0; }
        const int col0 = colt + wc * 32 + 8 * fq;
        f32x4 pq[2][4]; float rsv[2][4];
#pragma unroll
        for (int ai = 0; ai < 2; ++ai)
#pragma unroll
            for (int m = 0; m < 4; ++m) pq[ai][m] = *(const f32x4*)(ssqp + (size_t)(row0 + ai * HALF + m * 16) * 16 + 4 * fq);
#pragma unroll
        for (int ai = 0; ai < 2; ++ai)
#pragma unroll
            for (int m = 0; m < 4; ++m) { float t = (pq[ai][m][0] + pq[ai][m][1]) + (pq[ai][m][2] + pq[ai][m][3]); t += __shfl_xor(t, 16); t += __shfl_xor(t, 32);
                rsv[ai][m] = __builtin_amdgcn_rsqf(t * (1.0f / 1024.0f) + 1e-6f) * sc; }
#pragma unroll
        for (int ai = 0; ai < 2; ++ai)
#pragma unroll
            for (int m = 0; m < 4; ++m) { const int row = row0 + ai * HALF + m * 16; const float rs = rsv[ai][m]; bf16_t* rowp = base + (size_t)row * ldc + col0;
#pragma unroll
                for (int bj = 0; bj < 2; ++bj) { f32x4 v0 = acc[ai][bj][m][0] * rs, v1 = acc[ai][bj][m][1] * rs;
                    if (ACT == 2) {
#pragma unroll
                        for (int e = 0; e < 4; ++e) { const float a = __builtin_fmaxf(v0[e], 0.f), b = __builtin_fmaxf(v1[e], 0.f); v0[e] = a * a; v1[e] = b * b; } }
                    u32x4 w; w.x = cvt_pk_bf16(v0[0], v0[1]); w.y = cvt_pk_bf16(v0[2], v0[3]); w.z = cvt_pk_bf16(v1[0], v1[1]); w.w = cvt_pk_bf16(v1[2], v1[3]);
                    *(u32x4*)(rowp + bj * HALF) = w; } }
    }
};
struct EpiRes {
    static constexpr bool PERM = false, AFTER_DRAIN = false;
    const float* base; float* out; bf16_t* hb; float* ssqp; int ldc;
    __device__ __forceinline__ void operator()(const f32x4 (&acc)[2][2][4][2], const Unit& u, int wr, int wc, int fr, int fq) const {
        const int col0 = u.pn * BM + wc * 32 + 4 * fq;
#pragma unroll
        for (int ai = 0; ai < 2; ++ai)
#pragma unroll
            for (int m = 0; m < 4; ++m) { const int r = u.pm * BM + ai * HALF + wr * 64 + m * 16 + fr; const size_t off = (size_t)r * ldc + col0; float q = 0.f;
#pragma unroll
                for (int bj = 0; bj < 2; ++bj)
#pragma unroll
                    for (int n = 0; n < 2; ++n) { const f32x4 bs = *(const f32x4*)(base + off + bj * HALF + n * 16); const f32x4 o = bs + acc[ai][bj][m][n];
                        *(f32x4*)(out + off + bj * HALF + n * 16) = o; q += (o[0] * o[0] + o[1] * o[1]) + (o[2] * o[2] + o[3] * o[3]);
                        u32x2 w; w.x = cvt_pk_bf16(o[0], o[1]); w.y = cvt_pk_bf16(o[2], o[3]); *(u32x2*)(hb + off + bj * HALF + n * 16) = w; }
                q += __shfl_xor(q, 16); q += __shfl_xor(q, 32);
                if (fq == 0) ssqp[(size_t)r * 16 + u.pn * 4 + wc] = q;
                if (m & 1) asm volatile("" ::: "memory"); }
    }
};

template <class Epi, class Sched, bool ALIGN_EPI = false, bool SP2 = false>
__device__ __forceinline__ void gemm_phase(PG8_LAS unsigned char* lds, const Gemm g, const Sched& S, const Epi& E) {
    int tid = threadIdx.x; asm volatile("" : "+v"(tid)); const int wid = __builtin_amdgcn_readfirstlane(tid >> 6), lane = tid & 63, wr = wid >> 2, wc = wid & 3, fr = lane & 15, fq = lane >> 4;
    const int K = g.K, nt = K / BK;
    unsigned voffA[2], voffB[2];
#pragma unroll
    for (int i = 0; i < 2; ++i) { int R, C; stage_rc(tid * 16 + i * 8192, R, C); const int Rb = Epi::PERM ? ((R & ~31) + perm32(R & 31)) : R;
        voffA[i] = (unsigned)(R * K + C) * 2u; voffB[i] = (unsigned)(Rb * K + C) * 2u; }
    const size_t kstep = (size_t)(BK * 2);
    const size_t hstep = (size_t)HALF * K * 2;
    const size_t tstep = 2 * hstep;
    const unsigned ldsw = (unsigned)wid * 1024u;
    const int aoff = lds_byte(wr * 64 + fr, fq * 8), boff = lds_byte(wc * 32 + fr, fq * 8);
#define PG8_SA(b, h) (((b) * 2 + (h)) * HTB)
#define PG8_SB(b, h) ((4 + (b) * 2 + (h)) * HTB)
#define PG8_STAGE(bufoff, gbase, voff) do { _Pragma("unroll") for (int _i = 0; _i < 2; ++_i) \
        __builtin_amdgcn_global_load_lds((const unsigned*)((const char*)(gbase) + (voff)[_i]), (PG8_LAS unsigned*)(lds + (bufoff) + ldsw + _i * 8192), 16, 0, 0); } while (0)
#define PG8_LDA(dst, b, h) do { _Pragma("unroll") for (int m = 0; m < 4; ++m) _Pragma("unroll") for (int k = 0; k < 2; ++k) dst[m][k] = *(const PG8_LAS bf16x8*)(lds + PG8_SA(b, h) + aoff + m * 2048 + k * 1024); } while (0)
#define PG8_LDB(dst, b, h) do { _Pragma("unroll") for (int n = 0; n < 2; ++n) _Pragma("unroll") for (int k = 0; k < 2; ++k) dst[n][k] = *(const PG8_LAS bf16x8*)(lds + PG8_SB(b, h) + boff + n * 2048 + k * 1024); } while (0)
#define PG8_MMA(ai, bj, At, Bt) do { __builtin_amdgcn_s_setprio(1); _Pragma("unroll") for (int m = 0; m < 4; ++m) _Pragma("unroll") for (int n = 0; n < 2; ++n) _Pragma("unroll") for (int k = 0; k < 2; ++k) \
        acc[ai][bj][m][n] = __builtin_amdgcn_mfma_f32_16x16x32_bf16(Bt[n][k], At[m][k], acc[ai][bj][m][n], 0, 0, 0); __builtin_amdgcn_s_setprio(0); } while (0)
#define PG8_WAIT_V(n) asm volatile("s_waitcnt vmcnt(" #n ")" ::: "memory")
#define PG8_WAIT_L(n) asm volatile("s_waitcnt lgkmcnt(" #n ")" ::: "memory")
#define PG8_BAR __builtin_amdgcn_s_barrier()
#define PG8_SCHED __builtin_amdgcn_sched_barrier(0)
    Unit cur, nxt; int ui = 0;
    if (!S.next(0, cur)) return;
    f32x4 acc[2][2][4][2];
#pragma unroll
    for (int a = 0; a < 2; ++a)
#pragma unroll
        for (int b = 0; b < 2; ++b)
#pragma unroll
            for (int m = 0; m < 4; ++m)
#pragma unroll
                for (int n = 0; n < 2; ++n) acc[a][b][m][n] = (f32x4){0.f, 0.f, 0.f, 0.f};
    bf16x8 At[4][2], B0[2][2], B1[2][2];
    const char* cA = (const char*)g.A + (size_t)cur.pm * tstep; const char* cB = (const char*)g.Bt + (size_t)cur.pn * tstep;
    S.a_ready(cur);
    if constexpr (SP2) {
        PG8_STAGE(PG8_SB(0, 0), cB, voffB); PG8_STAGE(PG8_SB(0, 1), cB + hstep, voffB); PG8_STAGE(PG8_SA(0, 0), cA, voffA); PG8_STAGE(PG8_SA(0, 1), cA + hstep, voffA);
        if (wr == 1) PG8_BAR;
        PG8_WAIT_V(2); PG8_BAR;
        PG8_STAGE(PG8_SB(1, 0), cB + kstep, voffB); PG8_STAGE(PG8_SA(1, 0), cA + kstep, voffA); PG8_STAGE(PG8_SB(1, 1), cB + hstep + kstep, voffB);
        PG8_WAIT_V(6); PG8_BAR;
    } else {
        PG8_STAGE(PG8_SB(0, 0), cB, voffB); PG8_STAGE(PG8_SA(0, 0), cA, voffA); PG8_STAGE(PG8_SB(0, 1), cB + hstep, voffB); PG8_STAGE(PG8_SA(0, 1), cA + hstep, voffA);
        if (wr == 1) PG8_BAR;
        PG8_WAIT_V(4); PG8_BAR;
        PG8_STAGE(PG8_SB(1, 0), cB + kstep, voffB); PG8_STAGE(PG8_SA(1, 0), cA + kstep, voffA); PG8_STAGE(PG8_SB(1, 1), cB + hstep + kstep, voffB);
        PG8_WAIT_V(6); PG8_BAR;
    }
    for (;;) {
        const bool has_next = S.next(ui + 1, nxt);
        const char* nA = has_next ? (const char*)g.A + (size_t)nxt.pm * tstep : cA; const char* nB = has_next ? (const char*)g.Bt + (size_t)nxt.pn * tstep : cB;
        for (int t = 0; t < nt; t += 2) {
            const bool last = (t == nt - 2);
            const char* a1 = cA + (size_t)(t + 1) * kstep;
            const char* a2 = last ? nA : cA + (size_t)(t + 2) * kstep; const char* b2 = last ? nB : cB + (size_t)(t + 2) * kstep;
            const char* a3 = a2 + kstep; const char* b3 = b2 + kstep;
            if (last && has_next) S.a_ready(nxt);
            if constexpr (SP2) {
            PG8_LDB(B0, 0, 0); PG8_LDB(B1, 0, 1); PG8_SCHED; PG8_LDA(At, 0, 0); PG8_STAGE(PG8_SA(1, 1), a1 + hstep, voffA);
            PG8_WAIT_V(8); PG8_WAIT_L(0); PG8_BAR; PG8_MMA(0, 0, At, B0); PG8_MMA(0, 1, At, B1); PG8_BAR; PG8_SCHED;
            PG8_LDA(At, 0, 1); PG8_STAGE(PG8_SB(0, 0), b2, voffB); PG8_STAGE(PG8_SB(0, 1), b2 + hstep, voffB); PG8_STAGE(PG8_SA(0, 0), a2, voffA);
            PG8_WAIT_V(8); PG8_WAIT_L(0); PG8_BAR; PG8_MMA(1, 0, At, B0); PG8_MMA(1, 1, At, B1); PG8_BAR; PG8_SCHED;
            PG8_LDB(B0, 1, 0); PG8_LDB(B1, 1, 1); PG8_SCHED; PG8_LDA(At, 1, 0); PG8_STAGE(PG8_SA(0, 1), a2 + hstep, voffA);
            PG8_WAIT_V(8); PG8_WAIT_L(0); PG8_BAR; PG8_MMA(0, 0, At, B0); PG8_MMA(0, 1, At, B1); PG8_BAR; PG8_SCHED;
            PG8_LDA(At, 1, 1); PG8_STAGE(PG8_SB(1, 0), b3, voffB); PG8_STAGE(PG8_SB(1, 1), b3 + hstep, voffB); PG8_STAGE(PG8_SA(1, 0), a3, voffA);
            PG8_WAIT_V(8); PG8_WAIT_L(0); PG8_BAR; PG8_MMA(1, 0, At, B0); PG8_MMA(1, 1, At, B1); PG8_BAR; PG8_SCHED;
            } else {
            PG8_LDB(B0, 0, 0); PG8_SCHED; PG8_LDA(At, 0, 0); PG8_STAGE(PG8_SA(1, 1), a1 + hstep, voffA);
            PG8_WAIT_L(8); PG8_BAR; PG8_WAIT_L(0); PG8_MMA(0, 0, At, B0); PG8_BAR; PG8_SCHED;
            PG8_LDB(B1, 0, 1); PG8_STAGE(PG8_SB(0, 0), b2, voffB);
            PG8_BAR; PG8_WAIT_L(0); PG8_MMA(0, 1, At, B1); PG8_BAR;
            PG8_LDA(At, 0, 1); PG8_STAGE(PG8_SA(0, 0), a2, voffA);
            PG8_BAR; PG8_WAIT_L(0); PG8_MMA(1, 0, At, B0); PG8_BAR; PG8_SCHED;
            PG8_STAGE(PG8_SB(0, 1), b2 + hstep, voffB);
            PG8_WAIT_V(6); PG8_BAR; PG8_MMA(1, 1, At, B1); PG8_BAR;
            PG8_LDB(B0, 1, 0); PG8_SCHED; PG8_LDA(At, 1, 0); PG8_STAGE(PG8_SA(0, 1), a2 + hstep, voffA);
            PG8_WAIT_L(8); PG8_BAR; PG8_WAIT_L(0); PG8_MMA(0, 0, At, B0); PG8_BAR; PG8_SCHED;
            PG8_LDB(B1, 1, 1); PG8_STAGE(PG8_SB(1, 0), b3, voffB);
            PG8_BAR; PG8_WAIT_L(0); PG8_MMA(0, 1, At, B1); PG8_BAR;
            PG8_LDA(At, 1, 1); PG8_STAGE(PG8_SA(1, 0), a3, voffA);
            PG8_BAR; PG8_WAIT_L(0); PG8_MMA(1, 0, At, B0); PG8_BAR; PG8_SCHED;
            PG8_STAGE(PG8_SB(1, 1), b3 + hstep, voffB);
            PG8_WAIT_V(6); PG8_BAR; PG8_MMA(1, 1, At, B1); PG8_BAR;
            }
        }
        if constexpr (ALIGN_EPI) { if (wr == 0) PG8_BAR; }
        if constexpr (!Epi::AFTER_DRAIN) { E(acc, cur, wr, wc, fr, fq); S.done(cur); }
        if (!has_next) break;
#pragma unroll
        for (int a = 0; a < 2; ++a)
#pragma unroll
            for (int b = 0; b < 2; ++b)
#pragma unroll
                for (int m = 0; m < 4; ++m)
#pragma unroll
                    for (int n = 0; n < 2; ++n) acc[a][b][m][n] = (f32x4){0.f, 0.f, 0.f, 0.f};
        cur = nxt; cA = nA; cB = nB; ++ui;
        if constexpr (ALIGN_EPI) { if (wr == 1) PG8_BAR; }
    }
    PG8_WAIT_V(0);
    if constexpr (!ALIGN_EPI) { if (wr == 0) PG8_BAR; }
    PG8_BAR;
    if constexpr (Epi::AFTER_DRAIN) { E.fused(acc, cur, wr, wc, fr, fq, lds, wid, lane); S.done(cur); }
#undef PG8_SA
#undef PG8_SB
#undef PG8_STAGE
#undef PG8_LDA
#undef PG8_LDB
#undef PG8_MMA
#undef PG8_WAIT_V
#undef PG8_WAIT_L
#undef PG8_BAR
#undef PG8_SCHED
}
}

#ifndef PG8_SP2
#define PG8_SP2 true
#endif
#ifndef PG8_ALIGN
#define PG8_ALIGN true
#endif
#include <hip/hip_bf16.h>
#include <cmath>
namespace attn_body {
using bf16=__hip_bfloat16;
using bf16x8=__attribute__((ext_vector_type(8)))short;
using s16x4=__attribute__((ext_vector_type(4)))short;
using f32x16=__attribute__((ext_vector_type(16)))float;
using u32x4=__attribute__((ext_vector_type(4)))unsigned;
constexpr int BATCH=4,NHEAD=16,SEQ=4096,D=64,DM=NHEAD*D;
constexpr int NW=8,QBLK=32,QB=QBLK*NW,KVBLK=64,NQB=SEQ/QB;
constexpr int ATTN_PITCH=DM, ATTN_UNIT_ROWS=QB;
__device__ __forceinline__ int crow(int r,int hi){return (r&3)+8*(r>>2)+4*hi;}
#define SBAR() __builtin_amdgcn_sched_barrier(0)
__device__ __forceinline__ void cmask(f32x16&p0,f32x16&p1,int jb,int qrel,int hi){
  const float NEG=-INFINITY; int kb=64*jb+4*hi;
  #pragma unroll
  for(int r=0;r<16;++r){int kv=kb+(r&3)+8*(r>>2); if(kv>qrel)p0[r]=NEG; if(kv+32>qrel)p1[r]=NEG;}
}

constexpr int NSLOT=3, SLOTB=8192;
constexpr int LDS_K=0, LDS_V=NSLOT*SLOTB, LDS_WS=2*NSLOT*SLOTB, LDS_OST=LDS_WS+NW*64*4, LDS_BYTES=LDS_OST+NW*4096;
constexpr float C2=0.125f*1.4426950408889634f;
__device__ __forceinline__ void glds16(const void*gsrc,unsigned lds_dst){unsigned keep;
  asm volatile("s_mov_b32 %0, m0\n\ts_mov_b32 m0, %2\n\ts_nop 0\n\tglobal_load_lds_dwordx4 %1, off\n\ts_mov_b32 m0, %0":"=&s"(keep):"v"(gsrc),"s"(lds_dst):"memory");}
__device__ __forceinline__ float max3f(float a,float b,float c){float r;asm("v_max3_f32 %0, %1, %2, %3":"=v"(r):"v"(a),"v"(b),"v"(c));return r;}
__device__ __forceinline__ float max2f(float a,float b){float r;asm("v_max_f32_e32 %0, %1, %2":"=v"(r):"v"(a),"v"(b));return r;}
__device__ __forceinline__ float fadd_s(float a,float b){float r;asm("v_add_f32_e32 %0, %1, %2":"=v"(r):"v"(a),"v"(b));return r;}
__device__ __forceinline__ float fsub_s(float a,float b){float r;asm("v_sub_f32_e32 %0, %1, %2":"=v"(r):"v"(a),"v"(b));return r;}
typedef float f32x2_t __attribute__((ext_vector_type(2))); typedef __bf16 bf16x2_t __attribute__((ext_vector_type(2)));
__device__ __forceinline__ unsigned cvtpk_s(float lo,float hi){f32x2_t v={lo,hi};bf16x2_t b=__builtin_convertvector(v,bf16x2_t);return __builtin_bit_cast(unsigned,b);}
#define WAIT_BAR(N) asm volatile("s_waitcnt vmcnt(" #N ") lgkmcnt(0)\n\ts_barrier":::"memory")

__device__ __forceinline__ void qkt(f32x16&p0,f32x16&p1,const char*Kslot,const bf16x8*qr,int r32,int hi){
  const char*kb=Kslot+hi*1024+r32*16;
  #pragma unroll
  for(int d0=0;d0<4;++d0){
    const bf16x8 b0=*reinterpret_cast<const bf16x8*>(kb+d0*2048);
    const bf16x8 b1=*reinterpret_cast<const bf16x8*>(kb+d0*2048+512);
    {p0=__builtin_amdgcn_mfma_f32_32x32x16_bf16(b0,qr[d0],p0,0,0,0);p1=__builtin_amdgcn_mfma_f32_32x32x16_bf16(b1,qr[d0],p1,0,0,0);}}
}
typedef __attribute__((address_space(3))) const char* lds_cptr;
typedef short v4i16_t __attribute__((ext_vector_type(4)));
__device__ __forceinline__ void kload8(bf16x8*kf,lds_cptr kp){
  kf[0]=*(const __attribute__((address_space(3))) bf16x8*)(kp);      kf[1]=*(const __attribute__((address_space(3))) bf16x8*)(kp+512);
  kf[2]=*(const __attribute__((address_space(3))) bf16x8*)(kp+2048); kf[3]=*(const __attribute__((address_space(3))) bf16x8*)(kp+2560);
  kf[4]=*(const __attribute__((address_space(3))) bf16x8*)(kp+4096); kf[5]=*(const __attribute__((address_space(3))) bf16x8*)(kp+4608);
  kf[6]=*(const __attribute__((address_space(3))) bf16x8*)(kp+6144); kf[7]=*(const __attribute__((address_space(3))) bf16x8*)(kp+6656);
}
__device__ __forceinline__ void kload2(bf16x8*kf,lds_cptr kp,int j){ kf[2*j]=*(const __attribute__((address_space(3))) bf16x8*)(kp+j*2048); kf[2*j+1]=*(const __attribute__((address_space(3))) bf16x8*)(kp+j*2048+512); }
__device__ __forceinline__ s16x4 vtr(lds_cptr p){ return __builtin_bit_cast(s16x4,__builtin_amdgcn_ds_read_tr16_b64_v4i16((__attribute__((address_space(3))) v4i16_t*)p)); }
__device__ __forceinline__ float rowmax(const f32x16&p0,const f32x16&p1){
  float a=max3f(p0[0],p0[1],p1[0]),b=max3f(p0[2],p0[3],p1[1]);a=max3f(a,p1[2],p1[3]);
  #pragma unroll
  for(int r=4;r<16;r+=4){a=max3f(a,p0[r],p0[r+1]);b=max3f(b,p0[r+2],p0[r+3]);a=max3f(a,p1[r],p1[r+1]);b=max3f(b,p1[r+2],p1[r+3]);}
  const float m=max2f(a,b);
  auto rr=__builtin_amdgcn_permlane32_swap(__float_as_uint(m),__float_as_uint(m),false,false);
  return max2f(__uint_as_float(rr[0]),__uint_as_float(rr[1]));
}
__device__ __forceinline__ void pv(f32x16*o,int vb,bf16x8 pa0,bf16x8 pa1,bf16x8 pa2,bf16x8 pa3){
  #pragma unroll
  for(int d0=0;d0<2;++d0){s16x4 lo[4],hi[4];
    #pragma unroll
    for(int ks=0;ks<4;++ks){
      asm volatile("ds_read_b64_tr_b16 %0,%1 offset:%c2":"=&v"(lo[ks]):"v"(vb),"i"(d0*4096+ks*1024):"memory");
      asm volatile("ds_read_b64_tr_b16 %0,%1 offset:%c2":"=&v"(hi[ks]):"v"(vb),"i"(d0*4096+ks*1024+512):"memory");}
    asm volatile("s_waitcnt lgkmcnt(0)":::"memory");SBAR();
    #define PK(k) (bf16x8){lo[k][0],lo[k][1],lo[k][2],lo[k][3],hi[k][0],hi[k][1],hi[k][2],hi[k][3]}
    o[d0]=__builtin_amdgcn_mfma_f32_32x32x16_bf16(pa0,PK(0),o[d0],0,0,0);
    o[d0]=__builtin_amdgcn_mfma_f32_32x32x16_bf16(pa1,PK(1),o[d0],0,0,0);
    o[d0]=__builtin_amdgcn_mfma_f32_32x32x16_bf16(pa2,PK(2),o[d0],0,0,0);
    o[d0]=__builtin_amdgcn_mfma_f32_32x32x16_bf16(pa3,PK(3),o[d0],0,0,0);
    #undef PK
  }
}

#ifndef ATTN_STORE16
#define ATTN_STORE16(p,v) (*(u32x4*)(p)=(v))
#endif
typedef __attribute__((address_space(3))) const float* lds_cfptr;
typedef float f32x4a __attribute__((ext_vector_type(4)));
#define BIASINIT(C0,C1,t) do{ const lds_cfptr cb_=ckl+64*(t)+4*hi; \
    { f32x4a v_[4]; _Pragma("unroll") for(int j_=0;j_<4;++j_) v_[j_]=*(const __attribute__((address_space(3))) f32x4a*)(cb_+8*j_); \
      _Pragma("unroll") for(int j_=0;j_<4;++j_) _Pragma("unroll") for(int i_=0;i_<4;++i_) C0[4*j_+i_]=nm-v_[j_][i_]; } \
    SBAR(); \
    { f32x4a v_[4]; _Pragma("unroll") for(int j_=0;j_<4;++j_) v_[j_]=*(const __attribute__((address_space(3))) f32x4a*)(cb_+32+8*j_); \
      _Pragma("unroll") for(int j_=0;j_<4;++j_) _Pragma("unroll") for(int i_=0;i_<4;++i_) C1[4*j_+i_]=nm-v_[j_][i_]; } }while(0)
template<int THRL> __device__ __forceinline__ void attn_unit(int b,int h,int qb,const bf16*Q,const bf16*__restrict__ K,const bf16*__restrict__ V,bf16*O,char*shm,lds_cfptr ckl){
  int tid=threadIdx.x; asm volatile("":"+v"(tid)); const int lane=tid&63,r32=lane&31,hi=lane>>5; const int wid=__builtin_amdgcn_readfirstlane(tid>>6);
  const long rowbase=(long)b*SEQ; const int q0=qb*QB;
  const bf16*Qw=Q+(rowbase+q0+wid*QBLK)*DM+h*D;
  const bf16*Kh=K+rowbase*DM+h*D,*Vh=V+rowbase*DM+h*D;
  const unsigned lds0=(unsigned)(uintptr_t)shm;
  float*wsf=(float*)(shm+LDS_WS)+wid*64;
  const bf16*ksrc=Kh+(long)lane*DM+wid*8;
  const bf16*vsrc=Vh+(long)(16*(wid&3)+(lane>>2))*DM+(wid>>2)*32+(lane&3)*8;
  const unsigned kdst=lds0+LDS_K+wid*1024, vdst=lds0+LDS_V+wid*1024;
  #define DMA_K(t,slot) glds16(ksrc+(long)(t)*KVBLK*DM,(unsigned)__builtin_amdgcn_readfirstlane(kdst+(slot)))
  #define DMA_V(t,slot) glds16(vsrc+(long)(t)*KVBLK*DM,(unsigned)__builtin_amdgcn_readfirstlane(vdst+(slot)))
  const int vb0=(int)(lds0+LDS_V)+((lane>>4)&1)*32+(lane&3)*8+(4*hi+((lane&15)>>2))*64;
  const char*Kbase=shm+LDS_K; bf16x8 kf[8];
  const lds_cptr shm3=(lds_cptr)shm; const lds_cptr kp0=shm3+LDS_K+hi*1024+r32*16; const lds_cptr vp0=shm3+LDS_V+((lane>>4)&1)*32+(lane&3)*8+(4*hi+((lane&15)>>2))*64;
  const int NT=(q0+QB)/KVBLK;
  DMA_K(0,0);DMA_V(0,0);DMA_K(1,SLOTB);
  bf16x8 qr[4];
  #pragma unroll
  for(int d0=0;d0<4;++d0)qr[d0]=*reinterpret_cast<const bf16x8*>(&Qw[(long)r32*DM+d0*16+hi*8]);
  float mhat=0.f,l_reg=0.f;f32x16 o[2];o[0]=f32x16{};o[1]=f32x16{};
  const int qrel=wid*QBLK+r32; float nm=ckl[q0+qrel];
  #define CMASK(P0,P1,t) do{int jb_=(t)-(NT-4); if(jb_>=0)cmask(P0,P1,jb_,qrel,hi);}while(0)
  bool resc=false;
  #define START(P0,P1) do{ const float rm=rowmax(P0,P1); resc=false; \
    { const float dl=__builtin_fmaxf(rm,0.f); mhat=fadd_s(mhat,dl); nm=fsub_s(nm,dl); \
      _Pragma("unroll") for(int r=0;r<16;++r){P0[r]=fsub_s(P0[r],dl);P1[r]=fsub_s(P1[r],dl);} } \
    _Pragma("unroll") for(int r=0;r<16;++r)P0[r]=__builtin_amdgcn_exp2f(P0[r]); }while(0)
  #define RESC() do{ if(resc){ asm volatile("s_waitcnt lgkmcnt(0)":::"memory"); \
      _Pragma("unroll") for(int d_=0;d_<2;++d_) _Pragma("unroll") for(int r=0;r<16;++r)o[d_][r]*=wsf[crow(r,hi)]; } }while(0)
  f32x16 pA0,pA1,pB0,pB1;
  int sl_prev=0,sl_cur=0,sl_next=SLOTB;
  #define ROT() do{sl_prev=sl_cur;sl_cur=sl_next;sl_next=(sl_next==(NSLOT-1)*SLOTB)?0:sl_next+SLOTB;}while(0)
  DMA_K(2,2*SLOTB);
  WAIT_BAR(3);
  BIASINIT(pA0,pA1,0); qkt(pA0,pA1,Kbase,qr,r32,hi);asm volatile("s_nop 15\n\ts_nop 7":"+v"(pA0),"+v"(pA1));CMASK(pA0,pA1,0);
  START(pA0,pA1);
  _Pragma("unroll") for(int r=0;r<16;++r)pA1[r]=__builtin_amdgcn_exp2f(pA1[r]);
  WAIT_BAR(0);
  DMA_K(3,0);DMA_V(1,SLOTB);
  ROT();
  kload8(kf,kp0+sl_cur);
  WAIT_BAR(2);
  s16x4 vlo[8],vhi[8]; u32x4 pw0,pw1,pw2,pw3;
  #define PKW(P,B) cvtpk_s(P[B],P[B+1])
  #define PAF(k) __builtin_bit_cast(bf16x8,pw##k)
  #define VFR(i) (bf16x8){vlo[i][0],vlo[i][1],vlo[i][2],vlo[i][3],vhi[i][0],vhi[i][1],vhi[i][2],vhi[i][3]}
  #define PIN(x) asm volatile("":"+v"(x))
  #define MX3(a,b,c) __builtin_fmaxf(__builtin_fmaxf((a),(b)),(c))
  #define GAPA(MF,A0,A1,A2,A3,W0,W1,PW) do{ MF; sacc+=A0; sacc+=A1; sacc+=A2; sacc+=A3; PIN(sacc); W0; W1; PIN(PW); SBAR(); }while(0)
  #define EX(v) __builtin_amdgcn_exp2f(v)
  #define GAPB(MF,X,B) do{ MF; X[B]=EX(X[B]); X[B+1]=EX(X[B+1]); X[B+2]=EX(X[B+2]); X[B+3]=EX(X[B+3]); PIN(X); SBAR(); }while(0)
  #define VRD(i) do{ vlo[i]=vtr(vp_+(((i)>>2)*4096+((i)&3)*1024)); vhi[i]=vtr(vp_+(((i)>>2)*4096+((i)&3)*1024+512)); }while(0)
  #define KRD(G,j) do{ if(G){ kload2(kf,kp0+sl_next,j); SBAR(); } }while(0)
  #define STEP(C0,C1,P0,P1,t,GK,GV,GL) do{ SBAR(); \
    BIASINIT(C0,C1,t); SBAR(); \
    const lds_cptr vp_=vp0+sl_prev; \
    VRD(0); SBAR(); float sacc=(P0[0]+P0[1]); \
    GAPA(C0=__builtin_amdgcn_mfma_f32_32x32x16_bf16(kf[0],qr[0],C0,0,0,0), P0[2],P0[3],P0[4],P0[5],     pw0[0]=PKW(P0,0), pw0[1]=PKW(P0,2), pw0); \
    VRD(4); SBAR(); GAPA(C1=__builtin_amdgcn_mfma_f32_32x32x16_bf16(kf[1],qr[0],C1,0,0,0), P0[6],P0[7],P0[8],P0[9],     pw0[2]=PKW(P0,4), pw0[3]=PKW(P0,6), pw0); \
    VRD(1); SBAR(); GAPA(C0=__builtin_amdgcn_mfma_f32_32x32x16_bf16(kf[2],qr[1],C0,0,0,0),   P0[10],P0[11],P0[12],P0[13], pw1[0]=PKW(P0,8), pw1[1]=PKW(P0,10), pw1); \
    VRD(5); SBAR(); GAPA(C1=__builtin_amdgcn_mfma_f32_32x32x16_bf16(kf[3],qr[1],C1,0,0,0),   P0[14],P0[15],P1[0],P1[1],   pw1[2]=PKW(P0,12),pw1[3]=PKW(P0,14), pw1); \
    VRD(2); SBAR(); GAPA(C0=__builtin_amdgcn_mfma_f32_32x32x16_bf16(kf[4],qr[2],C0,0,0,0),   P1[2],P1[3],P1[4],P1[5],     pw2[0]=PKW(P1,0), pw2[1]=PKW(P1,2), pw2); \
    VRD(6); SBAR(); GAPA(C1=__builtin_amdgcn_mfma_f32_32x32x16_bf16(kf[5],qr[2],C1,0,0,0),   P1[6],P1[7],P1[8],P1[9],     pw2[2]=PKW(P1,4), pw2[3]=PKW(P1,6), pw2); \
    VRD(3); SBAR(); GAPA(C0=__builtin_amdgcn_mfma_f32_32x32x16_bf16(kf[6],qr[3],C0,0,0,0),   P1[10],P1[11],P1[12],P1[13], pw3[0]=PKW(P1,8), pw3[1]=PKW(P1,10), pw3); \
    VRD(7); SBAR(); GAPA(C1=__builtin_amdgcn_mfma_f32_32x32x16_bf16(kf[7],qr[3],C1,0,0,0),   P1[14],P1[15],0.f,0.f,       pw3[2]=PKW(P1,12),pw3[3]=PKW(P1,14), pw3); \
    l_reg+=sacc; \
    if(GK){DMA_K((t)+3,sl_cur);} if(GV){DMA_V((t)+1,sl_next);} \
    CMASK(C0,C1,t); \
    { float a=MX3(C0[0],C0[1],C1[0]),b=MX3(C0[2],C0[3],C1[1]); a=MX3(a,C1[2],C1[3]); \
      _Pragma("unroll") for(int r=4;r<16;r+=4){a=MX3(a,C0[r],C0[r+1]);b=MX3(b,C0[r+2],C0[r+3]);a=MX3(a,C1[r],C1[r+1]);b=MX3(b,C1[r+2],C1[r+3]);} \
      float rm=__builtin_fmaxf(a,b); { auto rr=__builtin_amdgcn_permlane32_swap(__float_as_uint(rm),__float_as_uint(rm),false,false); rm=__builtin_fmaxf(__uint_as_float(rr[0]),__uint_as_float(rr[1])); } \
      resc=false; \
      if(__builtin_expect(__any(rm>(float)THRL),0)){ const float dl=__builtin_fmaxf(rm,0.f); mhat+=dl; nm-=dl; \
        _Pragma("unroll") for(int r=0;r<16;++r){C0[r]-=dl;C1[r]-=dl;} \
        const float f=__builtin_amdgcn_exp2f(-dl); l_reg*=f; if(hi==0)wsf[r32]=f; resc=true; } } \
    SBAR(); \
    GAPB(o[0]=__builtin_amdgcn_mfma_f32_32x32x16_bf16(PAF(0),VFR(0),o[0],0,0,0), C0,0); \
    GAPB(o[1]=__builtin_amdgcn_mfma_f32_32x32x16_bf16(PAF(0),VFR(4),o[1],0,0,0), C0,4); \
    KRD(GL,0); GAPB(o[0]=__builtin_amdgcn_mfma_f32_32x32x16_bf16(PAF(1),VFR(1),o[0],0,0,0), C0,8); \
    KRD(GL,1); GAPB(o[1]=__builtin_amdgcn_mfma_f32_32x32x16_bf16(PAF(1),VFR(5),o[1],0,0,0), C0,12); \
    KRD(GL,2); GAPB(o[0]=__builtin_amdgcn_mfma_f32_32x32x16_bf16(PAF(2),VFR(2),o[0],0,0,0), C1,0); \
    KRD(GL,3); GAPB(o[1]=__builtin_amdgcn_mfma_f32_32x32x16_bf16(PAF(2),VFR(6),o[1],0,0,0), C1,4); \
    GAPB(o[0]=__builtin_amdgcn_mfma_f32_32x32x16_bf16(PAF(3),VFR(3),o[0],0,0,0), C1,8); \
    GAPB(o[1]=__builtin_amdgcn_mfma_f32_32x32x16_bf16(PAF(3),VFR(7),o[1],0,0,0), C1,12); \
    }while(0)
  int t=1;
  #undef CMASK
  #define CMASK(P0,P1,t) do{}while(0)
  for(;t+5<NT;t+=2){
    STEP(pB0,pB1,pA0,pA1,t,true,true,true);     WAIT_BAR(2); RESC(); ROT();
    STEP(pA0,pA1,pB0,pB1,t+1,true,true,true);   WAIT_BAR(2); RESC(); ROT();
  }
  #undef CMASK
  #define CMASK(P0,P1,t) do{int jb_=(t)-(NT-4); if(jb_>=0)cmask(P0,P1,jb_,qrel,hi);}while(0)
  #define ENDW(tt) do{ if((tt)+3<NT){WAIT_BAR(2);} else if((tt)+2<NT){WAIT_BAR(1);} else {WAIT_BAR(0);} }while(0)
  for(;t+1<NT;t+=2){
    STEP(pB0,pB1,pA0,pA1,t,(t+3<NT),(t+1<NT),(t+1<NT));       ENDW(t);   RESC(); ROT();
    STEP(pA0,pA1,pB0,pB1,t+1,(t+4<NT),(t+2<NT),(t+2<NT));     ENDW(t+1); RESC(); ROT();
  }
  STEP(pB0,pB1,pA0,pA1,NT-1,false,false,false); RESC();
  { float sacc=pB0[0]+pB0[1]; _Pragma("unroll") for(int r=2;r<16;++r)sacc+=pB0[r]; _Pragma("unroll") for(int r=0;r<16;++r)sacc+=pB1[r]; l_reg+=sacc;
    pw0=(u32x4){PKW(pB0,0),PKW(pB0,2),PKW(pB0,4),PKW(pB0,6)};pw1=(u32x4){PKW(pB0,8),PKW(pB0,10),PKW(pB0,12),PKW(pB0,14)};pw2=(u32x4){PKW(pB1,0),PKW(pB1,2),PKW(pB1,4),PKW(pB1,6)};pw3=(u32x4){PKW(pB1,8),PKW(pB1,10),PKW(pB1,12),PKW(pB1,14)};
    SBAR(); pv(o,vb0+sl_cur,PAF(0),PAF(1),PAF(2),PAF(3)); }
  #undef PKW
  #undef PAF
  #undef VFR
  #undef PIN
  #undef MX3
  #undef GAPA
  #undef GAPB
  #undef EX
  #undef VRD
  #undef KRD
  #undef STEP
  #undef ENDW
  {auto rr=__builtin_amdgcn_permlane32_swap(__float_as_uint(l_reg),__float_as_uint(l_reg),false,false);l_reg=__uint_as_float(rr[0])+__uint_as_float(rr[1]);}
  if(hi==0)wsf[32+r32]=l_reg;asm volatile("s_waitcnt lgkmcnt(0)":::"memory");
  float rli[16];
  #pragma unroll
  for(int r=0;r<16;++r)rli[r]=__builtin_amdgcn_rcpf(wsf[32+crow(r,hi)]);
  bf16*Ow=O+(rowbase+q0+wid*QBLK)*DM+h*D;
  { bf16*stg=(bf16*)(shm+LDS_OST)+wid*2048;
    #pragma unroll
    for(int r=0;r<16;++r){const int orow=crow(r,hi);
      #pragma unroll
      for(int d0=0;d0<2;++d0)stg[orow*64+d0*32+r32]=__float2bfloat16(o[d0][r]*rli[r]);}
    asm volatile("s_waitcnt lgkmcnt(0)":::"memory");
    #pragma unroll
    for(int i=0;i<4;++i){const int row=i*8+(lane>>3),ch=lane&7; const u32x4 v=*(const u32x4*)(stg+row*64+ch*8); ATTN_STORE16(Ow+(long)row*DM+ch*8,v);} }
  asm volatile("s_waitcnt lgkmcnt(0)\n\ts_barrier":::"memory");
  #undef DMA_K
  #undef DMA_V
  #undef CMASK
  #undef START
  #undef RESC
  #undef ROT
}
constexpr int ATTN_LDS_BYTES=LDS_BYTES;
struct AttnTensors { const bf16* Q; const bf16* K; const bf16* V; bf16* O; };
struct AttnUnit { int bh; int qb; };
#undef BIASINIT
#undef SBAR
#undef WAIT_BAR
}
namespace cg = cooperative_groups;
constexpr int NWAVES = 8;
constexpr int BATCH = 4, SEQ = 4096, D = 1024, M = BATCH * SEQ, FF = 4096, DEPTH = 4, NIN = 3072, WIN_LD = 3088;
constexpr int N_PHASES = 26;
#ifndef PROBE_DUP
#define PROBE_DUP -1
#endif
#ifndef MK_ONE_LAUNCH
#define MK_ONE_LAUNCH 1
#endif
constexpr size_t MiB = 1u << 20;
constexpr size_t WS_SSQ = 0;
constexpr size_t WS_SMALL = 1 * MiB;
constexpr size_t WS_BAR = 3 * MiB, BAR_ZERO_BYTES = 16384;
constexpr size_t WS_EB = 2 * MiB;
constexpr size_t WS_W = 4 * MiB, W_STRIDE = 25 * MiB;
constexpr size_t W_IN = 0, W_SM = 6 * MiB, W_O = 7 * MiB, W_UP = 9 * MiB, W_DN = 17 * MiB;
constexpr size_t WS_HB = 54 * MiB;
constexpr size_t WS_Q = 86 * MiB, WS_K = 118 * MiB, WS_V = 150 * MiB, WS_LS = 182 * MiB;
constexpr size_t WS_U = 86 * MiB;
constexpr size_t WS_END = 246 * MiB;
constexpr int LDS_BYTES = 147456;
constexpr int CKL_OFF = 86016;
static_assert(attn_body::ATTN_LDS_BYTES <= CKL_OFF && CKL_OFF + 16384 <= 131072, "LDS map");

#define LAS __attribute__((address_space(3)))
typedef unsigned short bf16;
typedef unsigned v4u __attribute__((ext_vector_type(4)));
typedef unsigned v2u __attribute__((ext_vector_type(2)));
typedef float f32x4 __attribute__((ext_vector_type(4)));
typedef short bf16x8 __attribute__((ext_vector_type(8)));
#define LDS_WAIT() asm volatile("s_waitcnt lgkmcnt(0)" ::: "memory")
__device__ __forceinline__ unsigned pk2(float lo, float hi) { return pg8::cvt_pk_bf16(lo, hi); }
__device__ __forceinline__ float bf2f(unsigned short v) { return __uint_as_float((unsigned)v << 16); }
__device__ __forceinline__ float bflo(unsigned w) { return __uint_as_float(w << 16); }
__device__ __forceinline__ float bfhi(unsigned w) { return __uint_as_float(w & 0xffff0000u); }
__device__ __forceinline__ float log_sigmoid(float x) { return __builtin_fminf(x, 0.f) - log1pf(__expf(-__builtin_fabsf(x))); }
__device__ __forceinline__ float wave_sum(float v) {
#pragma unroll
    for (int o = 1; o < 64; o <<= 1) v += __shfl_xor(v, o);
    return v;
}

#define XB_TMO      128
#define XB_XCNT(j)  (256  + 64 * (j))
#define XB_XSUB(j)  (1280 + 64 * (j))
#define XB_XGEN(j)  (2304 + 64 * (j))
#define XB_TOP      3328
#define XB_TOPGEN   3392
#define XCD_BAR_WORDS 3456
#define XB_SPIN_CAP (1u << 18)

__device__ __forceinline__ unsigned xb_ld(unsigned* p)              { return __hip_atomic_load(p, __ATOMIC_RELAXED, __HIP_MEMORY_SCOPE_AGENT); }
__device__ __forceinline__ unsigned xb_add(unsigned* p, unsigned v) { return __hip_atomic_fetch_add(p, v, __ATOMIC_RELAXED, __HIP_MEMORY_SCOPE_AGENT); }
__device__ __forceinline__ unsigned xb_xcc_id() { return (unsigned)__builtin_amdgcn_s_getreg((3 << 11) | 20) & 0xFu; }
#define XB_SPIN(cond, bar) do { unsigned _sp = 0; while (cond) { __builtin_amdgcn_s_sleep(1); \
    if ((++_sp & 255u) == 0u) { if (xb_ld(&(bar)[XB_TMO])) break; if (_sp > XB_SPIN_CAP) { atomicAdd(&(bar)[XB_TMO], 1u); break; } } } } while (0)

struct XcdBarrier {
    unsigned* bar; unsigned x;
    volatile LAS unsigned* st;
};

__device__ __forceinline__ XcdBarrier xcd_barrier_post(unsigned* bar, volatile LAS unsigned* st) {
    XcdBarrier b; b.bar = bar; b.x = xb_xcc_id(); b.st = st;
    if (threadIdx.x == 0) (void)xb_add(&bar[XB_XCNT(b.x)], 1u);
    return b;
}
__device__ __forceinline__ void xcd_barrier_complete(unsigned* bar, unsigned x, unsigned& nloc, unsigned& nx) {
    const unsigned G = gridDim.x * gridDim.y * gridDim.z;
    unsigned sum, cnt, mine, sp = 0u;
    for (;;) {
        sum = 0u; cnt = 0u; mine = 0u;
#pragma unroll
        for (unsigned j = 0; j < 16; ++j) { const unsigned c = xb_ld(&bar[XB_XCNT(j)]); sum += c; cnt += (c > 0u) ? 1u : 0u; mine = (j == x) ? c : mine; }
        if (sum == G) break;
        __builtin_amdgcn_s_sleep(1);
        if ((++sp & 255u) == 0u) { if (xb_ld(&bar[XB_TMO])) break; if (sp > XB_SPIN_CAP) { atomicAdd(&bar[XB_TMO], 1u); break; } }
    }
    nloc = mine > 0u ? mine : 1u; nx = cnt > 0u ? cnt : 1u;
}

__device__ __forceinline__ void xcd_barrier(const XcdBarrier& b) {
    asm volatile("s_waitcnt vmcnt(0)" ::: "memory");
    __syncthreads();
    if (threadIdx.x == 0) {
        unsigned* bar = b.bar;
        __builtin_amdgcn_s_waitcnt(0);
        unsigned nloc = b.st[0], nx = b.st[1];
        if (nloc == 0u) { xcd_barrier_complete(bar, b.x, nloc, nx); b.st[0] = nloc; b.st[1] = nx; }
        const unsigned old = xb_add(&bar[XB_XSUB(b.x)], 1u);
        const unsigned gen = old / nloc;
        if (old + 1u == (gen + 1u) * nloc) {
            __builtin_amdgcn_fence(__ATOMIC_RELEASE, "agent");
            asm volatile("s_waitcnt vmcnt(0)" ::: "memory");
            const unsigned og = xb_add(&bar[XB_TOP], 1u);
            const unsigned tg = og / nx;
            if (og + 1u == (tg + 1u) * nx) xb_add(&bar[XB_TOPGEN], 1u);
            else XB_SPIN(xb_ld(&bar[XB_TOPGEN]) == tg, bar);
            __builtin_amdgcn_fence(__ATOMIC_ACQUIRE, "agent");
            xb_add(&bar[XB_XGEN(b.x)], 1u);
            asm volatile("s_waitcnt vmcnt(0)" ::: "memory");
        } else {
            XB_SPIN(xb_ld(&bar[XB_XGEN(b.x)]) == gen, bar);
            __builtin_amdgcn_fence(__ATOMIC_ACQUIRE, "agent");
            asm volatile("s_waitcnt vmcnt(0)" ::: "memory");
        }
    }
    __syncthreads();
}

struct Args { const float* in[14]; float* out; unsigned char* ws; int ph_lo, ph_hi; };

__device__ __forceinline__ void transpose_item(const float* W, int ldw, int src_col0, const float* gain, bf16* WT, int K, int dst_row0, int nblk, LAS float* scr, int item, int lane) {
    const int kb = item / nblk, nb = item % nblk, k0 = 64 * kb, n0 = 32 * nb;
#pragma unroll 8
    for (int i = 0; i < 32; ++i) { const int kk = 2 * i + (lane >> 5); float w = W[(size_t)(k0 + kk) * ldw + src_col0 + n0 + (lane & 31)]; if (gain) w *= gain[k0 + kk]; scr[kk * 33 + (lane & 31)] = w; }
    LDS_WAIT(); asm volatile("" ::: "memory");
    const int c = lane & 7;
#pragma unroll
    for (int j = 0; j < 4; ++j) { const int n = (lane >> 3) + 8 * j; const LAS float* s = scr + (8 * c) * 33 + n;
        v4u o; o.x = pk2(s[0 * 33], s[1 * 33]); o.y = pk2(s[2 * 33], s[3 * 33]); o.z = pk2(s[4 * 33], s[5 * 33]); o.w = pk2(s[6 * 33], s[7 * 33]);
        *(v4u*)(WT + (size_t)(dst_row0 + n0 + n) * K + k0 + 8 * c) = o; }
    LDS_WAIT(); asm volatile("" ::: "memory");
}

__device__ __forceinline__ void convert_layer_weights(const Args& a, int L, LAS unsigned char* lds, int gw, int NGW, int wave, int lane) {
    LAS float* scr = (LAS float*)(lds + wave * 16384);
    unsigned char* wb = a.ws + WS_W + (size_t)(L & 1) * W_STRIDE;
    const int j = L >> 1; const bool fox = (L & 1) == 0;
    const float* Win = (fox ? a.in[1] : a.in[4]) + (size_t)j * D * WIN_LD;
    const float* Wo = (fox ? a.in[3] : a.in[8]) + (size_t)j * D * D;
    const float* Wup = a.in[9] + (size_t)L * D * FF; const float* Wdn = a.in[10] + (size_t)L * FF * D;
    const float* gmix = a.in[11] + L * D; const float* gmlp = a.in[12] + L * D;
    const int colB = fox ? 2048 : 2064, colS = fox ? 3072 : 2048;
    constexpr int I_A = 16 * 64, I_B = 16 * 32, I_O = 16 * 32, I_U = 16 * 128, I_D = 64 * 32, NITEMS = I_A + I_B + I_O + I_U + I_D;
    for (int it = gw; it < NITEMS; it += NGW) {
        int r = it;
        if (r < I_A) { transpose_item(Win, WIN_LD, 0, gmix, (bf16*)(wb + W_IN), D, 0, 64, scr, r, lane); continue; } r -= I_A;
        if (r < I_B) { transpose_item(Win, WIN_LD, colB, gmix, (bf16*)(wb + W_IN), D, 2048, 32, scr, r, lane); continue; } r -= I_B;
        if (r < I_O) { transpose_item(Wo, D, 0, nullptr, (bf16*)(wb + W_O), D, 0, 32, scr, r, lane); continue; } r -= I_O;
        if (r < I_U) { transpose_item(Wup, FF, 0, gmlp, (bf16*)(wb + W_UP), D, 0, 128, scr, r, lane); continue; } r -= I_U;
        transpose_item(Wdn, D, 0, nullptr, (bf16*)(wb + W_DN), FF, 0, 32, scr, r, lane);
    }
    bf16* wsm = (bf16*)(wb + W_SM);
    for (int e = gw * 64 + lane; e < 16 * D; e += NGW * 64) { const int k = e >> 4, n = e & 15; wsm[n * D + k] = (bf16)(pk2(Win[(size_t)k * WIN_LD + colS + n] * gmix[k], 0.f) & 0xffffu); }
}

namespace gla {
constexpr int H = 4, DK = 128, DV = 256, C = 64, NCH = SEQ / C;
constexpr int VT_LD = 72, KT_LD = 72, QT_LD = 136;
__device__ __forceinline__ f32x4 mfma16(bf16x8 a, bf16x8 b, f32x4 c) { return __builtin_amdgcn_mfma_f32_16x16x32_bf16(a, b, c, 0, 0, 0); }
__device__ __forceinline__ void stage_vT(const bf16* vsrc, LAS bf16* VT, int tid) {
#pragma unroll
    for (int c = 0; c < 4; ++c) { const int idx = tid + 512 * c, t = idx >> 5, d8 = idx & 31; const v4u w = *(const v4u*)(vsrc + (size_t)t * 1024 + d8 * 8);
        LAS bf16* p = VT + (d8 * 8) * VT_LD + t;
        p[0 * VT_LD] = (bf16)(w.x & 0xffffu); p[1 * VT_LD] = (bf16)(w.x >> 16); p[2 * VT_LD] = (bf16)(w.y & 0xffffu); p[3 * VT_LD] = (bf16)(w.y >> 16);
        p[4 * VT_LD] = (bf16)(w.z & 0xffffu); p[5 * VT_LD] = (bf16)(w.z >> 16); p[6 * VT_LD] = (bf16)(w.w & 0xffffu); p[7 * VT_LD] = (bf16)(w.w >> 16); }
}
__device__ __forceinline__ void g1_unit(int u, const bf16* QK, bf16* QKout, const bf16* V, const float* zlr, const float* wg, const float* bg, bf16* LS, float* EB, LAS unsigned char* lds, int tid, int wave, int lane) {
    const int b = u >> 8, j = (u >> 2) & 63, h = u & 3, lsid = (b * 4 + h) * 64 + j; const size_t tok0 = (size_t)b * SEQ + 64 * j;
    LAS bf16* KT = (LAS bf16*)lds; LAS bf16* VT = (LAS bf16*)(lds + 18432); LAS float* ZL = (LAS float*)(lds + 55296); LAS float* TOT = (LAS float*)(lds + 59392); LAS float* EBL = (LAS float*)(lds + 61440);
    const int d = tid & 127, tq = tid >> 7;
    if (tid < 256) ((LAS f32x4*)ZL)[tid] = ((const f32x4*)(zlr + tok0 * 16))[tid];
    float w[16];
#pragma unroll
    for (int r = 0; r < 16; ++r) w[r] = wg[r * 512 + h * 128 + d];
    const float bgd = bg[h * 128 + d];
    stage_vT(V + tok0 * 1024 + h * 256, VT, tid);
    __syncthreads();
    float bc[16]; float run = 0.f;
#pragma unroll
    for (int i = 0; i < 16; ++i) { const int t = 16 * tq + i; float z = bgd;
#pragma unroll
        for (int r4 = 0; r4 < 4; ++r4) { const f32x4 zz = ((const LAS f32x4*)ZL)[t * 4 + r4]; z += zz[0] * w[4 * r4] + zz[1] * w[4 * r4 + 1] + zz[2] * w[4 * r4 + 2] + zz[3] * w[4 * r4 + 3]; }
        run += log_sigmoid(z) * (1.0f / 16.0f); bc[i] = run; }
    TOT[tq * 128 + d] = run;
    __syncthreads();
    float pre = 0.f, blast = 0.f;
#pragma unroll
    for (int q = 0; q < 4; ++q) { const float tv = TOT[q * 128 + d]; if (q < tq) pre += tv; blast += tv; }
    const float eblast = __expf(blast);
    if (tq == 0) { EB[(size_t)lsid * 128 + d] = eblast; EBL[d] = eblast; }
    unsigned kpk[8];
    const bf16* qp = QK + tok0 * 1024 + h * 128 + d; bf16* qo = QKout + tok0 * 1024 + h * 128 + d;
#pragma unroll
    for (int i = 0; i < 16; i += 2) {
        float kt2[2];
#pragma unroll
        for (int e = 0; e < 2; ++e) { const int t = 16 * tq + i + e; const float bb = bc[i + e] + pre; const float eb = __expf(bb);
            const float qv = bf2f(qp[(size_t)t * 1024]), kv = bf2f(qp[(size_t)t * 1024 + 512]);
            const float qt = qv * eb * 0.08838834764831845f, kt = kv * __builtin_amdgcn_rcpf(eb);
            const unsigned pq = pk2(qt, kt); qo[(size_t)t * 1024] = (bf16)(pq & 0xffffu); qo[(size_t)t * 1024 + 512] = (bf16)(pq >> 16); kt2[e] = kt; }
        kpk[i >> 1] = pk2(kt2[0], kt2[1]); }
    { LAS v4u* kd = (LAS v4u*)(KT + d * KT_LD + 16 * tq); kd[0] = (v4u){kpk[0], kpk[1], kpk[2], kpk[3]}; kd[1] = (v4u){kpk[4], kpk[5], kpk[6], kpk[7]}; }
    __syncthreads();
    const int fr = lane & 15, fq = lane >> 4;
    f32x4 acc[2][8];
#pragma unroll
    for (int mt = 0; mt < 2; ++mt)
#pragma unroll
        for (int nt = 0; nt < 8; ++nt) acc[mt][nt] = (f32x4){0.f, 0.f, 0.f, 0.f};
#pragma unroll
    for (int ks = 0; ks < 2; ++ks) { bf16x8 vf[2];
#pragma unroll
        for (int mt = 0; mt < 2; ++mt) vf[mt] = *(const LAS bf16x8*)(VT + (32 * wave + 16 * mt + fr) * VT_LD + ks * 32 + fq * 8);
#pragma unroll
        for (int nt = 0; nt < 8; ++nt) { const bf16x8 kf = *(const LAS bf16x8*)(KT + (16 * nt + fr) * KT_LD + ks * 32 + fq * 8);
#pragma unroll
            for (int mt = 0; mt < 2; ++mt) acc[mt][nt] = mfma16(kf, vf[mt], acc[mt][nt]); } }
    bf16* lsp = LS + (size_t)lsid * 32768;
#pragma unroll
    for (int nt = 0; nt < 8; ++nt) { const f32x4 e4 = *(const LAS f32x4*)(EBL + 16 * nt + 4 * fq);
#pragma unroll
        for (int mt = 0; mt < 2; ++mt) { const f32x4 v = acc[mt][nt] * e4; v2u o; o.x = pk2(v[0], v[1]); o.y = pk2(v[2], v[3]);
            *(v2u*)(lsp + (size_t)(32 * wave + 16 * mt + fr) * 128 + 16 * nt + 4 * fq) = o; } }
    __syncthreads();
}
__device__ __forceinline__ void g2_scan(bf16* LS, const float* EB, int gtid, int nthreads) {
    for (int e = gtid; e < 16 * 8192; e += nthreads) { const int bh = e >> 13, off = (e & 8191) * 4;
        bf16* base = LS + (size_t)bh * 64 * 32768 + off; const float* ebp = EB + (size_t)bh * 64 * 128 + (off & 127);
        f32x4 S = (f32x4){0.f, 0.f, 0.f, 0.f};
#pragma unroll 9
        for (int j = 0; j < 63; ++j) { const v2u l = *(const v2u*)(base + (size_t)j * 32768); const f32x4 a = *(const f32x4*)(ebp + j * 128);
            S[0] = a[0] * S[0] + bflo(l.x); S[1] = a[1] * S[1] + bfhi(l.x); S[2] = a[2] * S[2] + bflo(l.y); S[3] = a[3] * S[3] + bfhi(l.y);
            v2u o; o.x = pk2(S[0], S[1]); o.y = pk2(S[2], S[3]); *(v2u*)(base + (size_t)j * 32768) = o; } }
}
__device__ __forceinline__ void g3_unit(int u, const bf16* QK, const bf16* V, const bf16* R, bf16* Rout, const bf16* LS, const float* gnorm, LAS unsigned char* lds, int tid, int wave, int lane) {
    const int b = u >> 8, j = (u >> 2) & 63, h = u & 3, lsid = (b * 4 + h) * 64 + j; const size_t tok0 = (size_t)b * SEQ + 64 * j;
    LAS bf16* QT = (LAS bf16*)lds; LAS bf16* KT = (LAS bf16*)(lds + 17408); LAS bf16* VT = (LAS bf16*)(lds + 34816); LAS bf16* AT = (LAS bf16*)(lds + 71680); LAS float* RS = (LAS float*)(lds + 80896);
#pragma unroll
    for (int c = 0; c < 2; ++c) { const int idx = tid + 512 * c, t = idx >> 4, c8 = idx & 15; const bf16* src = QK + (tok0 + t) * 1024 + h * 128 + c8 * 8;
        *(LAS v4u*)(QT + t * QT_LD + c8 * 8) = *(const v4u*)src; *(LAS v4u*)(KT + t * QT_LD + c8 * 8) = *(const v4u*)(src + 512); }
    stage_vT(V + tok0 * 1024 + h * 256, VT, tid);
    __syncthreads();
    const int fr = lane & 15, fq = lane >> 4, tm = wave >> 1, hh = wave & 1;
#pragma unroll
    for (int e = 0; e < 2; ++e) { const int sn = 2 * hh + e; f32x4 a = (f32x4){0.f, 0.f, 0.f, 0.f};
        if (sn <= tm) {
#pragma unroll
            for (int ks = 0; ks < 4; ++ks) { const bf16x8 qf = *(const LAS bf16x8*)(QT + (16 * tm + fr) * QT_LD + ks * 32 + fq * 8); const bf16x8 kf = *(const LAS bf16x8*)(KT + (16 * sn + fr) * QT_LD + ks * 32 + fq * 8);
                a = mfma16(kf, qf, a); }
#pragma unroll
            for (int i = 0; i < 4; ++i) if (16 * sn + 4 * fq + i > 16 * tm + fr) a[i] = 0.f; }
        v2u o; o.x = pk2(a[0], a[1]); o.y = pk2(a[2], a[3]); *(LAS v2u*)(AT + (16 * tm + fr) * VT_LD + 16 * sn + 4 * fq) = o; }
    __syncthreads();
    f32x4 acc[8];
#pragma unroll
    for (int nt = 0; nt < 8; ++nt) acc[nt] = (f32x4){0.f, 0.f, 0.f, 0.f};
#pragma unroll
    for (int ks = 0; ks < 2; ++ks) { const bf16x8 af = *(const LAS bf16x8*)(AT + (16 * tm + fr) * VT_LD + ks * 32 + fq * 8);
#pragma unroll
        for (int nt = 0; nt < 8; ++nt) { const bf16x8 vf = *(const LAS bf16x8*)(VT + (128 * hh + 16 * nt + fr) * VT_LD + ks * 32 + fq * 8); acc[nt] = mfma16(vf, af, acc[nt]); } }
    if (j > 0) { const bf16* sp = LS + (size_t)(lsid - 1) * 32768 + (size_t)(128 * hh + fr) * 128 + fq * 8;
#pragma unroll
        for (int ks = 0; ks < 4; ++ks) { const bf16x8 qf = *(const LAS bf16x8*)(QT + (16 * tm + fr) * QT_LD + ks * 32 + fq * 8);
#pragma unroll
            for (int nt = 0; nt < 8; ++nt) { const bf16x8 sf = *(const bf16x8*)(sp + (size_t)nt * 16 * 128 + ks * 32); acc[nt] = mfma16(sf, qf, acc[nt]); } } }
    float ss = 0.f;
#pragma unroll
    for (int nt = 0; nt < 8; ++nt) ss += (acc[nt][0] * acc[nt][0] + acc[nt][1] * acc[nt][1]) + (acc[nt][2] * acc[nt][2] + acc[nt][3] * acc[nt][3]);
    ss += __shfl_xor(ss, 16); ss += __shfl_xor(ss, 32);
    if (fq == 0) RS[(16 * tm + fr) * 2 + hh] = ss;
    __syncthreads();
    const float rinv = __builtin_amdgcn_rsqf((RS[(16 * tm + fr) * 2] + RS[(16 * tm + fr) * 2 + 1]) * (1.0f / 256.0f) + 1e-6f);
    const size_t roff = (tok0 + 16 * tm + fr) * 1024 + h * 256 + 128 * hh + 4 * fq; const bf16* rp = R + roff; bf16* ro = Rout + roff;
#pragma unroll
    for (int nt = 0; nt < 8; ++nt) { const f32x4 gn = *(const f32x4*)(gnorm + 128 * hh + 16 * nt + 4 * fq); const v2u rw = *(const v2u*)(rp + 16 * nt);
        const float r0 = bflo(rw.x), r1 = bfhi(rw.x), r2 = bflo(rw.y), r3 = bfhi(rw.y);
        const float o0 = acc[nt][0] * rinv * gn[0] * r0 * __builtin_amdgcn_rcpf(1.f + __expf(-r0)), o1 = acc[nt][1] * rinv * gn[1] * r1 * __builtin_amdgcn_rcpf(1.f + __expf(-r1));
        const float o2 = acc[nt][2] * rinv * gn[2] * r2 * __builtin_amdgcn_rcpf(1.f + __expf(-r2)), o3 = acc[nt][3] * rinv * gn[3] * r3 * __builtin_amdgcn_rcpf(1.f + __expf(-r3));
        v2u o; o.x = pk2(o0, o1); o.y = pk2(o2, o3); *(v2u*)(ro + 16 * nt) = o; }
    __syncthreads();
}
}

#define SEAM() do { if (ph + 1 < hi) { if (ph == 0) grid.sync(); else xcd_barrier(bar); } } while (0)
template <int L> __device__ __forceinline__ void run_layer(const Args& args, cg::grid_group& grid, const XcdBarrier& bar, LAS unsigned char* lds, unsigned char* lds_raw, int lo, int hi) {
    const int G = gridDim.x, bx = blockIdx.x, vcu = (G % 8 == 0) ? (bx % 8) * (G / 8) + bx / 8 : bx, NGW = G * NWAVES;
    unsigned char* ws = args.ws;
    float* ssqp = (float*)(ws + WS_SSQ); float* smallb = (float*)(ws + WS_SMALL); float* EB = (float*)(ws + WS_EB);
    bf16* HB = (bf16*)(ws + WS_HB); bf16* QB = (bf16*)(ws + WS_Q); bf16* KB = (bf16*)(ws + WS_K); bf16* VB = (bf16*)(ws + WS_V); bf16* LS = (bf16*)(ws + WS_LS); bf16* UB = (bf16*)(ws + WS_U);
    float* Hres = args.out;
    int ph = 1 + (L / 2) * 12 + (L % 2) * 5;
#define THREAD_VARS() int tid = threadIdx.x; asm volatile("" : "+v"(tid)); const int lane = tid & 63, wave = __builtin_amdgcn_readfirstlane(tid >> 6), gw = vcu * NWAVES + wave; (void)lane; (void)gw

        const bool fox = (L & 1) == 0; const int jl = L >> 1;
        unsigned char* wb = ws + WS_W + (size_t)(L & 1) * W_STRIDE;
        if (ph >= lo && ph < hi) { THREAD_VARS();
            if (L == 1 || L == 2) { convert_layer_weights(args, L + 1, lds, gw, NGW, wave, lane); __syncthreads(); }
            pg8::Gemm g{HB, (const bf16*)(wb + W_IN), M, NIN, D}; pg8::StaticOrder S; S.init(M, NIN, G, bx);
            pg8::EpiScaleBf16<0> E{QB, D, ssqp, D, (size_t)(WS_K - WS_Q) / 2, fox ? attn_body::C2 : 1.0f};
            for (int rep_ = 0; rep_ < (ph == PROBE_DUP ? 2 : 1); ++rep_)
            pg8::gemm_phase<pg8::EpiScaleBf16<0>, pg8::StaticOrder, PG8_ALIGN, PG8_SP2>(lds, g, S, E);
            const bf16* wsm = (const bf16*)(wb + W_SM); const int fr = lane & 15, fq = lane >> 4;
            for (int task = gw; task < M / 16; task += NGW) { const int row = task * 16 + fr;
                const bf16* ap = HB + (size_t)row * D + fq * 8; const bf16* bp = wsm + fr * D + fq * 8; f32x4 acc = (f32x4){0.f, 0.f, 0.f, 0.f};
#pragma unroll 8
                for (int s = 0; s < 32; ++s) { const bf16x8 av = *(const bf16x8*)(ap + s * 32); const bf16x8 bv = *(const bf16x8*)(bp + s * 32); acc = __builtin_amdgcn_mfma_f32_16x16x32_bf16(bv, av, acc, 0, 0, 0); }
                const float rs = pg8::row_rstd(ssqp, row); *(f32x4*)(smallb + (size_t)row * 16 + 4 * fq) = acc * rs; }
            SEAM();
        }
        ++ph;
        if (fox) {
            if (ph >= lo && ph < hi) { THREAD_VARS();
                LAS float* ckl = (LAS float*)(lds + CKL_OFF); LAS float* wtot = (LAS float*)(lds + CKL_OFF + 16384);
                const float* bf_ = args.in[2] + jl * 16;
                for (int rep_ = 0; rep_ < (ph == PROBE_DUP ? 2 : 1); ++rep_)
                for (int w = vcu; w < 256; w += G) { const int bh = w >> 2, s4 = w & 3, b = bh >> 4, h = bh & 15;
                    __syncthreads();
                    { const float bfh = bf_[h]; const float* fp = smallb + ((size_t)b * SEQ + 8 * tid) * 16 + h; float v[8]; float run = 0.f;
#pragma unroll
                        for (int i = 0; i < 8; ++i) { run += log_sigmoid(fp[i * 16] + bfh); v[i] = run; }
                        float tot = run;
#pragma unroll
                        for (int o = 1; o < 64; o <<= 1) { const float t = __shfl_up(tot, o); if (lane >= o) tot += t; }
                        if (lane == 63) wtot[wave] = tot;
                        __syncthreads();
                        float basev = tot - run;
                        for (int w2 = 0; w2 < wave; ++w2) basev += wtot[w2];
#pragma unroll
                        for (int i = 0; i < 8; ++i) ckl[8 * tid + i] = (basev + v[i]) * 1.4426950408889634f;
                        __syncthreads(); }
#pragma nounroll
                    for (int i = 0; i < 4; ++i) { const int qb = (i == 0) ? s4 : (i == 1) ? 7 - s4 : (i == 2) ? 8 + s4 : 15 - s4;
                        attn_body::attn_unit<8>(b, h, qb, (const attn_body::bf16*)QB, (const attn_body::bf16*)KB, (const attn_body::bf16*)VB, (attn_body::bf16*)((ph == PROBE_DUP && rep_ == 0) ? HB : QB), (char*)lds_raw, (attn_body::lds_cfptr)ckl); } }
                SEAM();
            }
            ++ph;
        } else {
            if (ph >= lo && ph < hi) { THREAD_VARS();
                for (int rep_ = 0; rep_ < (ph == PROBE_DUP ? 2 : 1); ++rep_)
                for (int u = bx; u < 1024; u += G) gla::g1_unit(u, QB, (ph == PROBE_DUP && rep_ == 0) ? HB : QB, KB, smallb, args.in[5] + (size_t)jl * 16 * 512, args.in[6] + jl * 512, LS, EB, lds, tid, wave, lane);
                SEAM();
            }
            ++ph;
            if (ph >= lo && ph < hi) { THREAD_VARS(); gla::g2_scan(LS, EB, bx * 512 + tid, G * 512); SEAM(); }
            ++ph;
            if (ph >= lo && ph < hi) { THREAD_VARS();
                for (int rep_ = 0; rep_ < (ph == PROBE_DUP ? 2 : 1); ++rep_)
                for (int u = bx; u < 1024; u += G) gla::g3_unit(u, QB, KB, VB, (ph == PROBE_DUP && rep_ == 0) ? HB : VB, LS, args.in[7] + jl * 256, lds, tid, wave, lane);
                SEAM();
            }
            ++ph;
        }
        if (ph >= lo && ph < hi) { THREAD_VARS();
            pg8::Gemm g{fox ? QB : VB, (const bf16*)(wb + W_O), M, D, D}; pg8::StaticOrder S; S.init(M, D, G, bx);
            for (int rep_ = 0; rep_ < (ph == PROBE_DUP ? 2 : 1); ++rep_) {
            pg8::EpiRes E{L == 0 ? args.in[0] : Hres, (ph == PROBE_DUP && rep_ == 0) ? (float*)LS : Hres, HB, ssqp, D};
            pg8::gemm_phase<pg8::EpiRes, pg8::StaticOrder, PG8_ALIGN, PG8_SP2>(lds, g, S, E); }
            SEAM();
        }
        ++ph;
        if (ph >= lo && ph < hi) { THREAD_VARS();
            pg8::Gemm g{HB, (const bf16*)(wb + W_UP), M, FF, D}; pg8::StaticOrder S; S.init(M, FF, G, bx);
            pg8::EpiScaleBf16<2> E{UB, FF, ssqp, 0, 0, 1.f};
            for (int rep_ = 0; rep_ < (ph == PROBE_DUP ? 2 : 1); ++rep_)
            pg8::gemm_phase<pg8::EpiScaleBf16<2>, pg8::StaticOrder, PG8_ALIGN, PG8_SP2>(lds, g, S, E);
            SEAM();
        }
        ++ph;
        if (ph >= lo && ph < hi) { THREAD_VARS();
            pg8::Gemm g{UB, (const bf16*)(wb + W_DN), M, D, FF}; pg8::StaticOrder S; S.init(M, D, G, bx);
            pg8::EpiRes E{Hres, Hres, HB, ssqp, D};
            pg8::gemm_phase<pg8::EpiRes, pg8::StaticOrder, PG8_ALIGN, PG8_SP2>(lds, g, S, E);
            SEAM();
        }
        ++ph;
    }
#undef SEAM
#undef THREAD_VARS
__global__ void __launch_bounds__(NWAVES * 64, 2) fwd_megakernel(Args args) {
    extern __shared__ __attribute__((aligned(16))) unsigned char lds_raw[];
    cg::grid_group grid = cg::this_grid();
    LAS unsigned char* lds = (LAS unsigned char*)lds_raw;
    const int tid = threadIdx.x, lane = tid & 63, wave = __builtin_amdgcn_readfirstlane(tid >> 6);
    const int G = gridDim.x, bx = blockIdx.x, vcu = (G % 8 == 0) ? (bx % 8) * (G / 8) + bx / 8 : bx;
    const int gw = vcu * NWAVES + wave, NGW = G * NWAVES;
    unsigned char* ws = args.ws;
    float* ssqp = (float*)(ws + WS_SSQ); float* smallb = (float*)(ws + WS_SMALL); float* EB = (float*)(ws + WS_EB);
    bf16* HB = (bf16*)(ws + WS_HB); bf16* QB = (bf16*)(ws + WS_Q); bf16* KB = (bf16*)(ws + WS_K); bf16* VB = (bf16*)(ws + WS_V); bf16* LS = (bf16*)(ws + WS_LS); bf16* UB = (bf16*)(ws + WS_U);
    float* Hres = args.out;
    const int lo = args.ph_lo, hi = args.ph_hi;
    int ph = 0;
    volatile LAS unsigned* bst = (volatile LAS unsigned*)(lds + 131072 + 64);
    if (tid < 2) bst[tid] = 0u;
    __syncthreads();
    const XcdBarrier bar = xcd_barrier_post((unsigned*)(ws + WS_BAR), bst);
#define SEAM() do { if (ph + 1 < hi) { if (ph == 0) grid.sync(); else xcd_barrier(bar); } } while (0)

    if (ph >= lo && ph < hi) {
        convert_layer_weights(args, 0, lds, gw, NGW, wave, lane);
        convert_layer_weights(args, 1, lds, gw, NGW, wave, lane);
        const float* x = args.in[0];
        for (int m = gw; m < M; m += NGW) { const f32x4* xr = (const f32x4*)(x + (size_t)m * D) + lane; f32x4 v[4]; float s = 0.f;
#pragma unroll
            for (int jj = 0; jj < 4; ++jj) { v[jj] = xr[64 * jj]; s += (v[jj][0] * v[jj][0] + v[jj][1] * v[jj][1]) + (v[jj][2] * v[jj][2] + v[jj][3] * v[jj][3]); }
            s = wave_sum(s);
            v2u* o8 = (v2u*)(HB + (size_t)m * D) + lane;
#pragma unroll
            for (int jj = 0; jj < 4; ++jj) { v2u o; o.x = pk2(v[jj][0], v[jj][1]); o.y = pk2(v[jj][2], v[jj][3]); o8[64 * jj] = o; }
            if (lane < 16) ssqp[(size_t)m * 16 + lane] = (lane == 0) ? s : 0.f; }
        SEAM();
    }
    ++ph;

    run_layer<0>(args, grid, bar, lds, lds_raw, lo, hi); run_layer<1>(args, grid, bar, lds, lds_raw, lo, hi); run_layer<2>(args, grid, bar, lds, lds_raw, lo, hi); run_layer<3>(args, grid, bar, lds, lds_raw, lo, hi);
    ph = N_PHASES - 1;
    if (ph >= lo && ph < hi) {
        const float* gf = args.in[13];
        for (int m = gw; m < M; m += NGW) { f32x4* xr = (f32x4*)(Hres + (size_t)m * D) + lane; const float rs = pg8::row_rstd(ssqp, m);
#pragma unroll
            for (int jj = 0; jj < 4; ++jj) { const f32x4 gv = ((const f32x4*)gf)[64 * jj + lane]; xr[64 * jj] = xr[64 * jj] * rs * gv; } }
    }
#undef SEAM
}

extern "C" void kernel_launch(void* const* d_in, const int* in_sizes, int n_in, void* d_out, int out_size, void* d_ws, size_t ws_size, hipStream_t stream) {
    static int grid = 0;
    if (grid == 0) {
        if (n_in != 14 || out_size != M * D || ws_size < WS_END) { fprintf(stderr, "kernel_launch: unexpected shapes (n_in %d, out %d, ws %zu)\n", n_in, out_size, ws_size); grid = -1; return; }
        int dev = 0, cus = 0, per_cu = 0;
        (void)hipGetDevice(&dev); (void)hipDeviceGetAttribute(&cus, hipDeviceAttributeMultiprocessorCount, dev);
        if (hipFuncSetAttribute((const void*)fwd_megakernel, hipFuncAttributeMaxDynamicSharedMemorySize, LDS_BYTES) != hipSuccess) { fprintf(stderr, "kernel_launch: hipFuncSetAttribute failed\n"); grid = -1; return; }
        if (hipOccupancyMaxActiveBlocksPerMultiprocessor(&per_cu, (const void*)fwd_megakernel, NWAVES * 64, LDS_BYTES) != hipSuccess || per_cu < 1) { fprintf(stderr, "kernel_launch: occupancy query says %d blocks per CU\n", per_cu); per_cu = 1; }
        (void)hipGetLastError();
        grid = cus * (per_cu < 1 ? 1 : per_cu);
        if (grid > 256) grid = 256;
    }
    if (grid < 0) return;
    (void)hipMemsetAsync((char*)d_ws + WS_BAR, 0, BAR_ZERO_BYTES, stream);
    Args a{};
    for (int i = 0; i < 14; ++i) a.in[i] = (const float*)d_in[i];
    a.out = (float*)d_out; a.ws = (unsigned char*)d_ws;
#if MK_ONE_LAUNCH
    a.ph_lo = 0; a.ph_hi = N_PHASES;
    void* kargs[] = {&a};
    hipError_t e = hipLaunchCooperativeKernel((const void*)fwd_megakernel, dim3(grid), dim3(NWAVES * 64), kargs, LDS_BYTES, stream);
    if (e != hipSuccess) fprintf(stderr, "kernel_launch: cooperative launch failed: %s (grid %d)\n", hipGetErrorString(e), grid);
#else
    for (int p = 0; p < N_PHASES; ++p) { a.ph_lo = p; a.ph_hi = p + 1; hipLaunchKernelGGL(fwd_megakernel, dim3(grid), dim3(NWAVES * 64), LDS_BYTES, stream, a); }
#endif
}
```

```cpp
#include <hip/hip_cooperative_groups.h>
#include <hip/hip_runtime.h>
#include <cstdio>
#include <cstdint>
namespace pg8 {
#define PG8_LAS __attribute__((address_space(3)))
typedef unsigned short bf16_t;
typedef short bf16x8 __attribute__((ext_vector_type(8)));
typedef float f32x4 __attribute__((ext_vector_type(4)));
typedef unsigned u32x4 __attribute__((ext_vector_type(4)));
constexpr int BM = 256, BK = 64, HALF = 128, HTB = HALF * BK * 2  , STAGE_BYTES = 8 * HTB, NXCD = 8, WGM = 8;

__host__ __device__ __forceinline__ int lds_byte(int r, int c) { const int st = (r >> 4) * 2 + (c >> 5), rr = r & 15, cc = c & 31, ob = rr * 64 + cc * 2; return st * 1024 + (ob ^ (((ob >> 9) & 1) << 5)); }
__host__ __device__ __forceinline__ void stage_rc(int b, int& R, int& C) { const int st = b / 1024, sb = b % 1024, swz = sb ^ (((sb >> 9) & 1) << 5); R = (st >> 1) * 16 + swz / 64; C = (st & 1) * 32 + (swz % 64) / 2; }
__host__ __device__ __forceinline__ int perm32(int rho) { const int n = rho >> 4, i = rho & 15; return 8 * (i >> 2) + 4 * n + (i & 3); }

struct Unit { int pm, pn; };
struct Gemm { const bf16_t* A; const bf16_t* Bt; int M, N, K; };

struct StaticOrder {
    int nM, nN, nwg, G, c;
    __host__ __device__ void init(int M, int N, int G_, int c_) { nM = M / BM; nN = N / BM; nwg = nM * nN; G = G_; c = c_; }
    __host__ __device__ bool next(int i, Unit& u) const {
        const long L = (long)i * G + c; if (L >= nwg) return false;
        int wgid = (int)L; { const int q = nwg / NXCD, r = nwg % NXCD, xcd = wgid % NXCD, off = wgid / NXCD; wgid = (xcd < r ? xcd * (q + 1) : r * (q + 1) + (xcd - r) * q) + off; }
        const int nig = WGM * nN, gid = wgid / nig, fm = gid * WGM, gsz = (nM - fm) < WGM ? (nM - fm) : WGM;
        u.pm = fm + ((wgid % nig) % gsz); u.pn = (wgid % nig) / gsz; return true;
    }
    __device__ __forceinline__ void a_ready(const Unit&) const {}
    __device__ __forceinline__ void done(const Unit&) const {}
};

__device__ __forceinline__ unsigned cvt_pk_bf16(float lo, float hi) { unsigned r; asm volatile("v_cvt_pk_bf16_f32 %0, %1, %2" : "=v"(r) : "v"(lo), "v"(hi)); return r; }
typedef float f32x2 __attribute__((ext_vector_type(2)));
typedef unsigned u32x2 __attribute__((ext_vector_type(2)));
__device__ __forceinline__ float row_rstd(const float* ssqp, int row) {
    const f32x4* p = (const f32x4*)(ssqp + (size_t)row * 16);
    const f32x4 a = p[0], b = p[1], c = p[2], d = p[3];
    const f32x4 s = (a + b) + (c + d);
    const float t = (s[0] + s[1]) + (s[2] + s[3]);
    return __builtin_amdgcn_rsqf(t * (1.0f / 1024.0f) + 1e-6f);
}
template <int ACT> struct EpiScaleBf16 {
    static constexpr bool PERM = true, AFTER_DRAIN = false;
    bf16_t* O; int ldc; const float* ssqp; int split_cols; size_t split_stride; float scale0;
    __device__ __forceinline__ void operator()(const f32x4 (&acc)[2][2][4][2], const Unit& u, int wr, int wc, int fr, int fq) const {
        const int row0 = u.pm * BM + wr * 64 + fr; int colt = u.pn * BM; bf16_t* base = O;
        float sc = 1.f; if (split_cols) { const int t = colt / split_cols; base += (size_t)t * split_stride; colt -= t * split_cols; if (t == 0) sc = scale0; }
        const int col0 = colt + wc * 32 + 8 * fq;
        f32x4 pq[2][4]; float rsv[2][4];
#pragma unroll
        for (int ai = 0; ai < 2; ++ai)
#pragma unroll
            for (int m = 0; m < 4; ++m) pq[ai][m] = *(const f32x4*)(ssqp + (size_t)(row0 + ai * HALF + m * 16) * 16 + 4 * fq);
#pragma unroll
        for (int ai = 0; ai < 2; ++ai)
#pragma unroll
            for (int m = 0; m < 4; ++m) { float t = (pq[ai][m][0] + pq[ai][m][1]) + (pq[ai][m][2] + pq[ai][m][3]); t += __shfl_xor(t, 16); t += __shfl_xor(t, 32);
                rsv[ai][m] = __builtin_amdgcn_rsqf(t * (1.0f / 1024.0f) + 1e-6f) * sc; }
#pragma unroll
        for (int ai = 0; ai < 2; ++ai)
#pragma unroll
            for (int m = 0; m < 4; ++m) { const int row = row0 + ai * HALF + m * 16; const float rs = rsv[ai][m]; bf16_t* rowp = base + (size_t)row * ldc + col0;
#pragma unroll
                for (int bj = 0; bj < 2; ++bj) { f32x4 v0 = acc[ai][bj][m][0] * rs, v1 = acc[ai][bj][m][1] * rs;
                    if (ACT == 2) {
#pragma unroll
                        for (int e = 0; e < 4; ++e) { const float a = __builtin_fmaxf(v0[e], 0.f), b = __builtin_fmaxf(v1[e], 0.f); v0[e] = a * a; v1[e] = b * b; } }
                    u32x4 w; w.x = cvt_pk_bf16(v0[0], v0[1]); w.y = cvt_pk_bf16(v0[2], v0[3]); w.z = cvt_pk_bf16(v1[0], v1[1]); w.w = cvt_pk_bf16(v1[2], v1[3]);
                    *(u32x4*)(rowp + bj * HALF) = w; } }
    }
};
struct EpiRes {
    static constexpr bool PERM = false, AFTER_DRAIN = false;
    const float* base; float* out; bf16_t* hb; float* ssqp; int ldc;
    __device__ __forceinline__ void operator()(const f32x4 (&acc)[2][2][4][2], const Unit& u, int wr, int wc, int fr, int fq) const {
        const int col0 = u.pn * BM + wc * 32 + 4 * fq;
#pragma unroll
        for (int ai = 0; ai < 2; ++ai)
#pragma unroll
            for (int m = 0; m < 4; ++m) { const int r = u.pm * BM + ai * HALF + wr * 64 + m * 16 + fr; const size_t off = (size_t)r * ldc + col0; float q = 0.f;
#pragma unroll
                for (int bj = 0; bj < 2; ++bj)
#pragma unroll
                    for (int n = 0; n < 2; ++n) { const f32x4 bs = *(const f32x4*)(base + off + bj * HALF + n * 16); const f32x4 o = bs + acc[ai][bj][m][n];
                        *(f32x4*)(out + off + bj * HALF + n * 16) = o; q += (o[0] * o[0] + o[1] * o[1]) + (o[2] * o[2] + o[3] * o[3]);
                        u32x2 w; w.x = cvt_pk_bf16(o[0], o[1]); w.y = cvt_pk_bf16(o[2], o[3]); *(u32x2*)(hb + off + bj * HALF + n * 16) = w; }
                q += __shfl_xor(q, 16); q += __shfl_xor(q, 32);
                if (fq == 0) ssqp[(size_t)r * 16 + u.pn * 4 + wc] = q;
                if (m & 1) asm volatile("" ::: "memory"); }
    }
};

template <class Epi, class Sched, bool ALIGN_EPI = false, bool SP2 = false>
__device__ __forceinline__ void gemm_phase(PG8_LAS unsigned char* lds, const Gemm g, const Sched& S, const Epi& E) {
    int tid = threadIdx.x; asm volatile("" : "+v"(tid)); const int wid = __builtin_amdgcn_readfirstlane(tid >> 6), lane = tid & 63, wr = wid >> 2, wc = wid & 3, fr = lane & 15, fq = lane >> 4;
    const int K = g.K, nt = K / BK;
    unsigned voffA[2], voffB[2];
#pragma unroll
    for (int i = 0; i < 2; ++i) { int R, C; stage_rc(tid * 16 + i * 8192, R, C); const int Rb = Epi::PERM ? ((R & ~31) + perm32(R & 31)) : R;
        voffA[i] = (unsigned)(R * K + C) * 2u; voffB[i] = (unsigned)(Rb * K + C) * 2u; }
    const size_t kstep = (size_t)(BK * 2);
    const size_t hstep = (size_t)HALF * K * 2;
    const size_t tstep = 2 * hstep;
    const unsigned ldsw = (unsigned)wid * 1024u;
    const int aoff = lds_byte(wr * 64 + fr, fq * 8), boff = lds_byte(wc * 32 + fr, fq * 8);
#define PG8_SA(b, h) (((b) * 2 + (h)) * HTB)
#define PG8_SB(b, h) ((4 + (b) * 2 + (h)) * HTB)
#define PG8_STAGE(bufoff, gbase, voff) do { _Pragma("unroll") for (int _i = 0; _i < 2; ++_i) \
        __builtin_amdgcn_global_load_lds((const unsigned*)((const char*)(gbase) + (voff)[_i]), (PG8_LAS unsigned*)(lds + (bufoff) + ldsw + _i * 8192), 16, 0, 0); } while (0)
#define PG8_LDA(dst, b, h) do { _Pragma("unroll") for (int m = 0; m < 4; ++m) _Pragma("unroll") for (int k = 0; k < 2; ++k) dst[m][k] = *(const PG8_LAS bf16x8*)(lds + PG8_SA(b, h) + aoff + m * 2048 + k * 1024); } while (0)
#define PG8_LDB(dst, b, h) do { _Pragma("unroll") for (int n = 0; n < 2; ++n) _Pragma("unroll") for (int k = 0; k < 2; ++k) dst[n][k] = *(const PG8_LAS bf16x8*)(lds + PG8_SB(b, h) + boff + n * 2048 + k * 1024); } while (0)
#define PG8_MMA(ai, bj, At, Bt) do { __builtin_amdgcn_s_setprio(1); _Pragma("unroll") for (int m = 0; m < 4; ++m) _Pragma("unroll") for (int n = 0; n < 2; ++n) _Pragma("unroll") for (int k = 0; k < 2; ++k) \
        acc[ai][bj][m][n] = __builtin_amdgcn_mfma_f32_16x16x32_bf16(Bt[n][k], At[m][k], acc[ai][bj][m][n], 0, 0, 0); __builtin_amdgcn_s_setprio(0); } while (0)
#define PG8_WAIT_V(n) asm volatile("s_waitcnt vmcnt(" #n ")" ::: "memory")
#define PG8_WAIT_L(n) asm volatile("s_waitcnt lgkmcnt(" #n ")" ::: "memory")
#define PG8_BAR __builtin_amdgcn_s_barrier()
#define PG8_SCHED __builtin_amdgcn_sched_barrier(0)
    Unit cur, nxt; int ui = 0;
    if (!S.next(0, cur)) return;
    f32x4 acc[2][2][4][2];
#pragma unroll
    for (int a = 0; a < 2; ++a)
#pragma unroll
        for (int b = 0; b < 2; ++b)
#pragma unroll
            for (int m = 0; m < 4; ++m)
#pragma unroll
                for (int n = 0; n < 2; ++n) acc[a][b][m][n] = (f32x4){0.f, 0.f, 0.f, 0.f};
    bf16x8 At[4][2], B0[2][2], B1[2][2];
    const char* cA = (const char*)g.A + (size_t)cur.pm * tstep; const char* cB = (const char*)g.Bt + (size_t)cur.pn * tstep;
    S.a_ready(cur);
    if constexpr (SP2) {
        PG8_STAGE(PG8_SB(0, 0), cB, voffB); PG8_STAGE(PG8_SB(0, 1), cB + hstep, voffB); PG8_STAGE(PG8_SA(0, 0), cA, voffA); PG8_STAGE(PG8_SA(0, 1), cA + hstep, voffA);
        if (wr == 1) PG8_BAR;
        PG8_WAIT_V(2); PG8_BAR;
        PG8_STAGE(PG8_SB(1, 0), cB + kstep, voffB); PG8_STAGE(PG8_SA(1, 0), cA + kstep, voffA); PG8_STAGE(PG8_SB(1, 1), cB + hstep + kstep, voffB);
        PG8_WAIT_V(6); PG8_BAR;
    } else {
        PG8_STAGE(PG8_SB(0, 0), cB, voffB); PG8_STAGE(PG8_SA(0, 0), cA, voffA); PG8_STAGE(PG8_SB(0, 1), cB + hstep, voffB); PG8_STAGE(PG8_SA(0, 1), cA + hstep, voffA);
        if (wr == 1) PG8_BAR;
        PG8_WAIT_V(4); PG8_BAR;
        PG8_STAGE(PG8_SB(1, 0), cB + kstep, voffB); PG8_STAGE(PG8_SA(1, 0), cA + kstep, voffA); PG8_STAGE(PG8_SB(1, 1), cB + hstep + kstep, voffB);
        PG8_WAIT_V(6); PG8_BAR;
    }
    for (;;) {
        const bool has_next = S.next(ui + 1, nxt);
        const char* nA = has_next ? (const char*)g.A + (size_t)nxt.pm * tstep : cA; const char* nB = has_next ? (const char*)g.Bt + (size_t)nxt.pn * tstep : cB;
        for (int t = 0; t < nt; t += 2) {
            const bool last = (t == nt - 2);
            const char* a1 = cA + (size_t)(t + 1) * kstep;
            const char* a2 = last ? nA : cA + (size_t)(t + 2) * kstep; const char* b2 = last ? nB : cB + (size_t)(t + 2) * kstep;
            const char* a3 = a2 + kstep; const char* b3 = b2 + kstep;
            if (last && has_next) S.a_ready(nxt);
            if constexpr (SP2) {
            PG8_LDB(B0, 0, 0); PG8_LDB(B1, 0, 1); PG8_SCHED; PG8_LDA(At, 0, 0); PG8_STAGE(PG8_SA(1, 1), a1 + hstep, voffA);
            PG8_WAIT_V(8); PG8_WAIT_L(0); PG8_BAR; PG8_MMA(0, 0, At, B0); PG8_MMA(0, 1, At, B1); PG8_BAR; PG8_SCHED;
            PG8_LDA(At, 0, 1); PG8_STAGE(PG8_SB(0, 0), b2, voffB); PG8_STAGE(PG8_SB(0, 1), b2 + hstep, voffB); PG8_STAGE(PG8_SA(0, 0), a2, voffA);
            PG8_WAIT_V(8); PG8_WAIT_L(0); PG8_BAR; PG8_MMA(1, 0, At, B0); PG8_MMA(1, 1, At, B1); PG8_BAR; PG8_SCHED;
            PG8_LDB(B0, 1, 0); PG8_LDB(B1, 1, 1); PG8_SCHED; PG8_LDA(At, 1, 0); PG8_STAGE(PG8_SA(0, 1), a2 + hstep, voffA);
            PG8_WAIT_V(8); PG8_WAIT_L(0); PG8_BAR; PG8_MMA(0, 0, At, B0); PG8_MMA(0, 1, At, B1); PG8_BAR; PG8_SCHED;
            PG8_LDA(At, 1, 1); PG8_STAGE(PG8_SB(1, 0), b3, voffB); PG8_STAGE(PG8_SB(1, 1), b3 + hstep, voffB); PG8_STAGE(PG8_SA(1, 0), a3, voffA);
            PG8_WAIT_V(8); PG8_WAIT_L(0); PG8_BAR; PG8_MMA(1, 0, At, B0); PG8_MMA(1, 1, At, B1); PG8_BAR; PG8_SCHED;
            } else {
            PG8_LDB(B0, 0, 0); PG8_SCHED; PG8_LDA(At, 0, 0); PG8_STAGE(PG8_SA(1, 1), a1 + hstep, voffA);
            PG8_WAIT_L(8); PG8_BAR; PG8_WAIT_L(0); PG8_MMA(0, 0, At, B0); PG8_BAR; PG8_SCHED;
            PG8_LDB(B1, 0, 1); PG8_STAGE(PG8_SB(0, 0), b2, voffB);
            PG8_BAR; PG8_WAIT_L(0); PG8_MMA(0, 1, At, B1); PG8_BAR;
            PG8_LDA(At, 0, 1); PG8_STAGE(PG8_SA(0, 0), a2, voffA);
            PG8_BAR; PG8_WAIT_L(0); PG8_MMA(1, 0, At, B0); PG8_BAR; PG8_SCHED;
            PG8_STAGE(PG8_SB(0, 1), b2 + hstep, voffB);
            PG8_WAIT_V(6); PG8_BAR; PG8_MMA(1, 1, At, B1); PG8_BAR;
            PG8_LDB(B0, 1, 0); PG8_SCHED; PG8_LDA(At, 1, 0); PG8_STAGE(PG8_SA(0, 1), a2 + hstep, voffA);
            PG8_WAIT_L(8); PG8_BAR; PG8_WAIT_L(0); PG8_MMA(0, 0, At, B0); PG8_BAR; PG8_SCHED;
            PG8_LDB(B1, 1, 1); PG8_STAGE(PG8_SB(1, 0), b3, voffB);
            PG8_BAR; PG8_WAIT_L(0); PG8_MMA(0, 1, At, B1); PG8_BAR;
            PG8_LDA(At, 1, 1); PG8_STAGE(PG8_SA(1, 0), a3, voffA);
            PG8_BAR; PG8_WAIT_L(0); PG8_MMA(1, 0, At, B0); PG8_BAR; PG8_SCHED;
            PG8_STAGE(PG8_SB(1, 1), b3 + hstep, voffB);
            PG8_WAIT_V(6); PG8_BAR; PG8_MMA(1, 1, At, B1); PG8_BAR;
            }
        }
        if constexpr (ALIGN_EPI) { if (wr == 0) PG8_BAR; }
        if constexpr (!Epi::AFTER_DRAIN) { E(acc, cur, wr, wc, fr, fq); S.done(cur); }
        if (!has_next) break;
#pragma unroll
        for (int a = 0; a < 2; ++a)
#pragma unroll
            for (int b = 0; b < 2; ++b)
#pragma unroll
                for (int m = 0; m < 4; ++m)
#pragma unroll
                    for (int n = 0; n < 2; ++n) acc[a][b][m][n] = (f32x4){0.f, 0.f, 0.f, 0.f};
        cur = nxt; cA = nA; cB = nB; ++ui;
        if constexpr (ALIGN_EPI) { if (wr == 1) PG8_BAR; }
    }
    PG8_WAIT_V(0);
    if constexpr (!ALIGN_EPI) { if (wr == 0) PG8_BAR; }
    PG8_BAR;
    if constexpr (Epi::AFTER_DRAIN) { E.fused(acc, cur, wr, wc, fr, fq, lds, wid, lane); S.done(cur); }
#undef PG8_SA
#undef PG8_SB
#undef PG8_STAGE
#undef PG8_LDA
#undef PG8_LDB
#undef PG8_MMA
#undef PG8_WAIT_V
#undef PG8_WAIT_L
#undef PG8_BAR
#undef PG8_SCHED
}
}

#ifndef PG8_SP2
#define PG8_SP2 true
#endif
#ifndef PG8_ALIGN
#define PG8_ALIGN true
#endif
#include <hip/hip_bf16.h>
#include <cmath>
namespace attn_body {
using bf16=__hip_bfloat16;
using bf16x8=__attribute__((ext_vector_type(8)))short;
using s16x4=__attribute__((ext_vector_type(4)))short;
using f32x16=__attribute__((ext_vector_type(16)))float;
using u32x4=__attribute__((ext_vector_type(4)))unsigned;
constexpr int BATCH=4,NHEAD=16,SEQ=4096,D=64,DM=NHEAD*D;
constexpr int NW=8,QBLK=32,QB=QBLK*NW,KVBLK=64,NQB=SEQ/QB;
constexpr int ATTN_PITCH=DM, ATTN_UNIT_ROWS=QB;
__device__ __forceinline__ int crow(int r,int hi){return (r&3)+8*(r>>2)+4*hi;}
#define SBAR() __builtin_amdgcn_sched_barrier(0)
__device__ __forceinline__ void cmask(f32x16&p0,f32x16&p1,int jb,int qrel,int hi){
  const float NEG=-INFINITY; int kb=64*jb+4*hi;
  #pragma unroll
  for(int r=0;r<16;++r){int kv=kb+(r&3)+8*(r>>2); if(kv>qrel)p0[r]=NEG; if(kv+32>qrel)p1[r]=NEG;}
}

constexpr int NSLOT=3, SLOTB=8192;
constexpr int LDS_K=0, LDS_V=NSLOT*SLOTB, LDS_WS=2*NSLOT*SLOTB, LDS_OST=LDS_WS+NW*64*4, LDS_BYTES=LDS_OST+NW*4096;
constexpr float C2=0.125f*1.4426950408889634f;
__device__ __forceinline__ void glds16(const void*gsrc,unsigned lds_dst){unsigned keep;
  asm volatile("s_mov_b32 %0, m0\n\ts_mov_b32 m0, %2\n\ts_nop 0\n\tglobal_load_lds_dwordx4 %1, off\n\ts_mov_b32 m0, %0":"=&s"(keep):"v"(gsrc),"s"(lds_dst):"memory");}
__device__ __forceinline__ float max3f(float a,float b,float c){float r;asm("v_max3_f32 %0, %1, %2, %3":"=v"(r):"v"(a),"v"(b),"v"(c));return r;}
__device__ __forceinline__ float max2f(float a,float b){float r;asm("v_max_f32_e32 %0, %1, %2":"=v"(r):"v"(a),"v"(b));return r;}
__device__ __forceinline__ float fadd_s(float a,float b){float r;asm("v_add_f32_e32 %0, %1, %2":"=v"(r):"v"(a),"v"(b));return r;}
__device__ __forceinline__ float fsub_s(float a,float b){float r;asm("v_sub_f32_e32 %0, %1, %2":"=v"(r):"v"(a),"v"(b));return r;}
typedef float f32x2_t __attribute__((ext_vector_type(2))); typedef __bf16 bf16x2_t __attribute__((ext_vector_type(2)));
__device__ __forceinline__ unsigned cvtpk_s(float lo,float hi){f32x2_t v={lo,hi};bf16x2_t b=__builtin_convertvector(v,bf16x2_t);return __builtin_bit_cast(unsigned,b);}
#define WAIT_BAR(N) asm volatile("s_waitcnt vmcnt(" #N ") lgkmcnt(0)\n\ts_barrier":::"memory")

__device__ __forceinline__ void qkt(f32x16&p0,f32x16&p1,const char*Kslot,const bf16x8*qr,int r32,int hi){
  const char*kb=Kslot+hi*1024+r32*16;
  #pragma unroll
  for(int d0=0;d0<4;++d0){
    const bf16x8 b0=*reinterpret_cast<const bf16x8*>(kb+d0*2048);
    const bf16x8 b1=*reinterpret_cast<const bf16x8*>(kb+d0*2048+512);
    {p0=__builtin_amdgcn_mfma_f32_32x32x16_bf16(b0,qr[d0],p0,0,0,0);p1=__builtin_amdgcn_mfma_f32_32x32x16_bf16(b1,qr[d0],p1,0,0,0);}}
}
typedef __attribute__((address_space(3))) const char* lds_cptr;
typedef short v4i16_t __attribute__((ext_vector_type(4)));
__device__ __forceinline__ void kload8(bf16x8*kf,lds_cptr kp){
  kf[0]=*(const __attribute__((address_space(3))) bf16x8*)(kp);      kf[1]=*(const __attribute__((address_space(3))) bf16x8*)(kp+512);
  kf[2]=*(const __attribute__((address_space(3))) bf16x8*)(kp+2048); kf[3]=*(const __attribute__((address_space(3))) bf16x8*)(kp+2560);
  kf[4]=*(const __attribute__((address_space(3))) bf16x8*)(kp+4096); kf[5]=*(const __attribute__((address_space(3))) bf16x8*)(kp+4608);
  kf[6]=*(const __attribute__((address_space(3))) bf16x8*)(kp+6144); kf[7]=*(const __attribute__((address_space(3))) bf16x8*)(kp+6656);
}
__device__ __forceinline__ void kload2(bf16x8*kf,lds_cptr kp,int j){ kf[2*j]=*(const __attribute__((address_space(3))) bf16x8*)(kp+j*2048); kf[2*j+1]=*(const __attribute__((address_space(3))) bf16x8*)(kp+j*2048+512); }
__device__ __forceinline__ s16x4 vtr(lds_cptr p){ return __builtin_bit_cast(s16x4,__builtin_amdgcn_ds_read_tr16_b64_v4i16((__attribute__((address_space(3))) v4i16_t*)p)); }
__device__ __forceinline__ float rowmax(const f32x16&p0,const f32x16&p1){
  float a=max3f(p0[0],p0[1],p1[0]),b=max3f(p0[2],p0[3],p1[1]);a=max3f(a,p1[2],p1[3]);
  #pragma unroll
  for(int r=4;r<16;r+=4){a=max3f(a,p0[r],p0[r+1]);b=max3f(b,p0[r+2],p0[r+3]);a=max3f(a,p1[r],p1[r+1]);b=max3f(b,p1[r+2],p1[r+3]);}
  const float m=max2f(a,b);
  auto rr=__builtin_amdgcn_permlane32_swap(__float_as_uint(m),__float_as_uint(m),false,false);
  return max2f(__uint_as_float(rr[0]),__uint_as_float(rr[1]));
}
__device__ __forceinline__ void pv(f32x16*o,int vb,bf16x8 pa0,bf16x8 pa1,bf16x8 pa2,bf16x8 pa3){
  #pragma unroll
  for(int d0=0;d0<2;++d0){s16x4 lo[4],hi[4];
    #pragma unroll
    for(int ks=0;ks<4;++ks){
      asm volatile("ds_read_b64_tr_b16 %0,%1 offset:%c2":"=&v"(lo[ks]):"v"(vb),"i"(d0*4096+ks*1024):"memory");
      asm volatile("ds_read_b64_tr_b16 %0,%1 offset:%c2":"=&v"(hi[ks]):"v"(vb),"i"(d0*4096+ks*1024+512):"memory");}
    asm volatile("s_waitcnt lgkmcnt(0)":::"memory");SBAR();
    #define PK(k) (bf16x8){lo[k][0],lo[k][1],lo[k][2],lo[k][3],hi[k][0],hi[k][1],hi[k][2],hi[k][3]}
    o[d0]=__builtin_amdgcn_mfma_f32_32x32x16_bf16(pa0,PK(0),o[d0],0,0,0);
    o[d0]=__builtin_amdgcn_mfma_f32_32x32x16_bf16(pa1,PK(1),o[d0],0,0,0);
    o[d0]=__builtin_amdgcn_mfma_f32_32x32x16_bf16(pa2,PK(2),o[d0],0,0,0);
    o[d0]=__builtin_amdgcn_mfma_f32_32x32x16_bf16(pa3,PK(3),o[d0],0,0,0);
    #undef PK
  }
}

#ifndef ATTN_STORE16
#define ATTN_STORE16(p,v) (*(u32x4*)(p)=(v))
#endif
typedef __attribute__((address_space(3))) const float* lds_cfptr;
typedef float f32x4a __attribute__((ext_vector_type(4)));
#define BIASINIT(C0,C1,t) do{ const lds_cfptr cb_=ckl+64*(t)+4*hi; \
    { f32x4a v_[4]; _Pragma("unroll") for(int j_=0;j_<4;++j_) v_[j_]=*(const __attribute__((address_space(3))) f32x4a*)(cb_+8*j_); \
      _Pragma("unroll") for(int j_=0;j_<4;++j_) _Pragma("unroll") for(int i_=0;i_<4;++i_) C0[4*j_+i_]=nm-v_[j_][i_]; } \
    SBAR(); \
    { f32x4a v_[4]; _Pragma("unroll") for(int j_=0;j_<4;++j_) v_[j_]=*(const __attribute__((address_space(3))) f32x4a*)(cb_+32+8*j_); \
      _Pragma("unroll") for(int j_=0;j_<4;++j_) _Pragma("unroll") for(int i_=0;i_<4;++i_) C1[4*j_+i_]=nm-v_[j_][i_]; } }while(0)
template<int THRL> __device__ __forceinline__ void attn_unit(int b,int h,int qb,const bf16*Q,const bf16*__restrict__ K,const bf16*__restrict__ V,bf16*O,char*shm,lds_cfptr ckl){
  int tid=threadIdx.x; asm volatile("":"+v"(tid)); const int lane=tid&63,r32=lane&31,hi=lane>>5; const int wid=__builtin_amdgcn_readfirstlane(tid>>6);
  const long rowbase=(long)b*SEQ; const int q0=qb*QB;
  const bf16*Qw=Q+(rowbase+q0+wid*QBLK)*DM+h*D;
  const bf16*Kh=K+rowbase*DM+h*D,*Vh=V+rowbase*DM+h*D;
  const unsigned lds0=(unsigned)(uintptr_t)shm;
  float*wsf=(float*)(shm+LDS_WS)+wid*64;
  const bf16*ksrc=Kh+(long)lane*DM+wid*8;
  const bf16*vsrc=Vh+(long)(16*(wid&3)+(lane>>2))*DM+(wid>>2)*32+(lane&3)*8;
  const unsigned kdst=lds0+LDS_K+wid*1024, vdst=lds0+LDS_V+wid*1024;
  #define DMA_K(t,slot) glds16(ksrc+(long)(t)*KVBLK*DM,(unsigned)__builtin_amdgcn_readfirstlane(kdst+(slot)))
  #define DMA_V(t,slot) glds16(vsrc+(long)(t)*KVBLK*DM,(unsigned)__builtin_amdgcn_readfirstlane(vdst+(slot)))
  const int vb0=(int)(lds0+LDS_V)+((lane>>4)&1)*32+(lane&3)*8+(4*hi+((lane&15)>>2))*64;
  const char*Kbase=shm+LDS_K; bf16x8 kf[8];
  const lds_cptr shm3=(lds_cptr)shm; const lds_cptr kp0=shm3+LDS_K+hi*1024+r32*16; const lds_cptr vp0=shm3+LDS_V+((lane>>4)&1)*32+(lane&3)*8+(4*hi+((lane&15)>>2))*64;
  const int NT=(q0+QB)/KVBLK;
  DMA_K(0,0);DMA_V(0,0);DMA_K(1,SLOTB);
  bf16x8 qr[4];
  #pragma unroll
  for(int d0=0;d0<4;++d0)qr[d0]=*reinterpret_cast<const bf16x8*>(&Qw[(long)r32*DM+d0*16+hi*8]);
  float mhat=0.f,l_reg=0.f;f32x16 o[2];o[0]=f32x16{};o[1]=f32x16{};
  const int qrel=wid*QBLK+r32; float nm=ckl[q0+qrel];
  #define CMASK(P0,P1,t) do{int jb_=(t)-(NT-4); if(jb_>=0)cmask(P0,P1,jb_,qrel,hi);}while(0)
  bool resc=false;
  #define START(P0,P1) do{ const float rm=rowmax(P0,P1); resc=false; \
    { const float dl=__builtin_fmaxf(rm,0.f); mhat=fadd_s(mhat,dl); nm=fsub_s(nm,dl); \
      _Pragma("unroll") for(int r=0;r<16;++r){P0[r]=fsub_s(P0[r],dl);P1[r]=fsub_s(P1[r],dl);} } \
    _Pragma("unroll") for(int r=0;r<16;++r)P0[r]=__builtin_amdgcn_exp2f(P0[r]); }while(0)
  #define RESC() do{ if(resc){ asm volatile("s_waitcnt lgkmcnt(0)":::"memory"); \
      _Pragma("unroll") for(int d_=0;d_<2;++d_) _Pragma("unroll") for(int r=0;r<16;++r)o[d_][r]*=wsf[crow(r,hi)]; } }while(0)
  f32x16 pA0,pA1,pB0,pB1;
  int sl_prev=0,sl_cur=0,sl_next=SLOTB;
  #define ROT() do{sl_prev=sl_cur;sl_cur=sl_next;sl_next=(sl_next==(NSLOT-1)*SLOTB)?0:sl_next+SLOTB;}while(0)
  DMA_K(2,2*SLOTB);
  WAIT_BAR(3);
  BIASINIT(pA0,pA1,0); qkt(pA0,pA1,Kbase,qr,r32,hi);asm volatile("s_nop 15\n\ts_nop 7":"+v"(pA0),"+v"(pA1));CMASK(pA0,pA1,0);
  START(pA0,pA1);
  _Pragma("unroll") for(int r=0;r<16;++r)pA1[r]=__builtin_amdgcn_exp2f(pA1[r]);
  WAIT_BAR(0);
  DMA_K(3,0);DMA_V(1,SLOTB);
  ROT();
  kload8(kf,kp0+sl_cur);
  WAIT_BAR(2);
  s16x4 vlo[8],vhi[8]; u32x4 pw0,pw1,pw2,pw3;
  #define PKW(P,B) cvtpk_s(P[B],P[B+1])
  #define PAF(k) __builtin_bit_cast(bf16x8,pw##k)
  #define VFR(i) (bf16x8){vlo[i][0],vlo[i][1],vlo[i][2],vlo[i][3],vhi[i][0],vhi[i][1],vhi[i][2],vhi[i][3]}
  #define PIN(x) asm volatile("":"+v"(x))
  #define MX3(a,b,c) __builtin_fmaxf(__builtin_fmaxf((a),(b)),(c))
  #define GAPA(MF,A0,A1,A2,A3,W0,W1,PW) do{ MF; sacc+=A0; sacc+=A1; sacc+=A2; sacc+=A3; PIN(sacc); W0; W1; PIN(PW); SBAR(); }while(0)
  #define EX(v) __builtin_amdgcn_exp2f(v)
  #define GAPB(MF,X,B) do{ MF; X[B]=EX(X[B]); X[B+1]=EX(X[B+1]); X[B+2]=EX(X[B+2]); X[B+3]=EX(X[B+3]); PIN(X); SBAR(); }while(0)
  #define VRD(i) do{ vlo[i]=vtr(vp_+(((i)>>2)*4096+((i)&3)*1024)); vhi[i]=vtr(vp_+(((i)>>2)*4096+((i)&3)*1024+512)); }while(0)
  #define KRD(G,j) do{ if(G){ kload2(kf,kp0+sl_next,j); SBAR(); } }while(0)
  #define STEP(C0,C1,P0,P1,t,GK,GV,GL) do{ SBAR(); \
    BIASINIT(C0,C1,t); SBAR(); \
    const lds_cptr vp_=vp0+sl_prev; \
    VRD(0); SBAR(); float sacc=(P0[0]+P0[1]); \
    GAPA(C0=__builtin_amdgcn_mfma_f32_32x32x16_bf16(kf[0],qr[0],C0,0,0,0), P0[2],P0[3],P0[4],P0[5],     pw0[0]=PKW(P0,0), pw0[1]=PKW(P0,2), pw0); \
    VRD(4); SBAR(); GAPA(C1=__builtin_amdgcn_mfma_f32_32x32x16_bf16(kf[1],qr[0],C1,0,0,0), P0[6],P0[7],P0[8],P0[9],     pw0[2]=PKW(P0,4), pw0[3]=PKW(P0,6), pw0); \
    VRD(1); SBAR(); GAPA(C0=__builtin_amdgcn_mfma_f32_32x32x16_bf16(kf[2],qr[1],C0,0,0,0),   P0[10],P0[11],P0[12],P0[13], pw1[0]=PKW(P0,8), pw1[1]=PKW(P0,10), pw1); \
    VRD(5); SBAR(); GAPA(C1=__builtin_amdgcn_mfma_f32_32x32x16_bf16(kf[3],qr[1],C1,0,0,0),   P0[14],P0[15],P1[0],P1[1],   pw1[2]=PKW(P0,12),pw1[3]=PKW(P0,14), pw1); \
    VRD(2); SBAR(); GAPA(C0=__builtin_amdgcn_mfma_f32_32x32x16_bf16(kf[4],qr[2],C0,0,0,0),   P1[2],P1[3],P1[4],P1[5],     pw2[0]=PKW(P1,0), pw2[1]=PKW(P1,2), pw2); \
    VRD(6); SBAR(); GAPA(C1=__builtin_amdgcn_mfma_f32_32x32x16_bf16(kf[5],qr[2],C1,0,0,0),   P1[6],P1[7],P1[8],P1[9],     pw2[2]=PKW(P1,4), pw2[3]=PKW(P1,6), pw2); \
    VRD(3); SBAR(); GAPA(C0=__builtin_amdgcn_mfma_f32_32x32x16_bf16(kf[6],qr[3],C0,0,0,0),   P1[10],P1[11],P1[12],P1[13], pw3[0]=PKW(P1,8), pw3[1]=PKW(P1,10), pw3); \
    VRD(7); SBAR(); GAPA(C1=__builtin_amdgcn_mfma_f32_32x32x16_bf16(kf[7],qr[3],C1,0,0,0),   P1[14],P1[15],0.f,0.f,       pw3[2]=PKW(P1,12),pw3[3]=PKW(P1,14), pw3); \
    l_reg+=sacc; \
    if(GK){DMA_K((t)+3,sl_cur);} if(GV){DMA_V((t)+1,sl_next);} \
    CMASK(C0,C1,t); \
    { float a=MX3(C0[0],C0[1],C1[0]),b=MX3(C0[2],C0[3],C1[1]); a=MX3(a,C1[2],C1[3]); \
      _Pragma("unroll") for(int r=4;r<16;r+=4){a=MX3(a,C0[r],C0[r+1]);b=MX3(b,C0[r+2],C0[r+3]);a=MX3(a,C1[r],C1[r+1]);b=MX3(b,C1[r+2],C1[r+3]);} \
      float rm=__builtin_fmaxf(a,b); { auto rr=__builtin_amdgcn_permlane32_swap(__float_as_uint(rm),__float_as_uint(rm),false,false); rm=__builtin_fmaxf(__uint_as_float(rr[0]),__uint_as_float(rr[1])); } \
      resc=false; \
      if(__builtin_expect(__any(rm>(float)THRL),0)){ const float dl=__builtin_fmaxf(rm,0.f); mhat+=dl; nm-=dl; \
        _Pragma("unroll") for(int r=0;r<16;++r){C0[r]-=dl;C1[r]-=dl;} \
        const float f=__builtin_amdgcn_exp2f(-dl); l_reg*=f; if(hi==0)wsf[r32]=f; resc=true; } } \
    SBAR(); \
    GAPB(o[0]=__builtin_amdgcn_mfma_f32_32x32x16_bf16(PAF(0),VFR(0),o[0],0,0,0), C0,0); \
    GAPB(o[1]=__builtin_amdgcn_mfma_f32_32x32x16_bf16(PAF(0),VFR(4),o[1],0,0,0), C0,4); \
    KRD(GL,0); GAPB(o[0]=__builtin_amdgcn_mfma_f32_32x32x16_bf16(PAF(1),VFR(1),o[0],0,0,0), C0,8); \
    KRD(GL,1); GAPB(o[1]=__builtin_amdgcn_mfma_f32_32x32x16_bf16(PAF(1),VFR(5),o[1],0,0,0), C0,12); \
    KRD(GL,2); GAPB(o[0]=__builtin_amdgcn_mfma_f32_32x32x16_bf16(PAF(2),VFR(2),o[0],0,0,0), C1,0); \
    KRD(GL,3); GAPB(o[1]=__builtin_amdgcn_mfma_f32_32x32x16_bf16(PAF(2),VFR(6),o[1],0,0,0), C1,4); \
    GAPB(o[0]=__builtin_amdgcn_mfma_f32_32x32x16_bf16(PAF(3),VFR(3),o[0],0,0,0), C1,8); \
    GAPB(o[1]=__builtin_amdgcn_mfma_f32_32x32x16_bf16(PAF(3),VFR(7),o[1],0,0,0), C1,12); \
    }while(0)
  int t=1;
  #undef CMASK
  #define CMASK(P0,P1,t) do{}while(0)
  for(;t+5<NT;t+=2){
    STEP(pB0,pB1,pA0,pA1,t,true,true,true);     WAIT_BAR(2); RESC(); ROT();
    STEP(pA0,pA1,pB0,pB1,t+1,true,true,true);   WAIT_BAR(2); RESC(); ROT();
  }
  #undef CMASK
  #define CMASK(P0,P1,t) do{int jb_=(t)-(NT-4); if(jb_>=0)cmask(P0,P1,jb_,qrel,hi);}while(0)
  #define ENDW(tt) do{ if((tt)+3<NT){WAIT_BAR(2);} else if((tt)+2<NT){WAIT_BAR(1);} else {WAIT_BAR(0);} }while(0)
  for(;t+1<NT;t+=2){
    STEP(pB0,pB1,pA0,pA1,t,(t+3<NT),(t+1<NT),(t+1<NT));       ENDW(t);   RESC(); ROT();
    STEP(pA0,pA1,pB0,pB1,t+1,(t+4<NT),(t+2<NT),(t+2<NT));     ENDW(t+1); RESC(); ROT();
  }
  STEP(pB0,pB1,pA0,pA1,NT-1,false,false,false); RESC();
  { float sacc=pB0[0]+pB0[1]; _Pragma("unroll") for(int r=2;r<16;++r)sacc+=pB0[r]; _Pragma("unroll") for(int r=0;r<16;++r)sacc+=pB1[r]; l_reg+=sacc;
    pw0=(u32x4){PKW(pB0,0),PKW(pB0,2),PKW(pB0,4),PKW(pB0,6)};pw1=(u32x4){PKW(pB0,8),PKW(pB0,10),PKW(pB0,12),PKW(pB0,14)};pw2=(u32x4){PKW(pB1,0),PKW(pB1,2),PKW(pB1,4),PKW(pB1,6)};pw3=(u32x4){PKW(pB1,8),PKW(pB1,10),PKW(pB1,12),PKW(pB1,14)};
    SBAR(); pv(o,vb0+sl_cur,PAF(0),PAF(1),PAF(2),PAF(3)); }
  #undef PKW
  #undef PAF
  #undef VFR
  #undef PIN
  #undef MX3
  #undef GAPA
  #undef GAPB
  #undef EX
  #undef VRD
  #undef KRD
  #undef STEP
  #undef ENDW
  {auto rr=__builtin_amdgcn_permlane32_swap(__float_as_uint(l_reg),__float_as_uint(l_reg),false,false);l_reg=__uint_as_float(rr[0])+__uint_as_float(rr[1]);}
  if(hi==0)wsf[32+r32]=l_reg;asm volatile("s_waitcnt lgkmcnt(0)":::"memory");
  float rli[16];
  #pragma unroll
  for(int r=0;r<16;++r)rli[r]=__builtin_amdgcn_rcpf(wsf[32+crow(r,hi)]);
  bf16*Ow=O+(rowbase+q0+wid*QBLK)*DM+h*D;
  { bf16*stg=(bf16*)(shm+LDS_OST)+wid*2048;
    #pragma unroll
    for(int r=0;r<16;++r){const int orow=crow(r,hi);
      #pragma unroll
      for(int d0=0;d0<2;++d0)stg[orow*64+d0*32+r32]=__float2bfloat16(o[d0][r]*rli[r]);}
    asm volatile("s_waitcnt lgkmcnt(0)":::"memory");
    #pragma unroll
    for(int i=0;i<4;++i){const int row=i*8+(lane>>3),ch=lane&7; const u32x4 v=*(const u32x4*)(stg+row*64+ch*8); ATTN_STORE16(Ow+(long)row*DM+ch*8,v);} }
  asm volatile("s_waitcnt lgkmcnt(0)\n\ts_barrier":::"memory");
  #undef DMA_K
  #undef DMA_V
  #undef CMASK
  #undef START
  #undef RESC
  #undef ROT
}
constexpr int ATTN_LDS_BYTES=LDS_BYTES;
struct AttnTensors { const bf16* Q; const bf16* K; const bf16* V; bf16* O; };
struct AttnUnit { int bh; int qb; };
#undef BIASINIT
#undef SBAR
#undef WAIT_BAR
}
namespace cg = cooperative_groups;
constexpr int NWAVES = 8;
constexpr int BATCH = 4, SEQ = 4096, D = 1024, M = BATCH * SEQ, FF = 4096, DEPTH = 4, NIN = 3072, WIN_LD = 3088;
constexpr int N_PHASES = 26;
#ifndef PROBE_DUP
#define PROBE_DUP -1
#endif
#ifndef MK_ONE_LAUNCH
#define MK_ONE_LAUNCH 1
#endif
constexpr size_t MiB = 1u << 20;
constexpr size_t WS_SSQ = 0;
constexpr size_t WS_SMALL = 1 * MiB;
constexpr size_t WS_BAR = 3 * MiB, BAR_ZERO_BYTES = 16384;
constexpr size_t WS_EB = 2 * MiB;
constexpr size_t WS_W = 4 * MiB, W_STRIDE = 25 * MiB;
constexpr size_t W_IN = 0, W_SM = 6 * MiB, W_O = 7 * MiB, W_UP = 9 * MiB, W_DN = 17 * MiB;
constexpr size_t WS_HB = 54 * MiB;
constexpr size_t WS_Q = 86 * MiB, WS_K = 118 * MiB, WS_V = 150 * MiB, WS_LS = 182 * MiB;
constexpr size_t WS_U = 86 * MiB;
constexpr size_t WS_END = 246 * MiB;
constexpr int LDS_BYTES = 147456;
constexpr int CKL_OFF = 86016;
static_assert(attn_body::ATTN_LDS_BYTES <= CKL_OFF && CKL_OFF + 16384 <= 131072, "LDS map");

#define LAS __attribute__((address_space(3)))
typedef unsigned short bf16;
typedef unsigned v4u __attribute__((ext_vector_type(4)));
typedef unsigned v2u __attribute__((ext_vector_type(2)));
typedef float f32x4 __attribute__((ext_vector_type(4)));
typedef short bf16x8 __attribute__((ext_vector_type(8)));
#define LDS_WAIT() asm volatile("s_waitcnt lgkmcnt(0)" ::: "memory")
__device__ __forceinline__ unsigned pk2(float lo, float hi) { return pg8::cvt_pk_bf16(lo, hi); }
__device__ __forceinline__ float bf2f(unsigned short v) { return __uint_as_float((unsigned)v << 16); }
__device__ __forceinline__ float bflo(unsigned w) { return __uint_as_float(w << 16); }
__device__ __forceinline__ float bfhi(unsigned w) { return __uint_as_float(w & 0xffff0000u); }
__device__ __forceinline__ float log_sigmoid(float x) { return __builtin_fminf(x, 0.f) - log1pf(__expf(-__builtin_fabsf(x))); }
__device__ __forceinline__ float wave_sum(float v) {
#pragma unroll
    for (int o = 1; o < 64; o <<= 1) v += __shfl_xor(v, o);
    return v;
}

#define XB_TMO      128
#define XB_XCNT(j)  (256  + 64 * (j))
#define XB_XSUB(j)  (1280 + 64 * (j))
#define XB_XGEN(j)  (2304 + 64 * (j))
#define XB_TOP      3328
#define XB_TOPGEN   3392
#define XCD_BAR_WORDS 3456
#define XB_SPIN_CAP (1u << 18)

__device__ __forceinline__ unsigned xb_ld(unsigned* p)              { return __hip_atomic_load(p, __ATOMIC_RELAXED, __HIP_MEMORY_SCOPE_AGENT); }
__device__ __forceinline__ unsigned xb_add(unsigned* p, unsigned v) { return __hip_atomic_fetch_add(p, v, __ATOMIC_RELAXED, __HIP_MEMORY_SCOPE_AGENT); }
__device__ __forceinline__ unsigned xb_xcc_id() { return (unsigned)__builtin_amdgcn_s_getreg((3 << 11) | 20) & 0xFu; }
#define XB_SPIN(cond, bar) do { unsigned _sp = 0; while (cond) { __builtin_amdgcn_s_sleep(1); \
    if ((++_sp & 255u) == 0u) { if (xb_ld(&(bar)[XB_TMO])) break; if (_sp > XB_SPIN_CAP) { atomicAdd(&(bar)[XB_TMO], 1u); break; } } } } while (0)

struct XcdBarrier {
    unsigned* bar; unsigned x;
    volatile LAS unsigned* st;
};

__device__ __forceinline__ XcdBarrier xcd_barrier_post(unsigned* bar, volatile LAS unsigned* st) {
    XcdBarrier b; b.bar = bar; b.x = xb_xcc_id(); b.st = st;
    if (threadIdx.x == 0) (void)xb_add(&bar[XB_XCNT(b.x)], 1u);
    return b;
}
__device__ __forceinline__ void xcd_barrier_complete(unsigned* bar, unsigned x, unsigned& nloc, unsigned& nx) {
    const unsigned G = gridDim.x * gridDim.y * gridDim.z;
    unsigned sum, cnt, mine, sp = 0u;
    for (;;) {
        sum = 0u; cnt = 0u; mine = 0u;
#pragma unroll
        for (unsigned j = 0; j < 16; ++j) { const unsigned c = xb_ld(&bar[XB_XCNT(j)]); sum += c; cnt += (c > 0u) ? 1u : 0u; mine = (j == x) ? c : mine; }
        if (sum == G) break;
        __builtin_amdgcn_s_sleep(1);
        if ((++sp & 255u) == 0u) { if (xb_ld(&bar[XB_TMO])) break; if (sp > XB_SPIN_CAP) { atomicAdd(&bar[XB_TMO], 1u); break; } }
    }
    nloc = mine > 0u ? mine : 1u; nx = cnt > 0u ? cnt : 1u;
}

__device__ __forceinline__ void xcd_barrier(const XcdBarrier& b) {
    asm volatile("s_waitcnt vmcnt(0)" ::: "memory");
    __syncthreads();
    if (threadIdx.x == 0) {
        unsigned* bar = b.bar;
        __builtin_amdgcn_s_waitcnt(0);
        unsigned nloc = b.st[0], nx = b.st[1];
        if (nloc == 0u) { xcd_barrier_complete(bar, b.x, nloc, nx); b.st[0] = nloc; b.st[1] = nx; }
        const unsigned old = xb_add(&bar[XB_XSUB(b.x)], 1u);
        const unsigned gen = old / nloc;
        if (old + 1u == (gen + 1u) * nloc) {
            __builtin_amdgcn_fence(__ATOMIC_RELEASE, "agent");
            asm volatile("s_waitcnt vmcnt(0)" ::: "memory");
            const unsigned og = xb_add(&bar[XB_TOP], 1u);
            const unsigned tg = og / nx;
            if (og + 1u == (tg + 1u) * nx) xb_add(&bar[XB_TOPGEN], 1u);
            else XB_SPIN(xb_ld(&bar[XB_TOPGEN]) == tg, bar);
            __builtin_amdgcn_fence(__ATOMIC_ACQUIRE, "agent");
            xb_add(&bar[XB_XGEN(b.x)], 1u);
            asm volatile("s_waitcnt vmcnt(0)" ::: "memory");
        } else {
            XB_SPIN(xb_ld(&bar[XB_XGEN(b.x)]) == gen, bar);
            __builtin_amdgcn_fence(__ATOMIC_ACQUIRE, "agent");
            asm volatile("s_waitcnt vmcnt(0)" ::: "memory");
        }
    }
    __syncthreads();
}

struct Args { const float* in[14]; float* out; unsigned char* ws; int ph_lo, ph_hi; };

__device__ __forceinline__ void transpose_item(const float* W, int ldw, int src_col0, const float* gain, bf16* WT, int K, int dst_row0, int nblk, LAS float* scr, int item, int lane) {
    const int kb = item / nblk, nb = item % nblk, k0 = 64 * kb, n0 = 32 * nb;
#pragma unroll 8
    for (int i = 0; i < 32; ++i) { const int kk = 2 * i + (lane >> 5); float w = W[(size_t)(k0 + kk) * ldw + src_col0 + n0 + (lane & 31)]; if (gain) w *= gain[k0 + kk]; scr[kk * 33 + (lane & 31)] = w; }
    LDS_WAIT(); asm volatile("" ::: "memory");
    const int c = lane & 7;
#pragma unroll
    for (int j = 0; j < 4; ++j) { const int n = (lane >> 3) + 8 * j; const LAS float* s = scr + (8 * c) * 33 + n;
        v4u o; o.x = pk2(s[0 * 33], s[1 * 33]); o.y = pk2(s[2 * 33], s[3 * 33]); o.z = pk2(s[4 * 33], s[5 * 33]); o.w = pk2(s[6 * 33], s[7 * 33]);
        *(v4u*)(WT + (size_t)(dst_row0 + n0 + n) * K + k0 + 8 * c) = o; }
    LDS_WAIT(); asm volatile("" ::: "memory");
}

__device__ __forceinline__ void convert_layer_weights(const Args& a, int L, LAS unsigned char* lds, int gw, int NGW, int wave, int lane) {
    LAS float* scr = (LAS float*)(lds + wave * 16384);
    unsigned char* wb = a.ws + WS_W + (size_t)(L & 1) * W_STRIDE;
    const int j = L >> 1; const bool fox = (L & 1) == 0;
    const float* Win = (fox ? a.in[1] : a.in[4]) + (size_t)j * D * WIN_LD;
    const float* Wo = (fox ? a.in[3] : a.in[8]) + (size_t)j * D * D;
    const float* Wup = a.in[9] + (size_t)L * D * FF; const float* Wdn = a.in[10] + (size_t)L * FF * D;
    const float* gmix = a.in[11] + L * D; const float* gmlp = a.in[12] + L * D;
    const int colB = fox ? 2048 : 2064, colS = fox ? 3072 : 2048;
    constexpr int I_A = 16 * 64, I_B = 16 * 32, I_O = 16 * 32, I_U = 16 * 128, I_D = 64 * 32, NITEMS = I_A + I_B + I_O + I_U + I_D;
    for (int it = gw; it < NITEMS; it += NGW) {
        int r = it;
        if (r < I_A) { transpose_item(Win, WIN_LD, 0, gmix, (bf16*)(wb + W_IN), D, 0, 64, scr, r, lane); continue; } r -= I_A;
        if (r < I_B) { transpose_item(Win, WIN_LD, colB, gmix, (bf16*)(wb + W_IN), D, 2048, 32, scr, r, lane); continue; } r -= I_B;
        if (r < I_O) { transpose_item(Wo, D, 0, nullptr, (bf16*)(wb + W_O), D, 0, 32, scr, r, lane); continue; } r -= I_O;
        if (r < I_U) { transpose_item(Wup, FF, 0, gmlp, (bf16*)(wb + W_UP), D, 0, 128, scr, r, lane); continue; } r -= I_U;
        transpose_item(Wdn, D, 0, nullptr, (bf16*)(wb + W_DN), FF, 0, 32, scr, r, lane);
    }
    bf16* wsm = (bf16*)(wb + W_SM);
    for (int e = gw * 64 + lane; e < 16 * D; e += NGW * 64) { const int k = e >> 4, n = e & 15; wsm[n * D + k] = (bf16)(pk2(Win[(size_t)k * WIN_LD + colS + n] * gmix[k], 0.f) & 0xffffu); }
}

namespace gla {
constexpr int H = 4, DK = 128, DV = 256, C = 64, NCH = SEQ / C;
constexpr int VT_LD = 72, KT_LD = 72, QT_LD = 136;
__device__ __forceinline__ f32x4 mfma16(bf16x8 a, bf16x8 b, f32x4 c) { return __builtin_amdgcn_mfma_f32_16x16x32_bf16(a, b, c, 0, 0, 0); }
__device__ __forceinline__ void stage_vT(const bf16* vsrc, LAS bf16* VT, int tid) {
#pragma unroll
    for (int c = 0; c < 4; ++c) { const int idx = tid + 512 * c, t = idx >> 5, d8 = idx & 31; const v4u w = *(const v4u*)(vsrc + (size_t)t * 1024 + d8 * 8);
        LAS bf16* p = VT + (d8 * 8) * VT_LD + t;
        p[0 * VT_LD] = (bf16)(w.x & 0xffffu); p[1 * VT_LD] = (bf16)(w.x >> 16); p[2 * VT_LD] = (bf16)(w.y & 0xffffu); p[3 * VT_LD] = (bf16)(w.y >> 16);
        p[4 * VT_LD] = (bf16)(w.z & 0xffffu); p[5 * VT_LD] = (bf16)(w.z >> 16); p[6 * VT_LD] = (bf16)(w.w & 0xffffu); p[7 * VT_LD] = (bf16)(w.w >> 16); }
}
__device__ __forceinline__ void g1_unit(int u, const bf16* QK, bf16* QKout, const bf16* V, const float* zlr, const float* wg, const float* bg, bf16* LS, float* EB, LAS unsigned char* lds, int tid, int wave, int lane) {
    const int b = u >> 8, j = (u >> 2) & 63, h = u & 3, lsid = (b * 4 + h) * 64 + j; const size_t tok0 = (size_t)b * SEQ + 64 * j;
    LAS bf16* KT = (LAS bf16*)lds; LAS bf16* VT = (LAS bf16*)(lds + 18432); LAS float* ZL = (LAS float*)(lds + 55296); LAS float* TOT = (LAS float*)(lds + 59392); LAS float* EBL = (LAS float*)(lds + 61440);
    const int d = tid & 127, tq = tid >> 7;
    if (tid < 256) ((LAS f32x4*)ZL)[tid] = ((const f32x4*)(zlr + tok0 * 16))[tid];
    float w[16];
#pragma unroll
    for (int r = 0; r < 16; ++r) w[r] = wg[r * 512 + h * 128 + d];
    const float bgd = bg[h * 128 + d];
    stage_vT(V + tok0 * 1024 + h * 256, VT, tid);
    __syncthreads();
    float bc[16]; float run = 0.f;
#pragma unroll
    for (int i = 0; i < 16; ++i) { const int t = 16 * tq + i; float z = bgd;
#pragma unroll
        for (int r4 = 0; r4 < 4; ++r4) { const f32x4 zz = ((const LAS f32x4*)ZL)[t * 4 + r4]; z += zz[0] * w[4 * r4] + zz[1] * w[4 * r4 + 1] + zz[2] * w[4 * r4 + 2] + zz[3] * w[4 * r4 + 3]; }
        run += log_sigmoid(z) * (1.0f / 16.0f); bc[i] = run; }
    TOT[tq * 128 + d] = run;
    __syncthreads();
    float pre = 0.f, blast = 0.f;
#pragma unroll
    for (int q = 0; q < 4; ++q) { const float tv = TOT[q * 128 + d]; if (q < tq) pre += tv; blast += tv; }
    const float eblast = __expf(blast);
    if (tq == 0) { EB[(size_t)lsid * 128 + d] = eblast; EBL[d] = eblast; }
    unsigned kpk[8];
    const bf16* qp = QK + tok0 * 1024 + h * 128 + d; bf16* qo = QKout + tok0 * 1024 + h * 128 + d;
#pragma unroll
    for (int i = 0; i < 16; i += 2) {
        float kt2[2];
#pragma unroll
        for (int e = 0; e < 2; ++e) { const int t = 16 * tq + i + e; const float bb = bc[i + e] + pre; const float eb = __expf(bb);
            const float qv = bf2f(qp[(size_t)t * 1024]), kv = bf2f(qp[(size_t)t * 1024 + 512]);
            const float qt = qv * eb * 0.08838834764831845f, kt = kv * __builtin_amdgcn_rcpf(eb);
            const unsigned pq = pk2(qt, kt); qo[(size_t)t * 1024] = (bf16)(pq & 0xffffu); qo[(size_t)t * 1024 + 512] = (bf16)(pq >> 16); kt2[e] = kt; }
        kpk[i >> 1] = pk2(kt2[0], kt2[1]); }
    { LAS v4u* kd = (LAS v4u*)(KT + d * KT_LD + 16 * tq); kd[0] = (v4u){kpk[0], kpk[1], kpk[2], kpk[3]}; kd[1] = (v4u){kpk[4], kpk[5], kpk[6], kpk[7]}; }
    __syncthreads();
    const int fr = lane & 15, fq = lane >> 4;
    f32x4 acc[2][8];
#pragma unroll
    for (int mt = 0; mt < 2; ++mt)
#pragma unroll
        for (int nt = 0; nt < 8; ++nt) acc[mt][nt] = (f32x4){0.f, 0.f, 0.f, 0.f};
#pragma unroll
    for (int ks = 0; ks < 2; ++ks) { bf16x8 vf[2];
#pragma unroll
        for (int mt = 0; mt < 2; ++mt) vf[mt] = *(const LAS bf16x8*)(VT + (32 * wave + 16 * mt + fr) * VT_LD + ks * 32 + fq * 8);
#pragma unroll
        for (int nt = 0; nt < 8; ++nt) { const bf16x8 kf = *(const LAS bf16x8*)(KT + (16 * nt + fr) * KT_LD + ks * 32 + fq * 8);
#pragma unroll
            for (int mt = 0; mt < 2; ++mt) acc[mt][nt] = mfma16(kf, vf[mt], acc[mt][nt]); } }
    bf16* lsp = LS + (size_t)lsid * 32768;
#pragma unroll
    for (int nt = 0; nt < 8; ++nt) { const f32x4 e4 = *(const LAS f32x4*)(EBL + 16 * nt + 4 * fq);
#pragma unroll
        for (int mt = 0; mt < 2; ++mt) { const f32x4 v = acc[mt][nt] * e4; v2u o; o.x = pk2(v[0], v[1]); o.y = pk2(v[2], v[3]);
            *(v2u*)(lsp + (size_t)(32 * wave + 16 * mt + fr) * 128 + 16 * nt + 4 * fq) = o; } }
    __syncthreads();
}
template <bool DUMMY> __device__ __forceinline__ void g2_scan(const bf16* LS, bf16* OUT, const float* EB, int gtid, int nthreads) {
    for (int e = gtid; e < 16 * 8192; e += nthreads) { const int bh = e >> 13, off = (e & 8191) * 4;
        const bf16* base = LS + (size_t)bh * 64 * 32768 + off; bf16* obase = OUT + (DUMMY ? ((size_t)(bh & 7) * 64 * 32768 + off) : ((size_t)bh * 64 * 32768 + off)); const float* ebp = EB + (size_t)bh * 64 * 128 + (off & 127);
        f32x4 S = (f32x4){0.f, 0.f, 0.f, 0.f};
#pragma unroll 9
        for (int j = 0; j < 63; ++j) { const v2u l = *(const v2u*)(base + (size_t)j * 32768); const f32x4 a = *(const f32x4*)(ebp + j * 128);
            S[0] = a[0] * S[0] + bflo(l.x); S[1] = a[1] * S[1] + bfhi(l.x); S[2] = a[2] * S[2] + bflo(l.y); S[3] = a[3] * S[3] + bfhi(l.y);
            v2u o; o.x = pk2(S[0], S[1]); o.y = pk2(S[2], S[3]); *(v2u*)(obase + (size_t)j * 32768) = o; } }
}
__device__ __forceinline__ void g3_unit(int u, const bf16* QK, const bf16* V, const bf16* R, bf16* Rout, const bf16* LS, const float* gnorm, LAS unsigned char* lds, int tid, int wave, int lane) {
    const int b = u >> 8, j = (u >> 2) & 63, h = u & 3, lsid = (b * 4 + h) * 64 + j; const size_t tok0 = (size_t)b * SEQ + 64 * j;
    LAS bf16* QT = (LAS bf16*)lds; LAS bf16* KT = (LAS bf16*)(lds + 17408); LAS bf16* VT = (LAS bf16*)(lds + 34816); LAS bf16* AT = (LAS bf16*)(lds + 71680); LAS float* RS = (LAS float*)(lds + 80896);
#pragma unroll
    for (int c = 0; c < 2; ++c) { const int idx = tid + 512 * c, t = idx >> 4, c8 = idx & 15; const bf16* src = QK + (tok0 + t) * 1024 + h * 128 + c8 * 8;
        *(LAS v4u*)(QT + t * QT_LD + c8 * 8) = *(const v4u*)src; *(LAS v4u*)(KT + t * QT_LD + c8 * 8) = *(const v4u*)(src + 512); }
    stage_vT(V + tok0 * 1024 + h * 256, VT, tid);
    __syncthreads();
    const int fr = lane & 15, fq = lane >> 4, tm = wave >> 1, hh = wave & 1;
#pragma unroll
    for (int e = 0; e < 2; ++e) { const int sn = 2 * hh + e; f32x4 a = (f32x4){0.f, 0.f, 0.f, 0.f};
        if (sn <= tm) {
#pragma unroll
            for (int ks = 0; ks < 4; ++ks) { const bf16x8 qf = *(const LAS bf16x8*)(QT + (16 * tm + fr) * QT_LD + ks * 32 + fq * 8); const bf16x8 kf = *(const LAS bf16x8*)(KT + (16 * sn + fr) * QT_LD + ks * 32 + fq * 8);
                a = mfma16(kf, qf, a); }
#pragma unroll
            for (int i = 0; i < 4; ++i) if (16 * sn + 4 * fq + i > 16 * tm + fr) a[i] = 0.f; }
        v2u o; o.x = pk2(a[0], a[1]); o.y = pk2(a[2], a[3]); *(LAS v2u*)(AT + (16 * tm + fr) * VT_LD + 16 * sn + 4 * fq) = o; }
    __syncthreads();
    f32x4 acc[8];
#pragma unroll
    for (int nt = 0; nt < 8; ++nt) acc[nt] = (f32x4){0.f, 0.f, 0.f, 0.f};
#pragma unroll
    for (int ks = 0; ks < 2; ++ks) { const bf16x8 af = *(const LAS bf16x8*)(AT + (16 * tm + fr) * VT_LD + ks * 32 + fq * 8);
#pragma unroll
        for (int nt = 0; nt < 8; ++nt) { const bf16x8 vf = *(const LAS bf16x8*)(VT + (128 * hh + 16 * nt + fr) * VT_LD + ks * 32 + fq * 8); acc[nt] = mfma16(vf, af, acc[nt]); } }
    if (j > 0) { const bf16* sp = LS + (size_t)(lsid - 1) * 32768 + (size_t)(128 * hh + fr) * 128 + fq * 8;
#pragma unroll
        for (int ks = 0; ks < 4; ++ks) { const bf16x8 qf = *(const LAS bf16x8*)(QT + (16 * tm + fr) * QT_LD + ks * 32 + fq * 8);
#pragma unroll
            for (int nt = 0; nt < 8; ++nt) { const bf16x8 sf = *(const bf16x8*)(sp + (size_t)nt * 16 * 128 + ks * 32); acc[nt] = mfma16(sf, qf, acc[nt]); } } }
    float ss = 0.f;
#pragma unroll
    for (int nt = 0; nt < 8; ++nt) ss += (acc[nt][0] * acc[nt][0] + acc[nt][1] * acc[nt][1]) + (acc[nt][2] * acc[nt][2] + acc[nt][3] * acc[nt][3]);
    ss += __shfl_xor(ss, 16); ss += __shfl_xor(ss, 32);
    if (fq == 0) RS[(16 * tm + fr) * 2 + hh] = ss;
    __syncthreads();
    const float rinv = __builtin_amdgcn_rsqf((RS[(16 * tm + fr) * 2] + RS[(16 * tm + fr) * 2 + 1]) * (1.0f / 256.0f) + 1e-6f);
    const size_t roff = (tok0 + 16 * tm + fr) * 1024 + h * 256 + 128 * hh + 4 * fq; const bf16* rp = R + roff; bf16* ro = Rout + roff;
#pragma unroll
    for (int nt = 0; nt < 8; ++nt) { const f32x4 gn = *(const f32x4*)(gnorm + 128 * hh + 16 * nt + 4 * fq); const v2u rw = *(const v2u*)(rp + 16 * nt);
        const float r0 = bflo(rw.x), r1 = bfhi(rw.x), r2 = bflo(rw.y), r3 = bfhi(rw.y);
        const float o0 = acc[nt][0] * rinv * gn[0] * r0 * __builtin_amdgcn_rcpf(1.f + __expf(-r0)), o1 = acc[nt][1] * rinv * gn[1] * r1 * __builtin_amdgcn_rcpf(1.f + __expf(-r1));
        const float o2 = acc[nt][2] * rinv * gn[2] * r2 * __builtin_amdgcn_rcpf(1.f + __expf(-r2)), o3 = acc[nt][3] * rinv * gn[3] * r3 * __builtin_amdgcn_rcpf(1.f + __expf(-r3));
        v2u o; o.x = pk2(o0, o1); o.y = pk2(o2, o3); *(v2u*)(ro + 16 * nt) = o; }
    __syncthreads();
}
}

#define SEAM() do { if (ph + 1 < hi) { if (ph == 0) grid.sync(); else xcd_barrier(bar); if (PROBE_DUP == 200 && ph == 4) { for (int r_ = 0; r_ < 10; ++r_) xcd_barrier(bar); } } } while (0)
template <int L> __device__ __forceinline__ void run_layer(const Args& args, cg::grid_group& grid, const XcdBarrier& bar, LAS unsigned char* lds, unsigned char* lds_raw, int lo, int hi) {
    const int G = gridDim.x, bx = blockIdx.x, vcu = (G % 8 == 0) ? (bx % 8) * (G / 8) + bx / 8 : bx, NGW = G * NWAVES;
    unsigned char* ws = args.ws;
    float* ssqp = (float*)(ws + WS_SSQ); float* smallb = (float*)(ws + WS_SMALL); float* EB = (float*)(ws + WS_EB);
    bf16* HB = (bf16*)(ws + WS_HB); bf16* QB = (bf16*)(ws + WS_Q); bf16* KB = (bf16*)(ws + WS_K); bf16* VB = (bf16*)(ws + WS_V); bf16* LS = (bf16*)(ws + WS_LS); bf16* UB = (bf16*)(ws + WS_U);
    float* Hres = args.out;
    int ph = 1 + (L / 2) * 12 + (L % 2) * 5;
#define THREAD_VARS() int tid = threadIdx.x; asm volatile("" : "+v"(tid)); const int lane = tid & 63, wave = __builtin_amdgcn_readfirstlane(tid >> 6), gw = vcu * NWAVES + wave; (void)lane; (void)gw

        const bool fox = (L & 1) == 0; const int jl = L >> 1;
        unsigned char* wb = ws + WS_W + (size_t)(L & 1) * W_STRIDE;
        if (ph >= lo && ph < hi) { THREAD_VARS();
            if (L == 1 || L == 2) { convert_layer_weights(args, L + 1, lds, gw, NGW, wave, lane); __syncthreads(); }
            pg8::Gemm g{HB, (const bf16*)(wb + W_IN), M, NIN, D}; pg8::StaticOrder S; S.init(M, NIN, G, bx);
            pg8::EpiScaleBf16<0> E{QB, D, ssqp, D, (size_t)(WS_K - WS_Q) / 2, fox ? attn_body::C2 : 1.0f};
            for (int rep_ = 0; rep_ < (ph == PROBE_DUP ? 2 : 1); ++rep_)
            pg8::gemm_phase<pg8::EpiScaleBf16<0>, pg8::StaticOrder, PG8_ALIGN, PG8_SP2>(lds, g, S, E);
            { const bf16* wsm = (const bf16*)(wb + W_SM); const int fr = lane & 15, fq = lane >> 4, half = wave & 1;
              LAS bf16* WL = (LAS bf16*)lds; LAS f32x4* RED = (LAS f32x4*)(lds + 40960);
              for (int idx = tid; idx < 16 * 128; idx += NWAVES * 64) { const int n = idx >> 7, c8 = idx & 127; *(LAS v4u*)(WL + n * 1032 + c8 * 8) = *(const v4u*)(wsm + n * D + c8 * 8); }
              __syncthreads();
              for (int rep_ = 0; rep_ < (100 + ph == PROBE_DUP ? 2 : 1); ++rep_)
              for (int tb = 0; tb < M / 16; tb += NGW / 2) { const int task = tb + (gw >> 1); const bool live = task < M / 16; const int row = (live ? task : 0) * 16 + fr;
                  const bf16* ap = HB + (size_t)row * D + half * 512 + fq * 8; bf16x8 av[16];
#pragma unroll
                  for (int s = 0; s < 16; ++s) av[s] = *(const bf16x8*)(ap + s * 32);
                  f32x4 acc = (f32x4){0.f, 0.f, 0.f, 0.f};
#pragma unroll
                  for (int s = 0; s < 16; ++s) { const bf16x8 bv = *(const LAS bf16x8*)(WL + fr * 1032 + half * 512 + s * 32 + fq * 8); acc = __builtin_amdgcn_mfma_f32_16x16x32_bf16(bv, av[s], acc, 0, 0, 0); }
                  if (half) RED[(wave >> 1) * 64 + lane] = acc;
                  __syncthreads();
                  if (!half && live) { acc += RED[(wave >> 1) * 64 + lane]; const float rs = pg8::row_rstd(ssqp, row); *(f32x4*)(smallb + (size_t)row * 16 + 4 * fq) = acc * rs; }
                  __syncthreads(); } }
            SEAM();
        }
        ++ph;
        if (fox) {
            if (ph >= lo && ph < hi) { THREAD_VARS();
                LAS float* ckl = (LAS float*)(lds + CKL_OFF); LAS float* wtot = (LAS float*)(lds + CKL_OFF + 16384);
                const float* bf_ = args.in[2] + jl * 16;
                for (int rep_ = 0; rep_ < (ph == PROBE_DUP ? 2 : 1); ++rep_)
                for (int w = vcu; w < 256; w += G) { const int bh = w >> 2, s4 = w & 3, b = bh >> 4, h = bh & 15;
                    __syncthreads();
                    { const float bfh = bf_[h]; const float* fp = smallb + ((size_t)b * SEQ + 8 * tid) * 16 + h; float v[8]; float run = 0.f;
#pragma unroll
                        for (int i = 0; i < 8; ++i) { run += log_sigmoid(fp[i * 16] + bfh); v[i] = run; }
                        float tot = run;
#pragma unroll
                        for (int o = 1; o < 64; o <<= 1) { const float t = __shfl_up(tot, o); if (lane >= o) tot += t; }
                        if (lane == 63) wtot[wave] = tot;
                        __syncthreads();
                        float basev = tot - run;
                        for (int w2 = 0; w2 < wave; ++w2) basev += wtot[w2];
#pragma unroll
                        for (int i = 0; i < 8; ++i) ckl[8 * tid + i] = (basev + v[i]) * 1.4426950408889634f;
                        __syncthreads(); }
#pragma nounroll
                    for (int i = 0; i < 4; ++i) { const int qb = (i == 0) ? s4 : (i == 1) ? 7 - s4 : (i == 2) ? 8 + s4 : 15 - s4;
                        attn_body::attn_unit<8>(b, h, qb, (const attn_body::bf16*)QB, (const attn_body::bf16*)KB, (const attn_body::bf16*)VB, (attn_body::bf16*)((ph == PROBE_DUP && rep_ == 0) ? HB : QB), (char*)lds_raw, (attn_body::lds_cfptr)ckl); } }
                SEAM();
            }
            ++ph;
        } else {
            if (ph >= lo && ph < hi) { THREAD_VARS();
                for (int rep_ = 0; rep_ < (ph == PROBE_DUP ? 2 : 1); ++rep_)
                for (int u = bx; u < 1024; u += G) gla::g1_unit(u, QB, (ph == PROBE_DUP && rep_ == 0) ? HB : QB, KB, smallb, args.in[5] + (size_t)jl * 16 * 512, args.in[6] + jl * 512, LS, EB, lds, tid, wave, lane);
                SEAM();
            }
            ++ph;
            if (ph >= lo && ph < hi) { THREAD_VARS(); if (ph == PROBE_DUP) gla::g2_scan<true>(LS, HB, EB, bx * 512 + tid, G * 512); gla::g2_scan<false>(LS, LS, EB, bx * 512 + tid, G * 512); SEAM(); }
            ++ph;
            if (ph >= lo && ph < hi) { THREAD_VARS();
                for (int rep_ = 0; rep_ < (ph == PROBE_DUP ? 2 : 1); ++rep_)
                for (int u = bx; u < 1024; u += G) gla::g3_unit(u, QB, KB, VB, (ph == PROBE_DUP && rep_ == 0) ? HB : VB, LS, args.in[7] + jl * 256, lds, tid, wave, lane);
                SEAM();
            }
            ++ph;
        }
        if (ph >= lo && ph < hi) { THREAD_VARS();
            pg8::Gemm g{fox ? QB : VB, (const bf16*)(wb + W_O), M, D, D}; pg8::StaticOrder S; S.init(M, D, G, bx);
            for (int rep_ = 0; rep_ < (ph == PROBE_DUP ? 2 : 1); ++rep_) {
            pg8::EpiRes E{L == 0 ? args.in[0] : Hres, (ph == PROBE_DUP && rep_ == 0) ? (float*)LS : Hres, HB, ssqp, D};
            pg8::gemm_phase<pg8::EpiRes, pg8::StaticOrder, PG8_ALIGN, PG8_SP2>(lds, g, S, E); }
            SEAM();
        }
        ++ph;
        if (ph >= lo && ph < hi) { THREAD_VARS();
            pg8::Gemm g{HB, (const bf16*)(wb + W_UP), M, FF, D}; pg8::StaticOrder S; S.init(M, FF, G, bx);
            pg8::EpiScaleBf16<2> E{UB, FF, ssqp, 0, 0, 1.f};
            for (int rep_ = 0; rep_ < (ph == PROBE_DUP ? 2 : 1); ++rep_)
            pg8::gemm_phase<pg8::EpiScaleBf16<2>, pg8::StaticOrder, PG8_ALIGN, PG8_SP2>(lds, g, S, E);
            SEAM();
        }
        ++ph;
        if (ph >= lo && ph < hi) { THREAD_VARS();
            pg8::Gemm g{UB, (const bf16*)(wb + W_DN), M, D, FF}; pg8::StaticOrder S; S.init(M, D, G, bx);
            pg8::EpiRes E{Hres, Hres, HB, ssqp, D};
            pg8::gemm_phase<pg8::EpiRes, pg8::StaticOrder, PG8_ALIGN, PG8_SP2>(lds, g, S, E);
            SEAM();
        }
        ++ph;
    }
#undef SEAM
#undef THREAD_VARS
__global__ void __launch_bounds__(NWAVES * 64, 2) fwd_megakernel(Args args) {
    extern __shared__ __attribute__((aligned(16))) unsigned char lds_raw[];
    cg::grid_group grid = cg::this_grid();
    LAS unsigned char* lds = (LAS unsigned char*)lds_raw;
    const int tid = threadIdx.x, lane = tid & 63, wave = __builtin_amdgcn_readfirstlane(tid >> 6);
    const int G = gridDim.x, bx = blockIdx.x, vcu = (G % 8 == 0) ? (bx % 8) * (G / 8) + bx / 8 : bx;
    const int gw = vcu * NWAVES + wave, NGW = G * NWAVES;
    unsigned char* ws = args.ws;
    float* ssqp = (float*)(ws + WS_SSQ); float* smallb = (float*)(ws + WS_SMALL); float* EB = (float*)(ws + WS_EB);
    bf16* HB = (bf16*)(ws + WS_HB); bf16* QB = (bf16*)(ws + WS_Q); bf16* KB = (bf16*)(ws + WS_K); bf16* VB = (bf16*)(ws + WS_V); bf16* LS = (bf16*)(ws + WS_LS); bf16* UB = (bf16*)(ws + WS_U);
    float* Hres = args.out;
    const int lo = args.ph_lo, hi = args.ph_hi;
    int ph = 0;
    volatile LAS unsigned* bst = (volatile LAS unsigned*)(lds + 131072 + 64);
    if (tid < 2) bst[tid] = 0u;
    __syncthreads();
    const XcdBarrier bar = xcd_barrier_post((unsigned*)(ws + WS_BAR), bst);
#define SEAM() do { if (ph + 1 < hi) { if (ph == 0) grid.sync(); else xcd_barrier(bar); if (PROBE_DUP == 200 && ph == 4) { for (int r_ = 0; r_ < 10; ++r_) xcd_barrier(bar); } } } while (0)

    if (ph >= lo && ph < hi) {
        for (int rep_ = 0; rep_ < (PROBE_DUP == 0 ? 2 : 1); ++rep_) {
        convert_layer_weights(args, 0, lds, gw, NGW, wave, lane);
        convert_layer_weights(args, 1, lds, gw, NGW, wave, lane);
        const float* x = args.in[0];
        for (int m = gw; m < M; m += NGW) { const f32x4* xr = (const f32x4*)(x + (size_t)m * D) + lane; f32x4 v[4]; float s = 0.f;
#pragma unroll
            for (int jj = 0; jj < 4; ++jj) { v[jj] = xr[64 * jj]; s += (v[jj][0] * v[jj][0] + v[jj][1] * v[jj][1]) + (v[jj][2] * v[jj][2] + v[jj][3] * v[jj][3]); }
            s = wave_sum(s);
            v2u* o8 = (v2u*)(HB + (size_t)m * D) + lane;
#pragma unroll
            for (int jj = 0; jj < 4; ++jj) { v2u o; o.x = pk2(v[jj][0], v[jj][1]); o.y = pk2(v[jj][2], v[jj][3]); o8[64 * jj] = o; }
            if (lane < 16) ssqp[(size_t)m * 16 + lane] = (lane == 0) ? s : 0.f; } }
        SEAM();
    }
    ++ph;

    run_layer<0>(args, grid, bar, lds, lds_raw, lo, hi); run_layer<1>(args, grid, bar, lds, lds_raw, lo, hi); run_layer<2>(args, grid, bar, lds, lds_raw, lo, hi); run_layer<3>(args, grid, bar, lds, lds_raw, lo, hi);
    ph = N_PHASES - 1;
    if (ph >= lo && ph < hi) {
        const float* gf = args.in[13];
        for (int m = gw; m < M; m += NGW) { f32x4* xr = (f32x4*)(Hres + (size_t)m * D) + lane; const float rs = pg8::row_rstd(ssqp, m);
#pragma unroll
            for (int jj = 0; jj < 4; ++jj) { const f32x4 gv = ((const f32x4*)gf)[64 * jj + lane]; xr[64 * jj] = xr[64 * jj] * rs * gv; } }
    }
#undef SEAM
}

extern "C" void kernel_launch(void* const* d_in, const int* in_sizes, int n_in, void* d_out, int out_size, void* d_ws, size_t ws_size, hipStream_t stream) {
    static int grid = 0;
    if (grid == 0) {
        if (n_in != 14 || out_size != M * D || ws_size < WS_END) { fprintf(stderr, "kernel_launch: unexpected shapes (n_in %d, out %d, ws %zu)\n", n_in, out_size, ws_size); grid = -1; return; }
        int dev = 0, cus = 0, per_cu = 0;
        (void)hipGetDevice(&dev); (void)hipDeviceGetAttribute(&cus, hipDeviceAttributeMultiprocessorCount, dev);
        if (hipFuncSetAttribute((const void*)fwd_megakernel, hipFuncAttributeMaxDynamicSharedMemorySize, LDS_BYTES) != hipSuccess) { fprintf(stderr, "kernel_launch: hipFuncSetAttribute failed\n"); grid = -1; return; }
        if (hipOccupancyMaxActiveBlocksPerMultiprocessor(&per_cu, (const void*)fwd_megakernel, NWAVES * 64, LDS_BYTES) != hipSuccess || per_cu < 1) { fprintf(stderr, "kernel_launch: occupancy query says %d blocks per CU\n", per_cu); per_cu = 1; }
        (void)hipGetLastError();
        grid = cus * (per_cu < 1 ? 1 : per_cu);
        if (grid > 256) grid = 256;
    }
    if (grid < 0) return;
    (void)hipMemsetAsync((char*)d_ws + WS_BAR, 0, BAR_ZERO_BYTES, stream);
    Args a{};
    for (int i = 0; i < 14; ++i) a.in[i] = (const float*)d_in[i];
    a.out = (float*)d_out; a.ws = (unsigned char*)d_ws;
#if MK_ONE_LAUNCH
    a.ph_lo = 0; a.ph_hi = N_PHASES;
    void* kargs[] = {&a};
    hipError_t e = hipLaunchCooperativeKernel((const void*)fwd_megakernel, dim3(grid), dim3(NWAVES * 64), kargs, LDS_BYTES, stream);
    if (e != hipSuccess) fprintf(stderr, "kernel_launch: cooperative launch failed: %s (grid %d)\n", hipGetErrorString(e), grid);
#else
    for (int p = 0; p < N_PHASES; ++p) { a.ph_lo = p; a.ph_hi = p + 1; hipLaunchKernelGGL(fwd_megakernel, dim3(grid), dim3(NWAVES * 64), LDS_BYTES, stream, a); }
#endif
}
```

```cpp
#include <hip/hip_cooperative_groups.h>
#include <hip/hip_runtime.h>
#include <cstdio>
#include <cstdint>
namespace pg8 {
#define PG8_LAS __attribute__((address_space(3)))
typedef unsigned short bf16_t;
typedef short bf16x8 __attribute__((ext_vector_type(8)));
typedef float f32x4 __attribute__((ext_vector_type(4)));
typedef unsigned u32x4 __attribute__((ext_vector_type(4)));
constexpr int BM = 256, BK = 64, HALF = 128, HTB = HALF * BK * 2  , STAGE_BYTES = 8 * HTB, NXCD = 8, WGM = 4;

__host__ __device__ __forceinline__ int lds_byte(int r, int c) { const int st = (r >> 4) * 2 + (c >> 5), rr = r & 15, cc = c & 31, ob = rr * 64 + cc * 2; return st * 1024 + (ob ^ (((ob >> 9) & 1) << 5)); }
__host__ __device__ __forceinline__ void stage_rc(int b, int& R, int& C) { const int st = b / 1024, sb = b % 1024, swz = sb ^ (((sb >> 9) & 1) << 5); R = (st >> 1) * 16 + swz / 64; C = (st & 1) * 32 + (swz % 64) / 2; }
__host__ __device__ __forceinline__ int perm32(int rho) { const int n = rho >> 4, i = rho & 15; return 8 * (i >> 2) + 4 * n + (i & 3); }

struct Unit { int pm, pn; };
struct Gemm { const bf16_t* A; const bf16_t* Bt; int M, N, K; int ldA, ldB; unsigned kA, kB; size_t tA, tB; };
__device__ __forceinline__ Gemm make_gemm(const bf16_t* A, const bf16_t* Bt, int M, int N, int K, bool blkA, bool blkB) {
    Gemm g; g.A = A; g.Bt = Bt; g.M = M; g.N = N; g.K = K;
    g.ldA = blkA ? 64 : K; g.kA = blkA ? 32768u : 128u; g.tA = blkA ? (size_t)(K / 64) * 32768 : (size_t)256 * K * 2;
    g.ldB = blkB ? 64 : K; g.kB = blkB ? 32768u : 128u; g.tB = blkB ? (size_t)(K / 64) * 32768 : (size_t)256 * K * 2;
    return g; }

struct StaticOrder {
    int nM, nN, nwg, G, c;
    __host__ __device__ void init(int M, int N, int G_, int c_) { nM = M / BM; nN = N / BM; nwg = nM * nN; G = G_; c = c_; }
    __host__ __device__ bool next(int i, Unit& u) const {
        const long L = (long)i * G + c; if (L >= nwg) return false;
        int wgid = (int)L; { const int q = nwg / NXCD, r = nwg % NXCD, xcd = wgid % NXCD, off = wgid / NXCD; wgid = (xcd < r ? xcd * (q + 1) : r * (q + 1) + (xcd - r) * q) + off; }
        const int nig = WGM * nN, gid = wgid / nig, fm = gid * WGM, gsz = (nM - fm) < WGM ? (nM - fm) : WGM;
        u.pm = fm + ((wgid % nig) % gsz); u.pn = (wgid % nig) / gsz; return true;
    }
    __device__ __forceinline__ void a_ready(const Unit&) const {}
    __device__ __forceinline__ void done(const Unit&) const {}
};

__device__ __forceinline__ unsigned cvt_pk_bf16(float lo, float hi) { unsigned r; asm volatile("v_cvt_pk_bf16_f32 %0, %1, %2" : "=v"(r) : "v"(lo), "v"(hi)); return r; }
typedef float f32x2 __attribute__((ext_vector_type(2)));
typedef unsigned u32x2 __attribute__((ext_vector_type(2)));
__device__ __forceinline__ float row_rstd(const float* ssqp, int row) {
    const f32x4* p = (const f32x4*)(ssqp + (size_t)row * 16);
    const f32x4 a = p[0], b = p[1], c = p[2], d = p[3];
    const f32x4 s = (a + b) + (c + d);
    const float t = (s[0] + s[1]) + (s[2] + s[3]);
    return __builtin_amdgcn_rsqf(t * (1.0f / 1024.0f) + 1e-6f);
}
template <int ACT, bool BLK = false> struct EpiScaleBf16 {
    static constexpr bool PERM = true, AFTER_DRAIN = false;
    bf16_t* O; int ldc; const float* ssqp; int split_cols; size_t split_stride; float scale0;
    unsigned* norms;
    __device__ __forceinline__ void operator()(const f32x4 (&acc)[2][2][4][2], const Unit& u, int wr, int wc, int fr, int fq) const {
        const int row0 = u.pm * BM + wr * 64 + fr; int colt = u.pn * BM; bf16_t* base = O; int tsplit = 0;
        float sc = 1.f; if (split_cols) { const int t = colt / split_cols; tsplit = t; base += (size_t)t * split_stride; colt -= t * split_cols; if (t == 0) sc = scale0; }
        const bool do_norm = (norms != nullptr) && tsplit < 2; float hm[2] = {0.f, 0.f};
        const int col0 = colt + wc * 32 + 8 * fq;
        f32x4 pq[2][4]; float rsv[2][4];
#pragma unroll
        for (int ai = 0; ai < 2; ++ai)
#pragma unroll
            for (int m = 0; m < 4; ++m) pq[ai][m] = *(const f32x4*)(ssqp + (size_t)(row0 + ai * HALF + m * 16) * 16 + 4 * fq);
#pragma unroll
        for (int ai = 0; ai < 2; ++ai)
#pragma unroll
            for (int m = 0; m < 4; ++m) { float t = (pq[ai][m][0] + pq[ai][m][1]) + (pq[ai][m][2] + pq[ai][m][3]); t += __shfl_xor(t, 16); t += __shfl_xor(t, 32);
                rsv[ai][m] = __builtin_amdgcn_rsqf(t * (1.0f / 1024.0f) + 1e-6f) * sc; }
#pragma unroll
        for (int ai = 0; ai < 2; ++ai)
#pragma unroll
            for (int m = 0; m < 4; ++m) { const int row = row0 + ai * HALF + m * 16; const float rs = rsv[ai][m];
                bf16_t* rowp = BLK ? base + ((size_t)(u.pm * (ldc >> 6) + u.pn * 4 + (wc >> 1)) * 256 + (wr * 64 + fr + ai * HALF + m * 16)) * 64 + (wc & 1) * 32 + 8 * fq : base + (size_t)row * ldc + col0;
#pragma unroll
                for (int bj = 0; bj < 2; ++bj) { f32x4 v0 = acc[ai][bj][m][0] * rs, v1 = acc[ai][bj][m][1] * rs;
                    if (ACT == 2) {
#pragma unroll
                        for (int e = 0; e < 4; ++e) { const float a = __builtin_fmaxf(v0[e], 0.f), b = __builtin_fmaxf(v1[e], 0.f); v0[e] = a * a; v1[e] = b * b; } }
                    if (do_norm) { float q = ((v0[0] * v0[0] + v0[1] * v0[1]) + (v0[2] * v0[2] + v0[3] * v0[3])) + ((v1[0] * v1[0] + v1[1] * v1[1]) + (v1[2] * v1[2] + v1[3] * v1[3]));
                        q += __shfl_xor(q, 16); q += __shfl_xor(q, 32); hm[bj] = __builtin_fmaxf(hm[bj], q); }
                    u32x4 w; w.x = cvt_pk_bf16(v0[0], v0[1]); w.y = cvt_pk_bf16(v0[2], v0[3]); w.z = cvt_pk_bf16(v1[0], v1[1]); w.w = cvt_pk_bf16(v1[2], v1[3]);
                    *(u32x4*)(rowp + (BLK ? bj * 2 * 256 * 64 : bj * HALF)) = w; } }
        if (do_norm) {
#pragma unroll
            for (int bj = 0; bj < 2; ++bj) { float m = hm[bj];
#pragma unroll
                for (int o = 1; o < 16; o <<= 1) m = __builtin_fmaxf(m, __shfl_xor(m, o));
                if (fr == 0 && fq == 0) __hip_atomic_fetch_max(norms + 2 * ((u.pm >> 4) * 16 + ((colt + bj * HALF + wc * 32) >> 6)) + (tsplit == 0 ? 1 : 0), __float_as_uint(2.0f * m), __ATOMIC_RELAXED, __HIP_MEMORY_SCOPE_AGENT); } }
    }
};
struct EpiRes {
    static constexpr bool PERM = true, AFTER_DRAIN = false;
    bf16_t* hb; float* ssqp; int ldc;
    __device__ __forceinline__ void operator()(const f32x4 (&acc)[2][2][4][2], const Unit& u, int wr, int wc, int fr, int fq) const {
        const int row0 = u.pm * BM + wr * 64 + fr, col0 = u.pn * BM + wc * 32 + 8 * fq;
#pragma unroll
        for (int ai = 0; ai < 2; ++ai) {
            u32x4 old[4][2];
#pragma unroll
            for (int m = 0; m < 4; ++m)
#pragma unroll
                for (int bj = 0; bj < 2; ++bj) old[m][bj] = *(const u32x4*)(hb + (size_t)(row0 + ai * HALF + m * 16) * ldc + col0 + bj * HALF);
#pragma unroll
            for (int m = 0; m < 4; ++m) { const int r = row0 + ai * HALF + m * 16; bf16_t* rowp = hb + (size_t)r * ldc + col0; float q = 0.f;
#pragma unroll
                for (int bj = 0; bj < 2; ++bj) { const u32x4 ov = old[m][bj]; const f32x4 a0 = acc[ai][bj][m][0], a1 = acc[ai][bj][m][1];
                    const float o0 = __uint_as_float(ov.x << 16) + a0[0], o1 = __uint_as_float(ov.x & 0xffff0000u) + a0[1], o2 = __uint_as_float(ov.y << 16) + a0[2], o3 = __uint_as_float(ov.y & 0xffff0000u) + a0[3];
                    const float o4 = __uint_as_float(ov.z << 16) + a1[0], o5 = __uint_as_float(ov.z & 0xffff0000u) + a1[1], o6 = __uint_as_float(ov.w << 16) + a1[2], o7 = __uint_as_float(ov.w & 0xffff0000u) + a1[3];
                    q += ((o0 * o0 + o1 * o1) + (o2 * o2 + o3 * o3)) + ((o4 * o4 + o5 * o5) + (o6 * o6 + o7 * o7));
                    u32x4 w; w.x = cvt_pk_bf16(o0, o1); w.y = cvt_pk_bf16(o2, o3); w.z = cvt_pk_bf16(o4, o5); w.w = cvt_pk_bf16(o6, o7);
                    *(u32x4*)(rowp + bj * HALF) = w; }
                q += __shfl_xor(q, 16); q += __shfl_xor(q, 32);
                if (fq == 0) ssqp[(size_t)r * 16 + u.pn * 4 + wc] = q; }
            asm volatile("" ::: "memory"); }
    }
};

template <class Epi, class Sched, bool ALIGN_EPI = false, bool SP2 = false>
__device__ __forceinline__ void gemm_phase(PG8_LAS unsigned char* lds, const Gemm g, const Sched& S, const Epi& E) {
    int tid = threadIdx.x; asm volatile("" : "+v"(tid)); const int wid = __builtin_amdgcn_readfirstlane(tid >> 6), lane = tid & 63, wr = wid >> 2, wc = wid & 3, fr = lane & 15, fq = lane >> 4;
    const int K = g.K, nt = K / BK;
    unsigned voffA[2], voffB[2];
#pragma unroll
    for (int i = 0; i < 2; ++i) { int R, C; stage_rc(tid * 16 + i * 8192, R, C); const int Rb = Epi::PERM ? ((R & ~31) + perm32(R & 31)) : R;
        voffA[i] = (unsigned)(R * g.ldA + C) * 2u; voffB[i] = (unsigned)(Rb * g.ldB + C) * 2u; }
    const size_t kstepA = g.kA, kstepB = g.kB;
    const size_t hstepA = (size_t)HALF * g.ldA * 2, hstepB = (size_t)HALF * g.ldB * 2;
    const size_t tstepA = g.tA, tstepB = g.tB;
    const unsigned ldsw = (unsigned)wid * 1024u;
    const int aoff = lds_byte(wr * 64 + fr, fq * 8), boff = lds_byte(wc * 32 + fr, fq * 8);
#define PG8_SA(b, h) (((b) * 2 + (h)) * HTB)
#define PG8_SB(b, h) ((4 + (b) * 2 + (h)) * HTB)
#define PG8_STAGE(bufoff, gbase, voff) do { _Pragma("unroll") for (int _i = 0; _i < 2; ++_i) \
        __builtin_amdgcn_global_load_lds((const unsigned*)((const char*)(gbase) + (voff)[_i]), (PG8_LAS unsigned*)(lds + (bufoff) + ldsw + _i * 8192), 16, 0, 0); } while (0)
#define PG8_LDA(dst, b, h) do { _Pragma("unroll") for (int m = 0; m < 4; ++m) _Pragma("unroll") for (int k = 0; k < 2; ++k) dst[m][k] = *(const PG8_LAS bf16x8*)(lds + PG8_SA(b, h) + aoff + m * 2048 + k * 1024); } while (0)
#define PG8_LDB(dst, b, h) do { _Pragma("unroll") for (int n = 0; n < 2; ++n) _Pragma("unroll") for (int k = 0; k < 2; ++k) dst[n][k] = *(const PG8_LAS bf16x8*)(lds + PG8_SB(b, h) + boff + n * 2048 + k * 1024); } while (0)
#define PG8_MMA(ai, bj, At, Bt) do { __builtin_amdgcn_s_setprio(1); _Pragma("unroll") for (int m = 0; m < 4; ++m) _Pragma("unroll") for (int n = 0; n < 2; ++n) _Pragma("unroll") for (int k = 0; k < 2; ++k) \
        acc[ai][bj][m][n] = __builtin_amdgcn_mfma_f32_16x16x32_bf16(Bt[n][k], At[m][k], acc[ai][bj][m][n], 0, 0, 0); __builtin_amdgcn_s_setprio(0); } while (0)
#define PG8_WAIT_V(n) asm volatile("s_waitcnt vmcnt(" #n ")" ::: "memory")
#define PG8_WAIT_L(n) asm volatile("s_waitcnt lgkmcnt(" #n ")" ::: "memory")
#define PG8_BAR __builtin_amdgcn_s_barrier()
#define PG8_SCHED __builtin_amdgcn_sched_barrier(0)
    Unit cur, nxt; int ui = 0;
    if (!S.next(0, cur)) return;
    f32x4 acc[2][2][4][2];
#pragma unroll
    for (int a = 0; a < 2; ++a)
#pragma unroll
        for (int b = 0; b < 2; ++b)
#pragma unroll
            for (int m = 0; m < 4; ++m)
#pragma unroll
                for (int n = 0; n < 2; ++n) acc[a][b][m][n] = (f32x4){0.f, 0.f, 0.f, 0.f};
    bf16x8 At[4][2], B0[2][2], B1[2][2];
    const char* cA = (const char*)g.A + (size_t)cur.pm * tstepA; const char* cB = (const char*)g.Bt + (size_t)cur.pn * tstepB;
    S.a_ready(cur);
    if constexpr (SP2) {
        PG8_STAGE(PG8_SB(0, 0), cB, voffB); PG8_STAGE(PG8_SB(0, 1), cB + hstepB, voffB); PG8_STAGE(PG8_SA(0, 0), cA, voffA); PG8_STAGE(PG8_SA(0, 1), cA + hstepA, voffA);
        if (wr == 1) PG8_BAR;
        PG8_WAIT_V(2); PG8_BAR;
        PG8_STAGE(PG8_SB(1, 0), cB + kstepB, voffB); PG8_STAGE(PG8_SA(1, 0), cA + kstepA, voffA); PG8_STAGE(PG8_SB(1, 1), cB + hstepB + kstepB, voffB);
        PG8_WAIT_V(6); PG8_BAR;
    } else {
        PG8_STAGE(PG8_SB(0, 0), cB, voffB); PG8_STAGE(PG8_SA(0, 0), cA, voffA); PG8_STAGE(PG8_SB(0, 1), cB + hstepB, voffB); PG8_STAGE(PG8_SA(0, 1), cA + hstepA, voffA);
        if (wr == 1) PG8_BAR;
        PG8_WAIT_V(4); PG8_BAR;
        PG8_STAGE(PG8_SB(1, 0), cB + kstepB, voffB); PG8_STAGE(PG8_SA(1, 0), cA + kstepA, voffA); PG8_STAGE(PG8_SB(1, 1), cB + hstepB + kstepB, voffB);
        PG8_WAIT_V(6); PG8_BAR;
    }
    for (;;) {
        const bool has_next = S.next(ui + 1, nxt);
        const char* nA = has_next ? (const char*)g.A + (size_t)nxt.pm * tstepA : cA; const char* nB = has_next ? (const char*)g.Bt + (size_t)nxt.pn * tstepB : cB;
        for (int t = 0; t < nt; t += 2) {
            const bool last = (t == nt - 2);
            const char* a1 = cA + (size_t)(t + 1) * kstepA;
            const char* a2 = last ? nA : cA + (size_t)(t + 2) * kstepA; const char* b2 = last ? nB : cB + (size_t)(t + 2) * kstepB;
            const char* a3 = a2 + kstepA; const char* b3 = b2 + kstepB;
            if (last && has_next) S.a_ready(nxt);
            if constexpr (SP2) {
            PG8_LDB(B0, 0, 0); PG8_LDB(B1, 0, 1); PG8_SCHED; PG8_LDA(At, 0, 0); PG8_STAGE(PG8_SA(1, 1), a1 + hstepA, voffA);
            PG8_WAIT_V(8); PG8_WAIT_L(0); PG8_BAR; PG8_MMA(0, 0, At, B0); PG8_MMA(0, 1, At, B1); PG8_BAR; PG8_SCHED;
            PG8_LDA(At, 0, 1); PG8_STAGE(PG8_SB(0, 0), b2, voffB); PG8_STAGE(PG8_SB(0, 1), b2 + hstepB, voffB); PG8_STAGE(PG8_SA(0, 0), a2, voffA);
            PG8_WAIT_V(8); PG8_WAIT_L(0); PG8_BAR; PG8_MMA(1, 0, At, B0); PG8_MMA(1, 1, At, B1); PG8_BAR; PG8_SCHED;
            PG8_LDB(B0, 1, 0); PG8_LDB(B1, 1, 1); PG8_SCHED; PG8_LDA(At, 1, 0); PG8_STAGE(PG8_SA(0, 1), a2 + hstepA, voffA);
            PG8_WAIT_V(8); PG8_WAIT_L(0); PG8_BAR; PG8_MMA(0, 0, At, B0); PG8_MMA(0, 1, At, B1); PG8_BAR; PG8_SCHED;
            PG8_LDA(At, 1, 1); PG8_STAGE(PG8_SB(1, 0), b3, voffB); PG8_STAGE(PG8_SB(1, 1), b3 + hstepB, voffB); PG8_STAGE(PG8_SA(1, 0), a3, voffA);
            PG8_WAIT_V(8); PG8_WAIT_L(0); PG8_BAR; PG8_MMA(1, 0, At, B0); PG8_MMA(1, 1, At, B1); PG8_BAR; PG8_SCHED;
            } else {
            PG8_LDB(B0, 0, 0); PG8_SCHED; PG8_LDA(At, 0, 0); PG8_STAGE(PG8_SA(1, 1), a1 + hstepA, voffA);
            PG8_WAIT_L(8); PG8_BAR; PG8_WAIT_L(0); PG8_MMA(0, 0, At, B0); PG8_BAR; PG8_SCHED;
            PG8_LDB(B1, 0, 1); PG8_STAGE(PG8_SB(0, 0), b2, voffB);
            PG8_BAR; PG8_WAIT_L(0); PG8_MMA(0, 1, At, B1); PG8_BAR;
            PG8_LDA(At, 0, 1); PG8_STAGE(PG8_SA(0, 0), a2, voffA);
            PG8_BAR; PG8_WAIT_L(0); PG8_MMA(1, 0, At, B0); PG8_BAR; PG8_SCHED;
            PG8_STAGE(PG8_SB(0, 1), b2 + hstepB, voffB);
            PG8_WAIT_V(6); PG8_BAR; PG8_MMA(1, 1, At, B1); PG8_BAR;
            PG8_LDB(B0, 1, 0); PG8_SCHED; PG8_LDA(At, 1, 0); PG8_STAGE(PG8_SA(0, 1), a2 + hstepA, voffA);
            PG8_WAIT_L(8); PG8_BAR; PG8_WAIT_L(0); PG8_MMA(0, 0, At, B0); PG8_BAR; PG8_SCHED;
            PG8_LDB(B1, 1, 1); PG8_STAGE(PG8_SB(1, 0), b3, voffB);
            PG8_BAR; PG8_WAIT_L(0); PG8_MMA(0, 1, At, B1); PG8_BAR;
            PG8_LDA(At, 1, 1); PG8_STAGE(PG8_SA(1, 0), a3, voffA);
            PG8_BAR; PG8_WAIT_L(0); PG8_MMA(1, 0, At, B0); PG8_BAR; PG8_SCHED;
            PG8_STAGE(PG8_SB(1, 1), b3 + hstepB, voffB);
            PG8_WAIT_V(6); PG8_BAR; PG8_MMA(1, 1, At, B1); PG8_BAR;
            }
        }
        if constexpr (ALIGN_EPI) { if (wr == 0) PG8_BAR; }
        if constexpr (!Epi::AFTER_DRAIN) { E(acc, cur, wr, wc, fr, fq); S.done(cur); }
        if (!has_next) break;
#pragma unroll
        for (int a = 0; a < 2; ++a)
#pragma unroll
            for (int b = 0; b < 2; ++b)
#pragma unroll
                for (int m = 0; m < 4; ++m)
#pragma unroll
                    for (int n = 0; n < 2; ++n) acc[a][b][m][n] = (f32x4){0.f, 0.f, 0.f, 0.f};
        cur = nxt; cA = nA; cB = nB; ++ui;
        if constexpr (ALIGN_EPI) { if (wr == 1) PG8_BAR; }
    }
    PG8_WAIT_V(0);
    if constexpr (!ALIGN_EPI) { if (wr == 0) PG8_BAR; }
    PG8_BAR;
    if constexpr (Epi::AFTER_DRAIN) { E.fused(acc, cur, wr, wc, fr, fq, lds, wid, lane); S.done(cur); }
#undef PG8_SA
#undef PG8_SB
#undef PG8_STAGE
#undef PG8_LDA
#undef PG8_LDB
#undef PG8_MMA
#undef PG8_WAIT_V
#undef PG8_WAIT_L
#undef PG8_BAR
#undef PG8_SCHED
}
}

#ifndef PG8_SP2
#define PG8_SP2 true
#endif
#ifndef PG8_ALIGN
#define PG8_ALIGN true
#endif
#include <hip/hip_bf16.h>
#include <cmath>
namespace attn_body {
using bf16=__hip_bfloat16;
using bf16x8=__attribute__((ext_vector_type(8)))short;
using s16x4=__attribute__((ext_vector_type(4)))short;
using f32x16=__attribute__((ext_vector_type(16)))float;
using u32x4=__attribute__((ext_vector_type(4)))unsigned;
constexpr int BATCH=4,NHEAD=16,SEQ=4096,D=64,DM=NHEAD*D;
constexpr int NW=8,QBLK=32,QB=QBLK*NW,KVBLK=64,NQB=SEQ/QB;
constexpr int ATTN_PITCH=DM, ATTN_UNIT_ROWS=QB;
__device__ __forceinline__ int crow(int r,int hi){return (r&3)+8*(r>>2)+4*hi;}
#define SBAR() __builtin_amdgcn_sched_barrier(0)
__device__ __forceinline__ void cmask(f32x16&p0,f32x16&p1,int jb,int qrel,int hi){
  const float NEG=-INFINITY; int kb=64*jb+4*hi;
  #pragma unroll
  for(int r=0;r<16;++r){int kv=kb+(r&3)+8*(r>>2); if(kv>qrel)p0[r]=NEG; if(kv+32>qrel)p1[r]=NEG;}
}

constexpr int NSLOT=3, SLOTB=8192;
constexpr int LDS_K=0, LDS_V=NSLOT*SLOTB, LDS_WS=2*NSLOT*SLOTB, LDS_OST=LDS_WS+NW*64*4, LDS_BYTES=LDS_OST+NW*4096;
constexpr float C2=0.125f*1.4426950408889634f;
__device__ __forceinline__ void glds16(const void*gsrc,unsigned lds_dst){unsigned keep;
  asm volatile("s_mov_b32 %0, m0\n\ts_mov_b32 m0, %2\n\ts_nop 0\n\tglobal_load_lds_dwordx4 %1, off\n\ts_mov_b32 m0, %0":"=&s"(keep):"v"(gsrc),"s"(lds_dst):"memory");}
__device__ __forceinline__ float max3f(float a,float b,float c){float r;asm("v_max3_f32 %0, %1, %2, %3":"=v"(r):"v"(a),"v"(b),"v"(c));return r;}
__device__ __forceinline__ float max2f(float a,float b){float r;asm("v_max_f32_e32 %0, %1, %2":"=v"(r):"v"(a),"v"(b));return r;}
__device__ __forceinline__ float fadd_s(float a,float b){float r;asm("v_add_f32_e32 %0, %1, %2":"=v"(r):"v"(a),"v"(b));return r;}
__device__ __forceinline__ float fsub_s(float a,float b){float r;asm("v_sub_f32_e32 %0, %1, %2":"=v"(r):"v"(a),"v"(b));return r;}
typedef float f32x2_t __attribute__((ext_vector_type(2))); typedef __bf16 bf16x2_t __attribute__((ext_vector_type(2)));
__device__ __forceinline__ unsigned cvtpk_s(float lo,float hi){f32x2_t v={lo,hi};bf16x2_t b=__builtin_convertvector(v,bf16x2_t);return __builtin_bit_cast(unsigned,b);}
#define WAIT_BAR(N) asm volatile("s_waitcnt vmcnt(" #N ") lgkmcnt(0)\n\ts_barrier":::"memory")

__device__ __forceinline__ void qkt(f32x16&p0,f32x16&p1,const char*Kslot,const bf16x8*qr,int r32,int hi){
  const char*kb=Kslot+hi*1024+r32*16;
  #pragma unroll
  for(int d0=0;d0<4;++d0){
    const bf16x8 b0=*reinterpret_cast<const bf16x8*>(kb+d0*2048);
    const bf16x8 b1=*reinterpret_cast<const bf16x8*>(kb+d0*2048+512);
    {p0=__builtin_amdgcn_mfma_f32_32x32x16_bf16(b0,qr[d0],p0,0,0,0);p1=__builtin_amdgcn_mfma_f32_32x32x16_bf16(b1,qr[d0],p1,0,0,0);}}
}
typedef __attribute__((address_space(3))) const char* lds_cptr;
typedef short v4i16_t __attribute__((ext_vector_type(4)));
__device__ __forceinline__ void kload8(bf16x8*kf,lds_cptr kp){
  kf[0]=*(const __attribute__((address_space(3))) bf16x8*)(kp);      kf[1]=*(const __attribute__((address_space(3))) bf16x8*)(kp+512);
  kf[2]=*(const __attribute__((address_space(3))) bf16x8*)(kp+2048); kf[3]=*(const __attribute__((address_space(3))) bf16x8*)(kp+2560);
  kf[4]=*(const __attribute__((address_space(3))) bf16x8*)(kp+4096); kf[5]=*(const __attribute__((address_space(3))) bf16x8*)(kp+4608);
  kf[6]=*(const __attribute__((address_space(3))) bf16x8*)(kp+6144); kf[7]=*(const __attribute__((address_space(3))) bf16x8*)(kp+6656);
}
__device__ __forceinline__ void kload2(bf16x8*kf,lds_cptr kp,int j){ kf[2*j]=*(const __attribute__((address_space(3))) bf16x8*)(kp+j*2048); kf[2*j+1]=*(const __attribute__((address_space(3))) bf16x8*)(kp+j*2048+512); }
__device__ __forceinline__ s16x4 vtr(lds_cptr p){ return __builtin_bit_cast(s16x4,__builtin_amdgcn_ds_read_tr16_b64_v4i16((__attribute__((address_space(3))) v4i16_t*)p)); }
__device__ __forceinline__ float rowmax(const f32x16&p0,const f32x16&p1){
  float a=max3f(p0[0],p0[1],p1[0]),b=max3f(p0[2],p0[3],p1[1]);a=max3f(a,p1[2],p1[3]);
  #pragma unroll
  for(int r=4;r<16;r+=4){a=max3f(a,p0[r],p0[r+1]);b=max3f(b,p0[r+2],p0[r+3]);a=max3f(a,p1[r],p1[r+1]);b=max3f(b,p1[r+2],p1[r+3]);}
  const float m=max2f(a,b);
  auto rr=__builtin_amdgcn_permlane32_swap(__float_as_uint(m),__float_as_uint(m),false,false);
  return max2f(__uint_as_float(rr[0]),__uint_as_float(rr[1]));
}
__device__ __forceinline__ void pv(f32x16*o,int vb,bf16x8 pa0,bf16x8 pa1,bf16x8 pa2,bf16x8 pa3){
  #pragma unroll
  for(int d0=0;d0<2;++d0){s16x4 lo[4],hi[4];
    #pragma unroll
    for(int ks=0;ks<4;++ks){
      asm volatile("ds_read_b64_tr_b16 %0,%1 offset:%c2":"=&v"(lo[ks]):"v"(vb),"i"(d0*4096+ks*1024):"memory");
      asm volatile("ds_read_b64_tr_b16 %0,%1 offset:%c2":"=&v"(hi[ks]):"v"(vb),"i"(d0*4096+ks*1024+512):"memory");}
    asm volatile("s_waitcnt lgkmcnt(0)":::"memory");SBAR();
    #define PK(k) (bf16x8){lo[k][0],lo[k][1],lo[k][2],lo[k][3],hi[k][0],hi[k][1],hi[k][2],hi[k][3]}
    o[d0]=__builtin_amdgcn_mfma_f32_32x32x16_bf16(pa0,PK(0),o[d0],0,0,0);
    o[d0]=__builtin_amdgcn_mfma_f32_32x32x16_bf16(pa1,PK(1),o[d0],0,0,0);
    o[d0]=__builtin_amdgcn_mfma_f32_32x32x16_bf16(pa2,PK(2),o[d0],0,0,0);
    o[d0]=__builtin_amdgcn_mfma_f32_32x32x16_bf16(pa3,PK(3),o[d0],0,0,0);
    #undef PK
  }
}

#ifndef ATTN_STORE16
#define ATTN_STORE16(p,v) (*(u32x4*)(p)=(v))
#endif
typedef __attribute__((address_space(3))) const float* lds_cfptr;
typedef float f32x4a __attribute__((ext_vector_type(4)));
#define BIASINIT(C0,C1,t) do{ const lds_cfptr cb_=cklt+64*(t)+4*hi; \
    { f32x4a v_[4]; _Pragma("unroll") for(int j_=0;j_<4;++j_) v_[j_]=*(const __attribute__((address_space(3))) f32x4a*)(cb_+8*j_); \
      _Pragma("unroll") for(int j_=0;j_<4;++j_) _Pragma("unroll") for(int i_=0;i_<4;++i_) C0[4*j_+i_]=nm-v_[j_][i_]; } \
    SBAR(); \
    { f32x4a v_[4]; _Pragma("unroll") for(int j_=0;j_<4;++j_) v_[j_]=*(const __attribute__((address_space(3))) f32x4a*)(cb_+32+8*j_); \
      _Pragma("unroll") for(int j_=0;j_<4;++j_) _Pragma("unroll") for(int i_=0;i_<4;++i_) C1[4*j_+i_]=nm-v_[j_][i_]; } }while(0)
template<int THRL> __device__ __forceinline__ void attn_unit(int b,int h,int qb,const bf16*Q,const bf16*__restrict__ K,const bf16*__restrict__ V,bf16*O,char*shm,lds_cfptr ckl,int t0){
  int tid=threadIdx.x; asm volatile("":"+v"(tid)); const int lane=tid&63,r32=lane&31,hi=lane>>5; const int wid=__builtin_amdgcn_readfirstlane(tid>>6);
  const long rowbase=(long)b*SEQ; const int q0=qb*QB;
  const bf16*Qw=Q+(rowbase+q0+wid*QBLK)*DM+h*D;
  const bf16*Kh=K+(rowbase+(long)t0*KVBLK)*DM+h*D,*Vh=V+(rowbase+(long)t0*KVBLK)*DM+h*D; const lds_cfptr cklt=ckl+64*t0;
  const unsigned lds0=(unsigned)(uintptr_t)shm;
  float*wsf=(float*)(shm+LDS_WS)+wid*64;
  const bf16*ksrc=Kh+(long)lane*DM+wid*8;
  const bf16*vsrc=Vh+(long)(16*(wid&3)+(lane>>2))*DM+(wid>>2)*32+(lane&3)*8;
  const unsigned kdst=lds0+LDS_K+wid*1024, vdst=lds0+LDS_V+wid*1024;
  #define DMA_K(t,slot) glds16(ksrc+(long)(t)*KVBLK*DM,(unsigned)__builtin_amdgcn_readfirstlane(kdst+(slot)))
  #define DMA_V(t,slot) glds16(vsrc+(long)(t)*KVBLK*DM,(unsigned)__builtin_amdgcn_readfirstlane(vdst+(slot)))
  const int vb0=(int)(lds0+LDS_V)+((lane>>4)&1)*32+(lane&3)*8+(4*hi+((lane&15)>>2))*64;
  const char*Kbase=shm+LDS_K; bf16x8 kf[8];
  const lds_cptr shm3=(lds_cptr)shm; const lds_cptr kp0=shm3+LDS_K+hi*1024+r32*16; const lds_cptr vp0=shm3+LDS_V+((lane>>4)&1)*32+(lane&3)*8+(4*hi+((lane&15)>>2))*64;
  const int NT=(q0+QB)/KVBLK-t0;
  DMA_K(0,0);DMA_V(0,0);DMA_K(1,SLOTB);
  bf16x8 qr[4];
  #pragma unroll
  for(int d0=0;d0<4;++d0)qr[d0]=*reinterpret_cast<const bf16x8*>(&Qw[(long)r32*DM+d0*16+hi*8]);
  float mhat=0.f,l_reg=0.f;f32x16 o[2];o[0]=f32x16{};o[1]=f32x16{};
  const int qrel=wid*QBLK+r32; float nm=ckl[q0+qrel];
  #define CMASK(P0,P1,t) do{int jb_=(t)-(NT-4); if(jb_>=0)cmask(P0,P1,jb_,qrel,hi);}while(0)
  bool resc=false;
  #define START(P0,P1) do{ const float rm=rowmax(P0,P1); resc=false; \
    { const float dl=__builtin_fmaxf(rm,0.f); mhat=fadd_s(mhat,dl); nm=fsub_s(nm,dl); \
      _Pragma("unroll") for(int r=0;r<16;++r){P0[r]=fsub_s(P0[r],dl);P1[r]=fsub_s(P1[r],dl);} } \
    _Pragma("unroll") for(int r=0;r<16;++r)P0[r]=__builtin_amdgcn_exp2f(P0[r]); }while(0)
  #define RESC() do{ if(resc){ asm volatile("s_waitcnt lgkmcnt(0)":::"memory"); \
      _Pragma("unroll") for(int d_=0;d_<2;++d_) _Pragma("unroll") for(int r=0;r<16;++r)o[d_][r]*=wsf[crow(r,hi)]; } }while(0)
  f32x16 pA0,pA1,pB0,pB1;
  int sl_prev=0,sl_cur=0,sl_next=SLOTB;
  #define ROT() do{sl_prev=sl_cur;sl_cur=sl_next;sl_next=(sl_next==(NSLOT-1)*SLOTB)?0:sl_next+SLOTB;}while(0)
  DMA_K(2,2*SLOTB);
  WAIT_BAR(3);
  BIASINIT(pA0,pA1,0); qkt(pA0,pA1,Kbase,qr,r32,hi);asm volatile("s_nop 15\n\ts_nop 7":"+v"(pA0),"+v"(pA1));CMASK(pA0,pA1,0);
  START(pA0,pA1);
  _Pragma("unroll") for(int r=0;r<16;++r)pA1[r]=__builtin_amdgcn_exp2f(pA1[r]);
  WAIT_BAR(0);
  DMA_K(3,0);DMA_V(1,SLOTB);
  ROT();
  kload8(kf,kp0+sl_cur);
  WAIT_BAR(2);
  s16x4 vlo[8],vhi[8]; u32x4 pw0,pw1,pw2,pw3;
  #define PKW(P,B) cvtpk_s(P[B],P[B+1])
  #define PAF(k) __builtin_bit_cast(bf16x8,pw##k)
  #define VFR(i) (bf16x8){vlo[i][0],vlo[i][1],vlo[i][2],vlo[i][3],vhi[i][0],vhi[i][1],vhi[i][2],vhi[i][3]}
  #define PIN(x) asm volatile("":"+v"(x))
  #define MX3(a,b,c) __builtin_fmaxf(__builtin_fmaxf((a),(b)),(c))
  #define GAPA(MF,A0,A1,A2,A3,W0,W1,PW) do{ MF; sacc+=A0; sacc+=A1; sacc+=A2; sacc+=A3; PIN(sacc); W0; W1; PIN(PW); SBAR(); }while(0)
  #define EX(v) __builtin_amdgcn_exp2f(v)
  #define GAPB(MF,X,B) do{ MF; X[B]=EX(X[B]); X[B+1]=EX(X[B+1]); X[B+2]=EX(X[B+2]); X[B+3]=EX(X[B+3]); PIN(X); SBAR(); }while(0)
  #define VRD(i) do{ vlo[i]=vtr(vp_+(((i)>>2)*4096+((i)&3)*1024)); vhi[i]=vtr(vp_+(((i)>>2)*4096+((i)&3)*1024+512)); }while(0)
  #define KRD(G,j) do{ if(G){ kload2(kf,kp0+sl_next,j); SBAR(); } }while(0)
  #define STEP(C0,C1,P0,P1,t,GK,GV,GL) do{ SBAR(); \
    BIASINIT(C0,C1,t); SBAR(); \
    const lds_cptr vp_=vp0+sl_prev; \
    VRD(0); SBAR(); float sacc=(P0[0]+P0[1]); \
    GAPA(C0=__builtin_amdgcn_mfma_f32_32x32x16_bf16(kf[0],qr[0],C0,0,0,0), P0[2],P0[3],P0[4],P0[5],     pw0[0]=PKW(P0,0), pw0[1]=PKW(P0,2), pw0); \
    VRD(4); SBAR(); GAPA(C1=__builtin_amdgcn_mfma_f32_32x32x16_bf16(kf[1],qr[0],C1,0,0,0), P0[6],P0[7],P0[8],P0[9],     pw0[2]=PKW(P0,4), pw0[3]=PKW(P0,6), pw0); \
    VRD(1); SBAR(); GAPA(C0=__builtin_amdgcn_mfma_f32_32x32x16_bf16(kf[2],qr[1],C0,0,0,0),   P0[10],P0[11],P0[12],P0[13], pw1[0]=PKW(P0,8), pw1[1]=PKW(P0,10), pw1); \
    VRD(5); SBAR(); GAPA(C1=__builtin_amdgcn_mfma_f32_32x32x16_bf16(kf[3],qr[1],C1,0,0,0),   P0[14],P0[15],P1[0],P1[1],   pw1[2]=PKW(P0,12),pw1[3]=PKW(P0,14), pw1); \
    VRD(2); SBAR(); GAPA(C0=__builtin_amdgcn_mfma_f32_32x32x16_bf16(kf[4],qr[2],C0,0,0,0),   P1[2],P1[3],P1[4],P1[5],     pw2[0]=PKW(P1,0), pw2[1]=PKW(P1,2), pw2); \
    VRD(6); SBAR(); GAPA(C1=__builtin_amdgcn_mfma_f32_32x32x16_bf16(kf[5],qr[2],C1,0,0,0),   P1[6],P1[7],P1[8],P1[9],     pw2[2]=PKW(P1,4), pw2[3]=PKW(P1,6), pw2); \
    VRD(3); SBAR(); GAPA(C0=__builtin_amdgcn_mfma_f32_32x32x16_bf16(kf[6],qr[3],C0,0,0,0),   P1[10],P1[11],P1[12],P1[13], pw3[0]=PKW(P1,8), pw3[1]=PKW(P1,10), pw3); \
    VRD(7); SBAR(); GAPA(C1=__builtin_amdgcn_mfma_f32_32x32x16_bf16(kf[7],qr[3],C1,0,0,0),   P1[14],P1[15],0.f,0.f,       pw3[2]=PKW(P1,12),pw3[3]=PKW(P1,14), pw3); \
    l_reg+=sacc; \
    if(GK){DMA_K((t)+3,sl_cur);} if(GV){DMA_V((t)+1,sl_next);} \
    CMASK(C0,C1,t); \
    { float a=MX3(C0[0],C0[1],C1[0]),b=MX3(C0[2],C0[3],C1[1]); a=MX3(a,C1[2],C1[3]); \
      _Pragma("unroll") for(int r=4;r<16;r+=4){a=MX3(a,C0[r],C0[r+1]);b=MX3(b,C0[r+2],C0[r+3]);a=MX3(a,C1[r],C1[r+1]);b=MX3(b,C1[r+2],C1[r+3]);} \
      float rm=__builtin_fmaxf(a,b); { auto rr=__builtin_amdgcn_permlane32_swap(__float_as_uint(rm),__float_as_uint(rm),false,false); rm=__builtin_fmaxf(__uint_as_float(rr[0]),__uint_as_float(rr[1])); } \
      resc=false; \
      if(__builtin_expect(__any(rm>(float)THRL),0)){ const float dl=__builtin_fmaxf(rm,0.f); mhat+=dl; nm-=dl; \
        _Pragma("unroll") for(int r=0;r<16;++r){C0[r]-=dl;C1[r]-=dl;} \
        const float f=__builtin_amdgcn_exp2f(-dl); l_reg*=f; if(hi==0)wsf[r32]=f; resc=true; } } \
    SBAR(); \
    GAPB(o[0]=__builtin_amdgcn_mfma_f32_32x32x16_bf16(PAF(0),VFR(0),o[0],0,0,0), C0,0); \
    GAPB(o[1]=__builtin_amdgcn_mfma_f32_32x32x16_bf16(PAF(0),VFR(4),o[1],0,0,0), C0,4); \
    KRD(GL,0); GAPB(o[0]=__builtin_amdgcn_mfma_f32_32x32x16_bf16(PAF(1),VFR(1),o[0],0,0,0), C0,8); \
    KRD(GL,1); GAPB(o[1]=__builtin_amdgcn_mfma_f32_32x32x16_bf16(PAF(1),VFR(5),o[1],0,0,0), C0,12); \
    KRD(GL,2); GAPB(o[0]=__builtin_amdgcn_mfma_f32_32x32x16_bf16(PAF(2),VFR(2),o[0],0,0,0), C1,0); \
    KRD(GL,3); GAPB(o[1]=__builtin_amdgcn_mfma_f32_32x32x16_bf16(PAF(2),VFR(6),o[1],0,0,0), C1,4); \
    GAPB(o[0]=__builtin_amdgcn_mfma_f32_32x32x16_bf16(PAF(3),VFR(3),o[0],0,0,0), C1,8); \
    GAPB(o[1]=__builtin_amdgcn_mfma_f32_32x32x16_bf16(PAF(3),VFR(7),o[1],0,0,0), C1,12); \
    }while(0)
  int t=1;
  #undef CMASK
  #define CMASK(P0,P1,t) do{}while(0)
  for(;t+5<NT;t+=2){
    STEP(pB0,pB1,pA0,pA1,t,true,true,true);     WAIT_BAR(2); RESC(); ROT();
    STEP(pA0,pA1,pB0,pB1,t+1,true,true,true);   WAIT_BAR(2); RESC(); ROT();
  }
  #undef CMASK
  #define CMASK(P0,P1,t) do{int jb_=(t)-(NT-4); if(jb_>=0)cmask(P0,P1,jb_,qrel,hi);}while(0)
  #define ENDW(tt) do{ if((tt)+3<NT){WAIT_BAR(2);} else if((tt)+2<NT){WAIT_BAR(1);} else {WAIT_BAR(0);} }while(0)
  for(;t+1<NT;t+=2){
    STEP(pB0,pB1,pA0,pA1,t,(t+3<NT),(t+1<NT),(t+1<NT));       ENDW(t);   RESC(); ROT();
    STEP(pA0,pA1,pB0,pB1,t+1,(t+4<NT),(t+2<NT),(t+2<NT));     ENDW(t+1); RESC(); ROT();
  }
  STEP(pB0,pB1,pA0,pA1,NT-1,false,false,false); RESC();
  { float sacc=pB0[0]+pB0[1]; _Pragma("unroll") for(int r=2;r<16;++r)sacc+=pB0[r]; _Pragma("unroll") for(int r=0;r<16;++r)sacc+=pB1[r]; l_reg+=sacc;
    pw0=(u32x4){PKW(pB0,0),PKW(pB0,2),PKW(pB0,4),PKW(pB0,6)};pw1=(u32x4){PKW(pB0,8),PKW(pB0,10),PKW(pB0,12),PKW(pB0,14)};pw2=(u32x4){PKW(pB1,0),PKW(pB1,2),PKW(pB1,4),PKW(pB1,6)};pw3=(u32x4){PKW(pB1,8),PKW(pB1,10),PKW(pB1,12),PKW(pB1,14)};
    SBAR(); pv(o,vb0+sl_cur,PAF(0),PAF(1),PAF(2),PAF(3)); }
  #undef PKW
  #undef PAF
  #undef VFR
  #undef PIN
  #undef MX3
  #undef GAPA
  #undef GAPB
  #undef EX
  #undef VRD
  #undef KRD
  #undef STEP
  #undef ENDW
  {auto rr=__builtin_amdgcn_permlane32_swap(__float_as_uint(l_reg),__float_as_uint(l_reg),false,false);l_reg=__uint_as_float(rr[0])+__uint_as_float(rr[1]);}
  if(hi==0)wsf[32+r32]=l_reg;asm volatile("s_waitcnt lgkmcnt(0)":::"memory");
  float rli[16];
  #pragma unroll
  for(int r=0;r<16;++r)rli[r]=__builtin_amdgcn_rcpf(wsf[32+crow(r,hi)]);
  bf16*Ow=O+(rowbase+q0+wid*QBLK)*DM+h*D;
  { bf16*stg=(bf16*)(shm+LDS_OST)+wid*2048;
    #pragma unroll
    for(int r=0;r<16;++r){const int orow=crow(r,hi);
      #pragma unroll
      for(int d0=0;d0<2;++d0)stg[orow*64+d0*32+r32]=__float2bfloat16(o[d0][r]*rli[r]);}
    asm volatile("s_waitcnt lgkmcnt(0)":::"memory");
    #pragma unroll
    for(int i=0;i<4;++i){const int row=i*8+(lane>>3),ch=lane&7; const u32x4 v=*(const u32x4*)(stg+row*64+ch*8); ATTN_STORE16(Ow+(long)row*DM+ch*8,v);} }
  asm volatile("s_waitcnt lgkmcnt(0)\n\ts_barrier":::"memory");
  #undef DMA_K
  #undef DMA_V
  #undef CMASK
  #undef START
  #undef RESC
  #undef ROT
}
constexpr int ATTN_LDS_BYTES=LDS_BYTES;
struct AttnTensors { const bf16* Q; const bf16* K; const bf16* V; bf16* O; };
struct AttnUnit { int bh; int qb; };
#undef BIASINIT
#undef SBAR
#undef WAIT_BAR
}
namespace cg = cooperative_groups;
constexpr int NWAVES = 8;
constexpr int BATCH = 4, SEQ = 4096, D = 1024, M = BATCH * SEQ, FF = 4096, DEPTH = 4, NIN = 3072, WIN_LD = 3088;
constexpr int N_PHASES = 26;
#ifndef PROBE_DUP
#define PROBE_DUP -1
#endif
#ifndef PROBE_AMP
#define PROBE_AMP 0u
#endif
#define AMP(p) (((PROBE_AMP) >> (p)) & 1u)
#ifndef MK_ONE_LAUNCH
#define MK_ONE_LAUNCH 1
#endif
constexpr size_t MiB = 1u << 20;
constexpr size_t WS_SSQ = 0;
constexpr size_t WS_SMALL = 1 * MiB;
constexpr size_t WS_BAR = 3 * MiB, BAR_ZERO_BYTES = 16384;
constexpr size_t WS_EB = 2 * MiB;
constexpr size_t WS_W = 4 * MiB, W_STRIDE = 25 * MiB;
constexpr size_t W_IN = 0, W_SM = 6 * MiB, W_O = 7 * MiB, W_UP = 9 * MiB, W_DN = 17 * MiB;
constexpr size_t WS_HB = 54 * MiB;
constexpr size_t WS_Q = 86 * MiB, WS_K = 118 * MiB, WS_V = 150 * MiB, WS_LS = 182 * MiB;
constexpr size_t WS_U = 86 * MiB;
constexpr size_t WS_CKLG = 246 * MiB;
constexpr size_t WS_END = 247 * MiB;
constexpr int NORM_WORD0 = 3584;
constexpr int LDS_BYTES = 147456;
constexpr int CKL_OFF = 86016;
static_assert(attn_body::ATTN_LDS_BYTES <= CKL_OFF && CKL_OFF + 16384 <= 131072, "LDS map");

#define LAS __attribute__((address_space(3)))
typedef unsigned short bf16;
typedef unsigned v4u __attribute__((ext_vector_type(4)));
typedef unsigned v2u __attribute__((ext_vector_type(2)));
typedef float f32x4 __attribute__((ext_vector_type(4)));
typedef short bf16x8 __attribute__((ext_vector_type(8)));
#define LDS_WAIT() asm volatile("s_waitcnt lgkmcnt(0)" ::: "memory")
__device__ __forceinline__ unsigned pk2(float lo, float hi) { return pg8::cvt_pk_bf16(lo, hi); }
__device__ __forceinline__ float bf2f(unsigned short v) { return __uint_as_float((unsigned)v << 16); }
__device__ __forceinline__ float bflo(unsigned w) { return __uint_as_float(w << 16); }
__device__ __forceinline__ float bfhi(unsigned w) { return __uint_as_float(w & 0xffff0000u); }
__device__ __forceinline__ float log_sigmoid(float x) { return __builtin_fminf(x, 0.f) - __logf(1.0f + __expf(-__builtin_fabsf(x))); }
__device__ __forceinline__ float wave_sum(float v) {
#pragma unroll
    for (int o = 1; o < 64; o <<= 1) v += __shfl_xor(v, o);
    return v;
}

#define XB_TMO      128
#define XB_XCNT(j)  (256  + 64 * (j))
#define XB_XSUB(j)  (1280 + 64 * (j))
#define XB_XGEN(j)  (2304 + 64 * (j))
#define XB_TOP      3328
#define XB_TOPGEN   3392
#define XCD_BAR_WORDS 3456
#define XB_SPIN_CAP (1u << 18)

__device__ __forceinline__ unsigned xb_ld(unsigned* p)              { return __hip_atomic_load(p, __ATOMIC_RELAXED, __HIP_MEMORY_SCOPE_AGENT); }
__device__ __forceinline__ unsigned xb_add(unsigned* p, unsigned v) { return __hip_atomic_fetch_add(p, v, __ATOMIC_RELAXED, __HIP_MEMORY_SCOPE_AGENT); }
__device__ __forceinline__ unsigned xb_xcc_id() { return (unsigned)__builtin_amdgcn_s_getreg((3 << 11) | 20) & 0xFu; }
#define XB_SPIN(cond, bar) do { unsigned _sp = 0; while (cond) { __builtin_amdgcn_s_sleep(1); \
    if ((++_sp & 255u) == 0u) { if (xb_ld(&(bar)[XB_TMO])) break; if (_sp > XB_SPIN_CAP) { atomicAdd(&(bar)[XB_TMO], 1u); break; } } } } while (0)

struct XcdBarrier {
    unsigned* bar; unsigned x;
    volatile LAS unsigned* st;
};

__device__ __forceinline__ XcdBarrier xcd_barrier_post(unsigned* bar, volatile LAS unsigned* st) {
    XcdBarrier b; b.bar = bar; b.x = xb_xcc_id(); b.st = st;
    if (threadIdx.x == 0) (void)xb_add(&bar[XB_XCNT(b.x)], 1u);
    return b;
}
__device__ __forceinline__ void xcd_barrier_complete(unsigned* bar, unsigned x, unsigned& nloc, unsigned& nx) {
    const unsigned G = gridDim.x * gridDim.y * gridDim.z;
    unsigned sum, cnt, mine, sp = 0u;
    for (;;) {
        sum = 0u; cnt = 0u; mine = 0u;
#pragma unroll
        for (unsigned j = 0; j < 16; ++j) { const unsigned c = xb_ld(&bar[XB_XCNT(j)]); sum += c; cnt += (c > 0u) ? 1u : 0u; mine = (j == x) ? c : mine; }
        if (sum == G) break;
        __builtin_amdgcn_s_sleep(1);
        if ((++sp & 255u) == 0u) { if (xb_ld(&bar[XB_TMO])) break; if (sp > XB_SPIN_CAP) { atomicAdd(&bar[XB_TMO], 1u); break; } }
    }
    nloc = mine > 0u ? mine : 1u; nx = cnt > 0u ? cnt : 1u;
}

__device__ __forceinline__ void xcd_barrier(const XcdBarrier& b) {
    asm volatile("s_waitcnt vmcnt(0)" ::: "memory");
    __syncthreads();
    if (threadIdx.x == 0) {
        unsigned* bar = b.bar;
        __builtin_amdgcn_s_waitcnt(0);
        unsigned nloc = b.st[0], nx = b.st[1];
        if (nloc == 0u) { xcd_barrier_complete(bar, b.x, nloc, nx); b.st[0] = nloc; b.st[1] = nx; }
        const unsigned old = xb_add(&bar[XB_XSUB(b.x)], 1u);
        const unsigned gen = old / nloc;
        if (old + 1u == (gen + 1u) * nloc) {
            __builtin_amdgcn_fence(__ATOMIC_RELEASE, "agent");
            asm volatile("s_waitcnt vmcnt(0)" ::: "memory");
            const unsigned og = xb_add(&bar[XB_TOP], 1u);
            const unsigned tg = og / nx;
            if (og + 1u == (tg + 1u) * nx) xb_add(&bar[XB_TOPGEN], 1u);
            else XB_SPIN(xb_ld(&bar[XB_TOPGEN]) == tg, bar);
            __builtin_amdgcn_fence(__ATOMIC_ACQUIRE, "agent");
            xb_add(&bar[XB_XGEN(b.x)], 1u);
            asm volatile("s_waitcnt vmcnt(0)" ::: "memory");
        } else {
            XB_SPIN(xb_ld(&bar[XB_XGEN(b.x)]) == gen, bar);
            __builtin_amdgcn_fence(__ATOMIC_ACQUIRE, "agent");
            asm volatile("s_waitcnt vmcnt(0)" ::: "memory");
        }
    }
    __syncthreads();
}

struct Args { const float* in[14]; float* out; unsigned char* ws; int ph_lo, ph_hi; };

constexpr int TR_LD = 65, TR_BYTES = 64 * TR_LD * 4;
__device__ __forceinline__ void transpose_item(const float* W, int ldw, int src_col0, const float* gain, bf16* WT, int K, int dst_row0, int nblk, LAS float* scr, int item, int lane, bool blk = false) {
    const int kb = item / nblk, nb = item % nblk, k0 = 64 * kb, n0 = 64 * nb;
#pragma unroll 8
    for (int i = 0; i < 16; ++i) { const int kk = 4 * i + (lane >> 4), c4 = lane & 15; f32x4 w = *(const f32x4*)(W + (size_t)(k0 + kk) * ldw + src_col0 + n0 + 4 * c4); if (gain) w = w * gain[k0 + kk];
        LAS float* d = scr + kk * TR_LD + 4 * c4; d[0] = w[0]; d[1] = w[1]; d[2] = w[2]; d[3] = w[3]; }
    LDS_WAIT(); asm volatile("" ::: "memory");
    const int c = lane & 7;
#pragma unroll
    for (int j = 0; j < 8; ++j) { const int n = (lane >> 3) + 8 * j; const LAS float* s = scr + (8 * c) * TR_LD + n;
        v4u o; o.x = pk2(s[0 * TR_LD], s[1 * TR_LD]); o.y = pk2(s[2 * TR_LD], s[3 * TR_LD]); o.z = pk2(s[4 * TR_LD], s[5 * TR_LD]); o.w = pk2(s[6 * TR_LD], s[7 * TR_LD]);
        const int ng = dst_row0 + n0 + n;
        *(v4u*)(WT + (blk ? ((size_t)((ng >> 8) * (K >> 6) + (k0 >> 6)) * 256 + (ng & 255)) * 64 + 8 * c : (size_t)ng * K + k0 + 8 * c)) = o; }
    LDS_WAIT(); asm volatile("" ::: "memory");
}

__device__ __forceinline__ void convert_layer_weights(const Args& a, int L, LAS unsigned char* lds, int gw, int NGW, int wave, int lane, int rot = 0) {
    LAS float* scr = (LAS float*)(lds + wave * TR_BYTES);
    unsigned char* wb = a.ws + WS_W + (size_t)(L & 1) * W_STRIDE;
    const int j = L >> 1; const bool fox = (L & 1) == 0;
    const float* Win = (fox ? a.in[1] : a.in[4]) + (size_t)j * D * WIN_LD;
    const float* Wo = (fox ? a.in[3] : a.in[8]) + (size_t)j * D * D;
    const float* Wup = a.in[9] + (size_t)L * D * FF; const float* Wdn = a.in[10] + (size_t)L * FF * D;
    const float* gmix = a.in[11] + L * D; const float* gmlp = a.in[12] + L * D;
    const int colB = fox ? 2048 : 2064, colS = fox ? 3072 : 2048;
    constexpr int I_A = 16 * 32, I_B = 16 * 16, I_O = 16 * 16, I_U = 16 * 64, I_D = 64 * 16, NITEMS = I_A + I_B + I_O + I_U + I_D;
    for (int it = (gw + rot) % NGW; it < NITEMS; it += NGW) {
        int r = it;
        if (r < I_A) { transpose_item(Win, WIN_LD, 0, gmix, (bf16*)(wb + W_IN), D, 0, 32, scr, r, lane); continue; } r -= I_A;
        if (r < I_B) { transpose_item(Win, WIN_LD, colB, gmix, (bf16*)(wb + W_IN), D, 2048, 16, scr, r, lane); continue; } r -= I_B;
        if (r < I_O) { transpose_item(Wo, D, 0, nullptr, (bf16*)(wb + W_O), D, 0, 16, scr, r, lane); continue; } r -= I_O;
        if (r < I_U) { transpose_item(Wup, FF, 0, gmlp, (bf16*)(wb + W_UP), D, 0, 64, scr, r, lane); continue; } r -= I_U;
        transpose_item(Wdn, D, 0, nullptr, (bf16*)(wb + W_DN), FF, 0, 16, scr, r, lane, true);
    }
    bf16* wsm = (bf16*)(wb + W_SM);
    for (int e = gw * 64 + lane; e < 16 * D; e += NGW * 64) { const int k = e >> 4, n = e & 15; wsm[n * D + k] = (bf16)(pk2(Win[(size_t)k * WIN_LD + colS + n] * gmix[k], 0.f) & 0xffffu); }
}

namespace gla {
constexpr int H = 4, DK = 128, DV = 256, C = 64, NCH = SEQ / C;
constexpr int VT_LD = 72, KT_LD = 72, QT_LD = 136;
__device__ __forceinline__ f32x4 mfma16(bf16x8 a, bf16x8 b, f32x4 c) { return __builtin_amdgcn_mfma_f32_16x16x32_bf16(a, b, c, 0, 0, 0); }
__device__ __forceinline__ void stage_vT(const bf16* vsrc, LAS bf16* VT, int tid) {
#pragma unroll
    for (int c = 0; c < 2; ++c) { const int item = tid + 512 * c, rest = item >> 6, tp = (rest & 1) * 16 + (item & 15), d8 = (rest >> 1) * 4 + ((item >> 4) & 3);
        const v4u w0 = *(const v4u*)(vsrc + (size_t)(2 * tp) * 1024 + d8 * 8), w1 = *(const v4u*)(vsrc + (size_t)(2 * tp + 1) * 1024 + d8 * 8);
        LAS unsigned* p = (LAS unsigned*)(VT + (d8 * 8) * VT_LD + 2 * tp);
        p[0 * (VT_LD / 2)] = (w0.x & 0xffffu) | (w1.x << 16); p[1 * (VT_LD / 2)] = (w0.x >> 16) | (w1.x & 0xffff0000u);
        p[2 * (VT_LD / 2)] = (w0.y & 0xffffu) | (w1.y << 16); p[3 * (VT_LD / 2)] = (w0.y >> 16) | (w1.y & 0xffff0000u);
        p[4 * (VT_LD / 2)] = (w0.z & 0xffffu) | (w1.z << 16); p[5 * (VT_LD / 2)] = (w0.z >> 16) | (w1.z & 0xffff0000u);
        p[6 * (VT_LD / 2)] = (w0.w & 0xffffu) | (w1.w << 16); p[7 * (VT_LD / 2)] = (w0.w >> 16) | (w1.w & 0xffff0000u); }
}
__device__ __forceinline__ void g1_unit(int u, const bf16* QK, bf16* QKout, const bf16* V, const float* zlr, const float* wg, const float* bg, bf16* LS, float* EB, LAS unsigned char* lds, int tid, int wave, int lane) {
    const int b = u >> 8, j = (u >> 2) & 63, h = u & 3, lsid = (b * 4 + h) * 64 + j; const size_t tok0 = (size_t)b * SEQ + 64 * j;
    LAS bf16* KT = (LAS bf16*)lds; LAS bf16* VT = (LAS bf16*)(lds + 18432); LAS float* ZL = (LAS float*)(lds + 55296); LAS float* TOT = (LAS float*)(lds + 59392); LAS float* EBL = (LAS float*)(lds + 67584);
    const int d4 = tid & 31, tg = tid >> 5;
    const bf16* qp = QK + (tok0 + 4 * tg) * 1024 + h * 128 + 4 * d4; bf16* qo = QKout + (tok0 + 4 * tg) * 1024 + h * 128 + 4 * d4;
    v2u qin[4], kin[4];
#pragma unroll
    for (int i = 0; i < 4; ++i) { qin[i] = *(const v2u*)(qp + (size_t)i * 1024); kin[i] = *(const v2u*)(qp + (size_t)i * 1024 + 512); }
    f32x4 w[16];
#pragma unroll
    for (int r = 0; r < 16; ++r) w[r] = *(const f32x4*)(wg + r * 512 + h * 128 + 4 * d4);
    const f32x4 bgd = *(const f32x4*)(bg + h * 128 + 4 * d4);
    if (tid < 256) ((LAS f32x4*)ZL)[tid] = ((const f32x4*)(zlr + tok0 * 16))[tid];
    stage_vT(V + tok0 * 1024 + h * 256, VT, tid);
    __syncthreads();
    f32x4 bc[4]; f32x4 run = (f32x4){0.f, 0.f, 0.f, 0.f};
#pragma unroll
    for (int i = 0; i < 4; ++i) { const int t = 4 * tg + i; f32x4 z = bgd;
#pragma unroll
        for (int r4 = 0; r4 < 4; ++r4) { const f32x4 zz = ((const LAS f32x4*)ZL)[t * 4 + r4]; z += zz[0] * w[4 * r4] + zz[1] * w[4 * r4 + 1] + zz[2] * w[4 * r4 + 2] + zz[3] * w[4 * r4 + 3]; }
#pragma unroll
        for (int e = 0; e < 4; ++e) run[e] += log_sigmoid(z[e]) * (1.0f / 16.0f);
        bc[i] = run; }
    *(LAS f32x4*)(TOT + tg * 128 + 4 * d4) = run;
    __syncthreads();
    f32x4 pre = (f32x4){0.f, 0.f, 0.f, 0.f}, blast = (f32x4){0.f, 0.f, 0.f, 0.f};
#pragma unroll
    for (int q = 0; q < 16; ++q) { const f32x4 tv = *(const LAS f32x4*)(TOT + q * 128 + 4 * d4); if (q < tg) pre += tv; blast += tv; }
    if (tg == 0) { f32x4 eb; eb[0] = __expf(blast[0]); eb[1] = __expf(blast[1]); eb[2] = __expf(blast[2]); eb[3] = __expf(blast[3]);
        *(f32x4*)(EB + (size_t)lsid * 128 + 4 * d4) = eb; *(LAS f32x4*)(EBL + 4 * d4) = eb; }
    float kt[4][4];
#pragma unroll
    for (int i = 0; i < 4; ++i) { const f32x4 bb = bc[i] + pre; float qv[4] = {bflo(qin[i].x), bfhi(qin[i].x), bflo(qin[i].y), bfhi(qin[i].y)}; float kv[4] = {bflo(kin[i].x), bfhi(kin[i].x), bflo(kin[i].y), bfhi(kin[i].y)}; float qt[4];
#pragma unroll
        for (int e = 0; e < 4; ++e) { const float eb = __expf(bb[e]); qt[e] = qv[e] * eb * 0.08838834764831845f; kt[i][e] = kv[e] * __builtin_amdgcn_rcpf(eb); }
        v2u oq; oq.x = pk2(qt[0], qt[1]); oq.y = pk2(qt[2], qt[3]); *(v2u*)(qo + (size_t)i * 1024) = oq;
        v2u ok; ok.x = pk2(kt[i][0], kt[i][1]); ok.y = pk2(kt[i][2], kt[i][3]); *(v2u*)(qo + (size_t)i * 1024 + 512) = ok; }
#pragma unroll
    for (int e = 0; e < 4; ++e) { v2u o; o.x = pk2(kt[0][e], kt[1][e]); o.y = pk2(kt[2][e], kt[3][e]); *(LAS v2u*)(KT + (4 * d4 + e) * KT_LD + 4 * tg) = o; }
    __syncthreads();
    const int fr = lane & 15, fq = lane >> 4;
    f32x4 acc[2][8];
#pragma unroll
    for (int mt = 0; mt < 2; ++mt)
#pragma unroll
        for (int nt = 0; nt < 8; ++nt) acc[mt][nt] = (f32x4){0.f, 0.f, 0.f, 0.f};
#pragma unroll
    for (int ks = 0; ks < 2; ++ks) { bf16x8 vf[2];
#pragma unroll
        for (int mt = 0; mt < 2; ++mt) vf[mt] = *(const LAS bf16x8*)(VT + (32 * wave + 16 * mt + fr) * VT_LD + ks * 32 + fq * 8);
#pragma unroll
        for (int nt = 0; nt < 8; ++nt) { const bf16x8 kf = *(const LAS bf16x8*)(KT + (16 * nt + fr) * KT_LD + ks * 32 + fq * 8);
#pragma unroll
            for (int mt = 0; mt < 2; ++mt) acc[mt][nt] = mfma16(kf, vf[mt], acc[mt][nt]); } }
    bf16* lsp = LS + (size_t)lsid * 32768;
#pragma unroll
    for (int nt = 0; nt < 8; ++nt) { const f32x4 e4 = *(const LAS f32x4*)(EBL + 16 * nt + 4 * fq);
#pragma unroll
        for (int mt = 0; mt < 2; ++mt) { const f32x4 v = acc[mt][nt] * e4; v2u o; o.x = pk2(v[0], v[1]); o.y = pk2(v[2], v[3]);
            *(v2u*)(lsp + (size_t)(32 * wave + 16 * mt + fr) * 128 + 16 * nt + 4 * fq) = o; } }
    __syncthreads();
}
template <bool DUMMY> __device__ __forceinline__ void g2_scan(const bf16* LS, bf16* OUT, const float* EB, int gtid, int nthreads) {
    for (int e = gtid; e < 16 * 8192; e += nthreads) { const int bh = e >> 13, off = (e & 8191) * 4;
        const bf16* base = LS + (size_t)bh * 64 * 32768 + off; bf16* obase = OUT + (DUMMY ? ((size_t)(bh & 7) * 64 * 32768 + off) : ((size_t)bh * 64 * 32768 + off)); const float* ebp = EB + (size_t)bh * 64 * 128 + (off & 127);
        f32x4 S = (f32x4){0.f, 0.f, 0.f, 0.f};
#pragma unroll 21
        for (int j = 0; j < 63; ++j) { const v2u l = *(const v2u*)(base + (size_t)j * 32768); const f32x4 a = *(const f32x4*)(ebp + j * 128);
            S[0] = a[0] * S[0] + bflo(l.x); S[1] = a[1] * S[1] + bfhi(l.x); S[2] = a[2] * S[2] + bflo(l.y); S[3] = a[3] * S[3] + bfhi(l.y);
            v2u o; o.x = pk2(S[0], S[1]); o.y = pk2(S[2], S[3]); *(v2u*)(obase + (size_t)j * 32768) = o; } }
}
__device__ __forceinline__ void g3_unit(int u, const bf16* QK, const bf16* V, const bf16* R, bf16* Rout, const bf16* LS, const float* gnorm, LAS unsigned char* lds, int tid, int wave, int lane) {
    const int b = u >> 8, j = (u >> 2) & 63, h = u & 3, lsid = (b * 4 + h) * 64 + j; const size_t tok0 = (size_t)b * SEQ + 64 * j;
    LAS bf16* QT = (LAS bf16*)lds; LAS bf16* KT = (LAS bf16*)(lds + 17408); LAS bf16* VT = (LAS bf16*)(lds + 34816); LAS bf16* AT = (LAS bf16*)(lds + 71680); LAS float* RS = (LAS float*)(lds + 80896);
#pragma unroll
    for (int c = 0; c < 2; ++c) { const int idx = tid + 512 * c, t = idx >> 4, c8 = idx & 15; const bf16* src = QK + (tok0 + t) * 1024 + h * 128 + c8 * 8;
        *(LAS v4u*)(QT + t * QT_LD + c8 * 8) = *(const v4u*)src; *(LAS v4u*)(KT + t * QT_LD + c8 * 8) = *(const v4u*)(src + 512); }
    const int fr = lane & 15, fq = lane >> 4, tm = wave >> 1, hh = wave & 1;
    bf16x8 sf[4][8];
    if (j > 0) { const bf16* sp = LS + (size_t)(lsid - 1) * 32768 + (size_t)(128 * hh + fr) * 128 + fq * 8;
#pragma unroll
        for (int ks = 0; ks < 4; ++ks)
#pragma unroll
            for (int nt = 0; nt < 8; ++nt) sf[ks][nt] = *(const bf16x8*)(sp + (size_t)nt * 16 * 128 + ks * 32); }
    const size_t roff = (tok0 + 16 * tm + fr) * 1024 + h * 256 + 128 * hh + 4 * fq; const bf16* rp = R + roff; bf16* ro = Rout + roff;
    v2u rin[8];
#pragma unroll
    for (int nt = 0; nt < 8; ++nt) rin[nt] = *(const v2u*)(rp + 16 * nt);
    stage_vT(V + tok0 * 1024 + h * 256, VT, tid);
    __syncthreads();
#pragma unroll
    for (int e = 0; e < 2; ++e) { const int sn = 2 * hh + e; f32x4 a = (f32x4){0.f, 0.f, 0.f, 0.f};
        if (sn <= tm) {
#pragma unroll
            for (int ks = 0; ks < 4; ++ks) { const bf16x8 qf = *(const LAS bf16x8*)(QT + (16 * tm + fr) * QT_LD + ks * 32 + fq * 8); const bf16x8 kf = *(const LAS bf16x8*)(KT + (16 * sn + fr) * QT_LD + ks * 32 + fq * 8);
                a = mfma16(kf, qf, a); }
#pragma unroll
            for (int i = 0; i < 4; ++i) if (16 * sn + 4 * fq + i > 16 * tm + fr) a[i] = 0.f; }
        v2u o; o.x = pk2(a[0], a[1]); o.y = pk2(a[2], a[3]); *(LAS v2u*)(AT + (16 * tm + fr) * VT_LD + 16 * sn + 4 * fq) = o; }
    __syncthreads();
    f32x4 acc[8];
#pragma unroll
    for (int nt = 0; nt < 8; ++nt) acc[nt] = (f32x4){0.f, 0.f, 0.f, 0.f};
#pragma unroll
    for (int ks = 0; ks < 2; ++ks) { const bf16x8 af = *(const LAS bf16x8*)(AT + (16 * tm + fr) * VT_LD + ks * 32 + fq * 8);
#pragma unroll
        for (int nt = 0; nt < 8; ++nt) { const bf16x8 vf = *(const LAS bf16x8*)(VT + (128 * hh + 16 * nt + fr) * VT_LD + ks * 32 + fq * 8); acc[nt] = mfma16(vf, af, acc[nt]); } }
    if (j > 0) {
#pragma unroll
        for (int ks = 0; ks < 4; ++ks) { const bf16x8 qf = *(const LAS bf16x8*)(QT + (16 * tm + fr) * QT_LD + ks * 32 + fq * 8);
#pragma unroll
            for (int nt = 0; nt < 8; ++nt) acc[nt] = mfma16(sf[ks][nt], qf, acc[nt]); } }
    float ss = 0.f;
#pragma unroll
    for (int nt = 0; nt < 8; ++nt) ss += (acc[nt][0] * acc[nt][0] + acc[nt][1] * acc[nt][1]) + (acc[nt][2] * acc[nt][2] + acc[nt][3] * acc[nt][3]);
    ss += __shfl_xor(ss, 16); ss += __shfl_xor(ss, 32);
    if (fq == 0) RS[(16 * tm + fr) * 2 + hh] = ss;
    __syncthreads();
    const float rinv = __builtin_amdgcn_rsqf((RS[(16 * tm + fr) * 2] + RS[(16 * tm + fr) * 2 + 1]) * (1.0f / 256.0f) + 1e-6f);
#pragma unroll
    for (int nt = 0; nt < 8; ++nt) { const f32x4 gn = *(const f32x4*)(gnorm + 128 * hh + 16 * nt + 4 * fq); const v2u rw = rin[nt];
        const float r0 = bflo(rw.x), r1 = bfhi(rw.x), r2 = bflo(rw.y), r3 = bfhi(rw.y);
        const float o0 = acc[nt][0] * rinv * gn[0] * r0 * __builtin_amdgcn_rcpf(1.f + __expf(-r0)), o1 = acc[nt][1] * rinv * gn[1] * r1 * __builtin_amdgcn_rcpf(1.f + __expf(-r1));
        const float o2 = acc[nt][2] * rinv * gn[2] * r2 * __builtin_amdgcn_rcpf(1.f + __expf(-r2)), o3 = acc[nt][3] * rinv * gn[3] * r3 * __builtin_amdgcn_rcpf(1.f + __expf(-r3));
        v2u o; o.x = pk2(o0, o1); o.y = pk2(o2, o3); *(v2u*)(ro + 16 * nt) = o; }
    __syncthreads();
}
}

#define SEAM() do { if (ph + 1 < hi) { if (hi > 1000) grid.sync(); else xcd_barrier(bar); if (AMP(ph)) { const unsigned long long t1_ = __builtin_amdgcn_s_memrealtime(); while (__builtin_amdgcn_s_memrealtime() < t1_ + 3ull * (t1_ - t0_)) __builtin_amdgcn_s_sleep(8); xcd_barrier(bar); } } } while (0)
template <int L> __device__ __forceinline__ void run_layer(const Args& args, cg::grid_group& grid, const XcdBarrier& bar, LAS unsigned char* lds, unsigned char* lds_raw, int lo, int hi) {
    const int G = gridDim.x, bx = blockIdx.x, vcu = (G % 8 == 0) ? (bx % 8) * (G / 8) + bx / 8 : bx, NGW = G * NWAVES;
    unsigned char* ws = args.ws;
    float* ssqp = (float*)(ws + WS_SSQ); float* smallb = (float*)(ws + WS_SMALL); float* EB = (float*)(ws + WS_EB);
    bf16* HB = (bf16*)(ws + WS_HB); bf16* QB = (bf16*)(ws + WS_Q); bf16* KB = (bf16*)(ws + WS_K); bf16* VB = (bf16*)(ws + WS_V); bf16* LS = (bf16*)(ws + WS_LS); bf16* UB = (bf16*)(ws + WS_U);
    int ph = 1 + (L / 2) * 12 + (L % 2) * 5;
#define THREAD_VARS() const unsigned long long t0_ = AMP(ph) ? __builtin_amdgcn_s_memrealtime() : 0ull; (void)t0_; int tid = threadIdx.x; asm volatile("" : "+v"(tid)); const int lane = tid & 63, wave = __builtin_amdgcn_readfirstlane(tid >> 6), gw = vcu * NWAVES + wave; (void)lane; (void)gw

        const bool fox = (L & 1) == 0; const int jl = L >> 1;
        unsigned char* wb = ws + WS_W + (size_t)(L & 1) * W_STRIDE;
        if (ph >= lo && ph < hi) { THREAD_VARS();
            if (L == 1 || L == 2) { convert_layer_weights(args, L + 1, lds, gw, NGW, wave, lane); __syncthreads(); }
            const pg8::Gemm g = pg8::make_gemm(HB, (const bf16*)(wb + W_IN), M, NIN, D, false, false); pg8::StaticOrder S; S.init(M, NIN, G, bx);
            pg8::EpiScaleBf16<0> E{QB, D, ssqp, D, (size_t)(WS_K - WS_Q) / 2, fox ? attn_body::C2 : 1.0f, fox ? (unsigned*)(ws + WS_BAR) + NORM_WORD0 + jl * 128 : nullptr};
            for (int rep_ = 0; rep_ < (ph == PROBE_DUP ? 2 : 1); ++rep_)
            pg8::gemm_phase<pg8::EpiScaleBf16<0>, pg8::StaticOrder, PG8_ALIGN, PG8_SP2>(lds, g, S, E);
            { const bf16* wsm = (const bf16*)(wb + W_SM); const int fr = lane & 15, fq = lane >> 4, half = wave & 1;
              LAS bf16* WL = (LAS bf16*)lds; LAS f32x4* RED = (LAS f32x4*)(lds + 40960);
              for (int idx = tid; idx < 16 * 128; idx += NWAVES * 64) { const int n = idx >> 7, c8 = idx & 127; *(LAS v4u*)(WL + n * 1032 + c8 * 8) = *(const v4u*)(wsm + n * D + c8 * 8); }
              __syncthreads();
              for (int rep_ = 0; rep_ < (100 + ph == PROBE_DUP ? 2 : 1); ++rep_)
              for (int tb = 0; tb < M / 16; tb += NGW / 2) { const int task = tb + (gw >> 1); const bool live = task < M / 16; const int row = (live ? task : 0) * 16 + fr;
                  const bf16* ap = HB + (size_t)row * D + half * 512 + fq * 8; bf16x8 av[16];
#pragma unroll
                  for (int s = 0; s < 16; ++s) av[s] = *(const bf16x8*)(ap + s * 32);
                  f32x4 acc = (f32x4){0.f, 0.f, 0.f, 0.f};
#pragma unroll
                  for (int s = 0; s < 16; ++s) { const bf16x8 bv = *(const LAS bf16x8*)(WL + fr * 1032 + half * 512 + s * 32 + fq * 8); acc = __builtin_amdgcn_mfma_f32_16x16x32_bf16(bv, av[s], acc, 0, 0, 0); }
                  if (half) RED[(wave >> 1) * 64 + lane] = acc;
                  __syncthreads();
                  if (!half && live) { acc += RED[(wave >> 1) * 64 + lane]; const float rs = pg8::row_rstd(ssqp, row); *(f32x4*)(smallb + (size_t)row * 16 + 4 * fq) = acc * rs; }
                  __syncthreads(); } }
            SEAM();
        }
        ++ph;
        if (fox) {
            if (ph >= lo && ph < hi) { THREAD_VARS();
                LAS float* ckl = (LAS float*)(lds + CKL_OFF); LAS float* wtot = (LAS float*)(lds + CKL_OFF + 16384);
                LAS float* red = wtot + 16; LAS int* sch = (LAS int*)(wtot + 64); LAS int* nh = (LAS int*)(wtot + 96); LAS int* cost = (LAS int*)(wtot + 112); LAS float* smh = wtot + 128;
                LAS float* cq = wtot + 256; LAS float* ce = wtot + 512; LAS int* T0 = (LAS int*)(wtot + 1536);
                const float* bf_ = args.in[2] + jl * 16;
                float* CKLG = (float*)(ws + WS_CKLG); unsigned* NORMS = (unsigned*)(ws + WS_BAR) + NORM_WORD0 + jl * 128;
                for (int rep_ = 0; rep_ < (ph == PROBE_DUP ? 2 : 1); ++rep_) {
                for (int w = vcu; w < 256; w += G) { const int bh = w >> 2, part = w & 3, b = bh >> 4, h = bh & 15;
                    __syncthreads();
                    { const float bfh = bf_[h]; const float* fp = smallb + ((size_t)b * SEQ + 8 * tid) * 16 + h; float v[8]; float run = 0.f;
#pragma unroll
                        for (int i = 0; i < 8; ++i) { run += log_sigmoid(fp[i * 16] + bfh); v[i] = run; }
                        float tot = run;
#pragma unroll
                        for (int o = 1; o < 64; o <<= 1) { const float t = __shfl_up(tot, o); if (lane >= o) tot += t; }
                        if (lane == 63) wtot[wave] = tot;
                        __syncthreads();
                        float basev = tot - run;
                        for (int w2 = 0; w2 < wave; ++w2) basev += wtot[w2];
                        if ((tid >> 7) == part) {
#pragma unroll
                            for (int i = 0; i < 8; i += 4) *(f32x4*)(CKLG + (size_t)bh * SEQ + 8 * tid + i) = (f32x4){(basev + v[i]) * 1.4426950408889634f, (basev + v[i + 1]) * 1.4426950408889634f, (basev + v[i + 2]) * 1.4426950408889634f, (basev + v[i + 3]) * 1.4426950408889634f}; } }
                    }
                xcd_barrier(bar);
                for (int w = vcu; w < 256; w += G) { const int b = w >> 6, i64 = w & 63;
                    __syncthreads();
                    for (int e = tid; e < 16 * 80; e += NWAVES * 64) { const int hh = e / 80, r = e % 80; const float* src = CKLG + (size_t)(b * 16 + hh) * SEQ;
                        if (r < 16) cq[hh * 16 + r] = src[256 * r]; else ce[hh * 64 + (r - 16)] = src[64 * (r - 16) + 63]; }
                    if (tid < 16) { const unsigned kb = __hip_atomic_load(NORMS + 2 * (b * 16 + tid), __ATOMIC_RELAXED, __HIP_MEMORY_SCOPE_AGENT), qb2 = __hip_atomic_load(NORMS + 2 * (b * 16 + tid) + 1, __ATOMIC_RELAXED, __HIP_MEMORY_SCOPE_AGENT);
                        smh[tid] = __builtin_sqrtf(__uint_as_float(kb) * __uint_as_float(qb2)) * 1.01f + 0.5f; }
                    __syncthreads();
#pragma nounroll
                    for (int k = 0; k < 2; ++k) { const int hh = 2 * wave + k; const float sm = smh[hh]; int c = 0;
                        for (int qb = 0; qb < 16; ++qb) { const bool dead = (lane < 4 * qb) && (sm + cq[hh * 16 + qb] - ce[hh * 64 + lane] < -152.0f);
                            const int t0 = __builtin_popcountll(__ballot(dead)) & ~1; c += 4 * qb + 4 - t0 + 14;
                            if (lane == 0) T0[hh * 16 + qb] = t0; }
                        if (lane == 0) cost[hh] = c; }
                    __syncthreads();
                    if (tid == 0) { int total = 0; for (int hh = 0; hh < 16; ++hh) total += cost[hh];
                        const float ideal = (float)total * (1.f / 64.f); int sum = 0;
                        for (int hh = 0; hh < 16; ++hh) { int n = (int)((float)cost[hh] / ideal + 0.5f); n = min(max(n, 1), 16); nh[hh] = n; sum += n; }
                        while (sum > 64) { int best = 0; float bv = 1e30f; for (int hh = 0; hh < 16; ++hh) if (nh[hh] > 1) { const float v = (float)cost[hh] / (float)nh[hh]; if (v < bv) { bv = v; best = hh; } } nh[best] -= 1; --sum; }
                        while (sum < 64) { int best = 0; float bv = -1.f; for (int hh = 0; hh < 16; ++hh) if (nh[hh] < 16) { const float v = (float)cost[hh] / (float)nh[hh]; if (v > bv) { bv = v; best = hh; } } nh[best] += 1; ++sum; }
                        int acc = 0, myh = 15, slot = 0;
                        for (int hh = 0; hh < 16; ++hh) { if (i64 < acc + nh[hh]) { myh = hh; slot = i64 - acc; break; } acc += nh[hh]; }
                        const int nbins = nh[myh]; int mask = 0;
                        for (int k = 0; k < 16; ++k) sch[16 + k] = 0;
                        for (int qb = 15; qb >= 0; --qb) { const int cu = 4 * qb + 4 - T0[myh * 16 + qb] + 14; int best = 0, bl = sch[16];
                            for (int k = 1; k < nbins; ++k) { const int l = sch[16 + k]; if (l < bl) { bl = l; best = k; } }
                            sch[16 + best] = bl + cu; if (best == slot) mask |= 1 << qb; }
                        sch[0] = myh; sch[1] = mask; }
                    __syncthreads();
                    const int h = sch[0], mask = sch[1];
                    { const f32x4* src = (const f32x4*)(CKLG + (size_t)(b * 16 + h) * SEQ); ((LAS f32x4*)ckl)[tid] = src[tid]; ((LAS f32x4*)ckl)[tid + 512] = src[tid + 512]; }
                    __syncthreads();
#pragma nounroll
                    for (int qb = 15; qb >= 0; --qb) { if (!((mask >> qb) & 1)) continue; const int t0 = T0[h * 16 + qb];
                        attn_body::attn_unit<8>(b, h, qb, (const attn_body::bf16*)QB, (const attn_body::bf16*)KB, (const attn_body::bf16*)VB, (attn_body::bf16*)((ph == PROBE_DUP && rep_ == 0) ? HB : QB), (char*)lds_raw, (attn_body::lds_cfptr)ckl, t0); } } }
                SEAM();
            }
            ++ph;
        } else {
            if (ph >= lo && ph < hi) { THREAD_VARS();
                for (int rep_ = 0; rep_ < (ph == PROBE_DUP ? 2 : 1); ++rep_)
                for (int u = bx; u < 1024; u += G) gla::g1_unit(u, QB, (ph == PROBE_DUP && rep_ == 0) ? HB : QB, KB, smallb, args.in[5] + (size_t)jl * 16 * 512, args.in[6] + jl * 512, LS, EB, lds, tid, wave, lane);
                SEAM();
            }
            ++ph;
            if (ph >= lo && ph < hi) { THREAD_VARS(); if (ph == PROBE_DUP) gla::g2_scan<true>(LS, HB, EB, bx * 512 + tid, G * 512); gla::g2_scan<false>(LS, LS, EB, bx * 512 + tid, G * 512); SEAM(); }
            ++ph;
            if (ph >= lo && ph < hi) { THREAD_VARS();
                for (int rep_ = 0; rep_ < (ph == PROBE_DUP ? 2 : 1); ++rep_)
                for (int u = bx; u < 1024; u += G) gla::g3_unit(u, QB, KB, VB, (ph == PROBE_DUP && rep_ == 0) ? HB : VB, LS, args.in[7] + jl * 256, lds, tid, wave, lane);
                SEAM();
            }
            ++ph;
        }
        if (ph >= lo && ph < hi) { THREAD_VARS();
            const pg8::Gemm g = pg8::make_gemm(fox ? QB : VB, (const bf16*)(wb + W_O), M, D, D, false, false); pg8::StaticOrder S; S.init(M, D, G, bx);
            pg8::EpiRes E{HB, ssqp, D};
            pg8::gemm_phase<pg8::EpiRes, pg8::StaticOrder, false, PG8_SP2>(lds, g, S, E);
            SEAM();
        }
        ++ph;
        if (ph >= lo && ph < hi) { THREAD_VARS();
            const pg8::Gemm g = pg8::make_gemm(HB, (const bf16*)(wb + W_UP), M, FF, D, false, false); pg8::StaticOrder S; S.init(M, FF, G, bx);
            pg8::EpiScaleBf16<2, true> E{UB, FF, ssqp, 0, 0, 1.f, nullptr};
            for (int rep_ = 0; rep_ < (ph == PROBE_DUP ? 2 : 1); ++rep_)
            pg8::gemm_phase<pg8::EpiScaleBf16<2, true>, pg8::StaticOrder, PG8_ALIGN, PG8_SP2>(lds, g, S, E);
            SEAM();
        }
        ++ph;
        if (ph >= lo && ph < hi) { THREAD_VARS();
            const pg8::Gemm g = pg8::make_gemm(UB, (const bf16*)(wb + W_DN), M, D, FF, true, true); pg8::StaticOrder S; S.init(M, D, G, bx);
            pg8::EpiRes E{HB, ssqp, D};
            pg8::gemm_phase<pg8::EpiRes, pg8::StaticOrder, false, PG8_SP2>(lds, g, S, E);
            SEAM();
        }
        ++ph;
    }
#undef SEAM
#undef THREAD_VARS
__global__ void __launch_bounds__(NWAVES * 64, 2) fwd_megakernel(Args args) {
    extern __shared__ __attribute__((aligned(16))) unsigned char lds_raw[];
    cg::grid_group grid = cg::this_grid();
    LAS unsigned char* lds = (LAS unsigned char*)lds_raw;
    const int tid = threadIdx.x, lane = tid & 63, wave = __builtin_amdgcn_readfirstlane(tid >> 6);
    const int G = gridDim.x, bx = blockIdx.x, vcu = (G % 8 == 0) ? (bx % 8) * (G / 8) + bx / 8 : bx;
    const int gw = vcu * NWAVES + wave, NGW = G * NWAVES;
    unsigned char* ws = args.ws;
    float* ssqp = (float*)(ws + WS_SSQ); float* smallb = (float*)(ws + WS_SMALL); float* EB = (float*)(ws + WS_EB);
    bf16* HB = (bf16*)(ws + WS_HB); bf16* QB = (bf16*)(ws + WS_Q); bf16* KB = (bf16*)(ws + WS_K); bf16* VB = (bf16*)(ws + WS_V); bf16* LS = (bf16*)(ws + WS_LS); bf16* UB = (bf16*)(ws + WS_U);
    float* Hres = args.out;
    const int lo = args.ph_lo, hi = args.ph_hi;
    int ph = 0;
    volatile LAS unsigned* bst = (volatile LAS unsigned*)(lds + LDS_BYTES - 128);
    if (tid < 2) bst[tid] = 0u;
    __syncthreads();
    const XcdBarrier bar = xcd_barrier_post((unsigned*)(ws + WS_BAR), bst);
#define SEAM() do { if (ph + 1 < hi) { if (hi > 1000) grid.sync(); else xcd_barrier(bar); if (AMP(ph)) { const unsigned long long t1_ = __builtin_amdgcn_s_memrealtime(); while (__builtin_amdgcn_s_memrealtime() < t1_ + 3ull * (t1_ - t0_)) __builtin_amdgcn_s_sleep(8); xcd_barrier(bar); } } } while (0)

    if (ph >= lo && ph < hi) {
        const unsigned long long t0_ = AMP(0) ? __builtin_amdgcn_s_memrealtime() : 0ull; (void)t0_;
        for (int rep_ = 0; rep_ < (PROBE_DUP == 0 ? 2 : 1); ++rep_) {
        convert_layer_weights(args, 0, lds, gw, NGW, wave, lane);
        convert_layer_weights(args, 1, lds, gw, NGW, wave, lane, NGW / 2);
        const float* x = args.in[0];
        for (int m = gw; m < M; m += NGW) { const f32x4* xr = (const f32x4*)(x + (size_t)m * D) + lane; f32x4 v[4]; float s = 0.f;
#pragma unroll
            for (int jj = 0; jj < 4; ++jj) { v[jj] = xr[64 * jj]; s += (v[jj][0] * v[jj][0] + v[jj][1] * v[jj][1]) + (v[jj][2] * v[jj][2] + v[jj][3] * v[jj][3]); }
            s = wave_sum(s);
            v2u* o8 = (v2u*)(HB + (size_t)m * D) + lane;
#pragma unroll
            for (int jj = 0; jj < 4; ++jj) { v2u o; o.x = pk2(v[jj][0], v[jj][1]); o.y = pk2(v[jj][2], v[jj][3]); o8[64 * jj] = o; }
            if (lane < 16) ssqp[(size_t)m * 16 + lane] = (lane == 0) ? s : 0.f; } }
        SEAM();
    }
    ++ph;

    run_layer<0>(args, grid, bar, lds, lds_raw, lo, hi); run_layer<1>(args, grid, bar, lds, lds_raw, lo, hi); run_layer<2>(args, grid, bar, lds, lds_raw, lo, hi); run_layer<3>(args, grid, bar, lds, lds_raw, lo, hi);
    ph = N_PHASES - 1;
    if (ph >= lo && ph < hi) {
        const unsigned long long t0_ = AMP(25) ? __builtin_amdgcn_s_memrealtime() : 0ull;
        const float* gf = args.in[13];
        for (int m = gw; m < M; m += NGW) { f32x4* xr = (f32x4*)(Hres + (size_t)m * D) + lane; const v2u* hr = (const v2u*)(HB + (size_t)m * D) + lane; const float rs = pg8::row_rstd(ssqp, m);
#pragma unroll
            for (int jj = 0; jj < 4; ++jj) { const f32x4 gv = ((const f32x4*)gf)[64 * jj + lane]; const v2u hv = hr[64 * jj];
                xr[64 * jj] = (f32x4){bflo(hv.x), bfhi(hv.x), bflo(hv.y), bfhi(hv.y)} * rs * gv; } }
        if (AMP(25)) { asm volatile("s_waitcnt vmcnt(0)" ::: "memory"); const unsigned long long t1_ = __builtin_amdgcn_s_memrealtime(); while (__builtin_amdgcn_s_memrealtime() < t1_ + 3ull * (t1_ - t0_)) __builtin_amdgcn_s_sleep(8); }
    }
#undef SEAM
}

extern "C" void kernel_launch(void* const* d_in, const int* in_sizes, int n_in, void* d_out, int out_size, void* d_ws, size_t ws_size, hipStream_t stream) {
    static int grid = 0;
    if (grid == 0) {
        if (n_in != 14 || out_size != M * D || ws_size < WS_END) { fprintf(stderr, "kernel_launch: unexpected shapes (n_in %d, out %d, ws %zu)\n", n_in, out_size, ws_size); grid = -1; return; }
        int dev = 0, cus = 0, per_cu = 0;
        (void)hipGetDevice(&dev); (void)hipDeviceGetAttribute(&cus, hipDeviceAttributeMultiprocessorCount, dev);
        if (hipFuncSetAttribute((const void*)fwd_megakernel, hipFuncAttributeMaxDynamicSharedMemorySize, LDS_BYTES) != hipSuccess) { fprintf(stderr, "kernel_launch: hipFuncSetAttribute failed\n"); grid = -1; return; }
        if (hipOccupancyMaxActiveBlocksPerMultiprocessor(&per_cu, (const void*)fwd_megakernel, NWAVES * 64, LDS_BYTES) != hipSuccess || per_cu < 1) { fprintf(stderr, "kernel_launch: occupancy query says %d blocks per CU\n", per_cu); per_cu = 1; }
        (void)hipGetLastError();
        grid = cus * (per_cu < 1 ? 1 : per_cu);
        if (grid > 256) grid = 256;
    }
    if (grid < 0) return;
    (void)hipMemsetAsync((char*)d_ws + WS_BAR, 0, BAR_ZERO_BYTES, stream);
    Args a{};
    for (int i = 0; i < 14; ++i) a.in[i] = (const float*)d_in[i];
    a.out = (float*)d_out; a.ws = (unsigned char*)d_ws;
#if MK_ONE_LAUNCH
    a.ph_lo = 0; a.ph_hi = N_PHASES;
    void* kargs[] = {&a};
    hipError_t e = hipLaunchCooperativeKernel((const void*)fwd_megakernel, dim3(grid), dim3(NWAVES * 64), kargs, LDS_BYTES, stream);
    if (e != hipSuccess) fprintf(stderr, "kernel_launch: cooperative launch failed: %s (grid %d)\n", hipGetErrorString(e), grid);
#else
    for (int p = 0; p < N_PHASES; ++p) { a.ph_lo = p; a.ph_hi = p + 1; hipLaunchKernelGGL(fwd_megakernel, dim3(grid), dim3(NWAVES * 64), LDS_BYTES, stream, a); }
#endif
}
```

```cpp
#include <hip/hip_cooperative_groups.h>
#include <hip/hip_runtime.h>
#include <cstdio>
#include <cstdint>
namespace pg8 {
#define PG8_LAS __attribute__((address_space(3)))
typedef unsigned short bf16_t;
typedef short bf16x8 __attribute__((ext_vector_type(8)));
typedef float f32x4 __attribute__((ext_vector_type(4)));
typedef unsigned u32x4 __attribute__((ext_vector_type(4)));
constexpr int BM = 256, BK = 64, HALF = 128, HTB = HALF * BK * 2  , STAGE_BYTES = 8 * HTB, NXCD = 8, WGM = 4;

__host__ __device__ __forceinline__ int lds_byte(int r, int c) { const int st = (r >> 4) * 2 + (c >> 5), rr = r & 15, cc = c & 31, ob = rr * 64 + cc * 2; return st * 1024 + (ob ^ (((ob >> 9) & 1) << 5)); }
__host__ __device__ __forceinline__ void stage_rc(int b, int& R, int& C) { const int st = b / 1024, sb = b % 1024, swz = sb ^ (((sb >> 9) & 1) << 5); R = (st >> 1) * 16 + swz / 64; C = (st & 1) * 32 + (swz % 64) / 2; }
__host__ __device__ __forceinline__ int perm32(int rho) { const int n = rho >> 4, i = rho & 15; return 8 * (i >> 2) + 4 * n + (i & 3); }

struct Unit { int pm, pn; };
struct Gemm { const bf16_t* A; const bf16_t* Bt; int M, N, K; int ldA, ldB; unsigned kA, kB; size_t tA, tB; };
__device__ __forceinline__ Gemm make_gemm(const bf16_t* A, const bf16_t* Bt, int M, int N, int K, bool blkA, bool blkB) {
    Gemm g; g.A = A; g.Bt = Bt; g.M = M; g.N = N; g.K = K;
    g.ldA = blkA ? 64 : K; g.kA = blkA ? 32768u : 128u; g.tA = blkA ? (size_t)(K / 64) * 32768 : (size_t)256 * K * 2;
    g.ldB = blkB ? 64 : K; g.kB = blkB ? 32768u : 128u; g.tB = blkB ? (size_t)(K / 64) * 32768 : (size_t)256 * K * 2;
    return g; }

struct StaticOrder {
    int nM, nN, nwg, G, c;
    __host__ __device__ void init(int M, int N, int G_, int c_) { nM = M / BM; nN = N / BM; nwg = nM * nN; G = G_; c = c_; }
    __host__ __device__ bool next(int i, Unit& u) const {
        const long L = (long)i * G + c; if (L >= nwg) return false;
        int wgid = (int)L; { const int q = nwg / NXCD, r = nwg % NXCD, xcd = wgid % NXCD, off = wgid / NXCD; wgid = (xcd < r ? xcd * (q + 1) : r * (q + 1) + (xcd - r) * q) + off; }
        const int nig = WGM * nN, gid = wgid / nig, fm = gid * WGM, gsz = (nM - fm) < WGM ? (nM - fm) : WGM;
        u.pm = fm + ((wgid % nig) % gsz); u.pn = (wgid % nig) / gsz; return true;
    }
    __device__ __forceinline__ void a_ready(const Unit&) const {}
    __device__ __forceinline__ void done(const Unit&) const {}
};

__device__ __forceinline__ unsigned cvt_pk_bf16(float lo, float hi) { unsigned r; asm volatile("v_cvt_pk_bf16_f32 %0, %1, %2" : "=v"(r) : "v"(lo), "v"(hi)); return r; }
typedef float f32x2 __attribute__((ext_vector_type(2)));
typedef unsigned u32x2 __attribute__((ext_vector_type(2)));
__device__ __forceinline__ float row_rstd(const float* ssqp, int row) {
    const f32x4* p = (const f32x4*)(ssqp + (size_t)row * 16);
    const f32x4 a = p[0], b = p[1], c = p[2], d = p[3];
    const f32x4 s = (a + b) + (c + d);
    const float t = (s[0] + s[1]) + (s[2] + s[3]);
    return __builtin_amdgcn_rsqf(t * (1.0f / 1024.0f) + 1e-6f);
}
template <int ACT, bool BLK = false> struct EpiScaleBf16 {
    static constexpr bool PERM = true, AFTER_DRAIN = false;
    bf16_t* O; int ldc; const float* ssqp; int split_cols; size_t split_stride; float scale0;
    unsigned* norms;
    __device__ __forceinline__ void operator()(const f32x4 (&acc)[2][2][4][2], const Unit& u, int wr, int wc, int fr, int fq) const {
        const int row0 = u.pm * BM + wr * 64 + fr; int colt = u.pn * BM; bf16_t* base = O; int tsplit = 0;
        float sc = 1.f; if (split_cols) { const int t = colt / split_cols; tsplit = t; base += (size_t)t * split_stride; colt -= t * split_cols; if (t == 0) sc = scale0; }
        const bool do_norm = (norms != nullptr) && tsplit < 2; float hm[2] = {0.f, 0.f};
        const int col0 = colt + wc * 32 + 8 * fq;
        f32x4 pq[2][4]; float rsv[2][4];
#pragma unroll
        for (int ai = 0; ai < 2; ++ai)
#pragma unroll
            for (int m = 0; m < 4; ++m) pq[ai][m] = *(const f32x4*)(ssqp + (size_t)(row0 + ai * HALF + m * 16) * 16 + 4 * fq);
#pragma unroll
        for (int ai = 0; ai < 2; ++ai)
#pragma unroll
            for (int m = 0; m < 4; ++m) { float t = (pq[ai][m][0] + pq[ai][m][1]) + (pq[ai][m][2] + pq[ai][m][3]); t += __shfl_xor(t, 16); t += __shfl_xor(t, 32);
                rsv[ai][m] = __builtin_amdgcn_rsqf(t * (1.0f / 1024.0f) + 1e-6f) * sc; }
#pragma unroll
        for (int ai = 0; ai < 2; ++ai)
#pragma unroll
            for (int m = 0; m < 4; ++m) { const int row = row0 + ai * HALF + m * 16; const float rs = rsv[ai][m];
                bf16_t* rowp = BLK ? base + ((size_t)(u.pm * (ldc >> 6) + u.pn * 4 + (wc >> 1)) * 256 + (wr * 64 + fr + ai * HALF + m * 16)) * 64 + (wc & 1) * 32 + 8 * fq : base + (size_t)row * ldc + col0;
#pragma unroll
                for (int bj = 0; bj < 2; ++bj) { f32x4 v0 = acc[ai][bj][m][0] * rs, v1 = acc[ai][bj][m][1] * rs;
                    if (ACT == 2) {
#pragma unroll
                        for (int e = 0; e < 4; ++e) { const float a = __builtin_fmaxf(v0[e], 0.f), b = __builtin_fmaxf(v1[e], 0.f); v0[e] = a * a; v1[e] = b * b; } }
                    if (do_norm) { float q = ((v0[0] * v0[0] + v0[1] * v0[1]) + (v0[2] * v0[2] + v0[3] * v0[3])) + ((v1[0] * v1[0] + v1[1] * v1[1]) + (v1[2] * v1[2] + v1[3] * v1[3]));
                        q += __shfl_xor(q, 16); q += __shfl_xor(q, 32); hm[bj] = __builtin_fmaxf(hm[bj], q); }
                    u32x4 w; w.x = cvt_pk_bf16(v0[0], v0[1]); w.y = cvt_pk_bf16(v0[2], v0[3]); w.z = cvt_pk_bf16(v1[0], v1[1]); w.w = cvt_pk_bf16(v1[2], v1[3]);
                    *(u32x4*)(rowp + (BLK ? bj * 2 * 256 * 64 : bj * HALF)) = w; } }
        if (do_norm) {
#pragma unroll
            for (int bj = 0; bj < 2; ++bj) { float m = hm[bj];
#pragma unroll
                for (int o = 1; o < 16; o <<= 1) m = __builtin_fmaxf(m, __shfl_xor(m, o));
                if (fr == 0 && fq == 0) __hip_atomic_fetch_max(norms + 2 * ((u.pm >> 4) * 16 + ((colt + bj * HALF + wc * 32) >> 6)) + (tsplit == 0 ? 1 : 0), __float_as_uint(2.0f * m), __ATOMIC_RELAXED, __HIP_MEMORY_SCOPE_AGENT); } }
    }
};
struct EpiRes {
    static constexpr bool PERM = true, AFTER_DRAIN = false;
    bf16_t* hb; float* ssqp; int ldc;
    __device__ __forceinline__ void operator()(const f32x4 (&acc)[2][2][4][2], const Unit& u, int wr, int wc, int fr, int fq) const {
        const int row0 = u.pm * BM + wr * 64 + fr, col0 = u.pn * BM + wc * 32 + 8 * fq;
#pragma unroll
        for (int ai = 0; ai < 2; ++ai) {
            u32x4 old[4][2];
#pragma unroll
            for (int m = 0; m < 4; ++m)
#pragma unroll
                for (int bj = 0; bj < 2; ++bj) old[m][bj] = *(const u32x4*)(hb + (size_t)(row0 + ai * HALF + m * 16) * ldc + col0 + bj * HALF);
#pragma unroll
            for (int m = 0; m < 4; ++m) { const int r = row0 + ai * HALF + m * 16; bf16_t* rowp = hb + (size_t)r * ldc + col0; float q = 0.f;
#pragma unroll
                for (int bj = 0; bj < 2; ++bj) { const u32x4 ov = old[m][bj]; const f32x4 a0 = acc[ai][bj][m][0], a1 = acc[ai][bj][m][1];
                    const float o0 = __uint_as_float(ov.x << 16) + a0[0], o1 = __uint_as_float(ov.x & 0xffff0000u) + a0[1], o2 = __uint_as_float(ov.y << 16) + a0[2], o3 = __uint_as_float(ov.y & 0xffff0000u) + a0[3];
                    const float o4 = __uint_as_float(ov.z << 16) + a1[0], o5 = __uint_as_float(ov.z & 0xffff0000u) + a1[1], o6 = __uint_as_float(ov.w << 16) + a1[2], o7 = __uint_as_float(ov.w & 0xffff0000u) + a1[3];
                    q += ((o0 * o0 + o1 * o1) + (o2 * o2 + o3 * o3)) + ((o4 * o4 + o5 * o5) + (o6 * o6 + o7 * o7));
                    u32x4 w; w.x = cvt_pk_bf16(o0, o1); w.y = cvt_pk_bf16(o2, o3); w.z = cvt_pk_bf16(o4, o5); w.w = cvt_pk_bf16(o6, o7);
                    *(u32x4*)(rowp + bj * HALF) = w; }
                q += __shfl_xor(q, 16); q += __shfl_xor(q, 32);
                if (fq == 0) ssqp[(size_t)r * 16 + u.pn * 4 + wc] = q; }
            asm volatile("" ::: "memory"); }
    }
};

template <class Epi, class Sched, bool ALIGN_EPI = false, bool SP2 = false>
__device__ __forceinline__ void gemm_phase(PG8_LAS unsigned char* lds, const Gemm g, const Sched& S, const Epi& E) {
    int tid = threadIdx.x; asm volatile("" : "+v"(tid)); const int wid = __builtin_amdgcn_readfirstlane(tid >> 6), lane = tid & 63, wr = wid >> 2, wc = wid & 3, fr = lane & 15, fq = lane >> 4;
    const int K = g.K, nt = K / BK;
    unsigned voffA[2], voffB[2];
#pragma unroll
    for (int i = 0; i < 2; ++i) { int R, C; stage_rc(tid * 16 + i * 8192, R, C); const int Rb = Epi::PERM ? ((R & ~31) + perm32(R & 31)) : R;
        voffA[i] = (unsigned)(R * g.ldA + C) * 2u; voffB[i] = (unsigned)(Rb * g.ldB + C) * 2u; }
    const size_t kstepA = g.kA, kstepB = g.kB;
    const size_t hstepA = (size_t)HALF * g.ldA * 2, hstepB = (size_t)HALF * g.ldB * 2;
    const size_t tstepA = g.tA, tstepB = g.tB;
    const unsigned ldsw = (unsigned)wid * 1024u;
    const int aoff = lds_byte(wr * 64 + fr, fq * 8), boff = lds_byte(wc * 32 + fr, fq * 8);
#define PG8_SA(b, h) (((b) * 2 + (h)) * HTB)
#define PG8_SB(b, h) ((4 + (b) * 2 + (h)) * HTB)
#define PG8_STAGE(bufoff, gbase, voff) do { _Pragma("unroll") for (int _i = 0; _i < 2; ++_i) \
        __builtin_amdgcn_global_load_lds((const unsigned*)((const char*)(gbase) + (voff)[_i]), (PG8_LAS unsigned*)(lds + (bufoff) + ldsw + _i * 8192), 16, 0, 0); } while (0)
#define PG8_LDA(dst, b, h) do { _Pragma("unroll") for (int m = 0; m < 4; ++m) _Pragma("unroll") for (int k = 0; k < 2; ++k) dst[m][k] = *(const PG8_LAS bf16x8*)(lds + PG8_SA(b, h) + aoff + m * 2048 + k * 1024); } while (0)
#define PG8_LDB(dst, b, h) do { _Pragma("unroll") for (int n = 0; n < 2; ++n) _Pragma("unroll") for (int k = 0; k < 2; ++k) dst[n][k] = *(const PG8_LAS bf16x8*)(lds + PG8_SB(b, h) + boff + n * 2048 + k * 1024); } while (0)
#define PG8_MMA(ai, bj, At, Bt) do { __builtin_amdgcn_s_setprio(1); _Pragma("unroll") for (int m = 0; m < 4; ++m) _Pragma("unroll") for (int n = 0; n < 2; ++n) _Pragma("unroll") for (int k = 0; k < 2; ++k) \
        acc[ai][bj][m][n] = __builtin_amdgcn_mfma_f32_16x16x32_bf16(Bt[n][k], At[m][k], acc[ai][bj][m][n], 0, 0, 0); __builtin_amdgcn_s_setprio(0); } while (0)
#define PG8_WAIT_V(n) asm volatile("s_waitcnt vmcnt(" #n ")" ::: "memory")
#define PG8_WAIT_L(n) asm volatile("s_waitcnt lgkmcnt(" #n ")" ::: "memory")
#define PG8_BAR __builtin_amdgcn_s_barrier()
#define PG8_SCHED __builtin_amdgcn_sched_barrier(0)
    Unit cur, nxt; int ui = 0;
    if (!S.next(0, cur)) return;
    f32x4 acc[2][2][4][2];
#pragma unroll
    for (int a = 0; a < 2; ++a)
#pragma unroll
        for (int b = 0; b < 2; ++b)
#pragma unroll
            for (int m = 0; m < 4; ++m)
#pragma unroll
                for (int n = 0; n < 2; ++n) acc[a][b][m][n] = (f32x4){0.f, 0.f, 0.f, 0.f};
    bf16x8 At[4][2], B0[2][2], B1[2][2];
    const char* cA = (const char*)g.A + (size_t)cur.pm * tstepA; const char* cB = (const char*)g.Bt + (size_t)cur.pn * tstepB;
    S.a_ready(cur);
    if constexpr (SP2) {
        PG8_STAGE(PG8_SB(0, 0), cB, voffB); PG8_STAGE(PG8_SB(0, 1), cB + hstepB, voffB); PG8_STAGE(PG8_SA(0, 0), cA, voffA); PG8_STAGE(PG8_SA(0, 1), cA + hstepA, voffA);
        if (wr == 1) PG8_BAR;
        PG8_WAIT_V(2); PG8_BAR;
        PG8_STAGE(PG8_SB(1, 0), cB + kstepB, voffB); PG8_STAGE(PG8_SA(1, 0), cA + kstepA, voffA); PG8_STAGE(PG8_SB(1, 1), cB + hstepB + kstepB, voffB);
        PG8_WAIT_V(6); PG8_BAR;
    } else {
        PG8_STAGE(PG8_SB(0, 0), cB, voffB); PG8_STAGE(PG8_SA(0, 0), cA, voffA); PG8_STAGE(PG8_SB(0, 1), cB + hstepB, voffB); PG8_STAGE(PG8_SA(0, 1), cA + hstepA, voffA);
        if (wr == 1) PG8_BAR;
        PG8_WAIT_V(4); PG8_BAR;
        PG8_STAGE(PG8_SB(1, 0), cB + kstepB, voffB); PG8_STAGE(PG8_SA(1, 0), cA + kstepA, voffA); PG8_STAGE(PG8_SB(1, 1), cB + hstepB + kstepB, voffB);
        PG8_WAIT_V(6); PG8_BAR;
    }
    for (;;) {
        const bool has_next = S.next(ui + 1, nxt);
        const char* nA = has_next ? (const char*)g.A + (size_t)nxt.pm * tstepA : cA; const char* nB = has_next ? (const char*)g.Bt + (size_t)nxt.pn * tstepB : cB;
        for (int t = 0; t < nt; t += 2) {
            const bool last = (t == nt - 2);
            const char* a1 = cA + (size_t)(t + 1) * kstepA;
            const char* a2 = last ? nA : cA + (size_t)(t + 2) * kstepA; const char* b2 = last ? nB : cB + (size_t)(t + 2) * kstepB;
            const char* a3 = a2 + kstepA; const char* b3 = b2 + kstepB;
            if (last && has_next) S.a_ready(nxt);
            if constexpr (SP2) {
            PG8_LDB(B0, 0, 0); PG8_LDB(B1, 0, 1); PG8_SCHED; PG8_LDA(At, 0, 0); PG8_STAGE(PG8_SA(1, 1), a1 + hstepA, voffA);
            PG8_WAIT_V(8); PG8_WAIT_L(0); PG8_BAR; PG8_MMA(0, 0, At, B0); PG8_MMA(0, 1, At, B1); PG8_BAR; PG8_SCHED;
            PG8_LDA(At, 0, 1); PG8_STAGE(PG8_SB(0, 0), b2, voffB); PG8_STAGE(PG8_SB(0, 1), b2 + hstepB, voffB); PG8_STAGE(PG8_SA(0, 0), a2, voffA);
            PG8_WAIT_V(8); PG8_WAIT_L(0); PG8_BAR; PG8_MMA(1, 0, At, B0); PG8_MMA(1, 1, At, B1); PG8_BAR; PG8_SCHED;
            PG8_LDB(B0, 1, 0); PG8_LDB(B1, 1, 1); PG8_SCHED; PG8_LDA(At, 1, 0); PG8_STAGE(PG8_SA(0, 1), a2 + hstepA, voffA);
            PG8_WAIT_V(8); PG8_WAIT_L(0); PG8_BAR; PG8_MMA(0, 0, At, B0); PG8_MMA(0, 1, At, B1); PG8_BAR; PG8_SCHED;
            PG8_LDA(At, 1, 1); PG8_STAGE(PG8_SB(1, 0), b3, voffB); PG8_STAGE(PG8_SB(1, 1), b3 + hstepB, voffB); PG8_STAGE(PG8_SA(1, 0), a3, voffA);
            PG8_WAIT_V(8); PG8_WAIT_L(0); PG8_BAR; PG8_MMA(1, 0, At, B0); PG8_MMA(1, 1, At, B1); PG8_BAR; PG8_SCHED;
            } else {
            PG8_LDB(B0, 0, 0); PG8_SCHED; PG8_LDA(At, 0, 0); PG8_STAGE(PG8_SA(1, 1), a1 + hstepA, voffA);
            PG8_WAIT_L(8); PG8_BAR; PG8_WAIT_L(0); PG8_MMA(0, 0, At, B0); PG8_BAR; PG8_SCHED;
            PG8_LDB(B1, 0, 1); PG8_STAGE(PG8_SB(0, 0), b2, voffB);
            PG8_BAR; PG8_WAIT_L(0); PG8_MMA(0, 1, At, B1); PG8_BAR;
            PG8_LDA(At, 0, 1); PG8_STAGE(PG8_SA(0, 0), a2, voffA);
            PG8_BAR; PG8_WAIT_L(0); PG8_MMA(1, 0, At, B0); PG8_BAR; PG8_SCHED;
            PG8_STAGE(PG8_SB(0, 1), b2 + hstepB, voffB);
            PG8_WAIT_V(6); PG8_BAR; PG8_MMA(1, 1, At, B1); PG8_BAR;
            PG8_LDB(B0, 1, 0); PG8_SCHED; PG8_LDA(At, 1, 0); PG8_STAGE(PG8_SA(0, 1), a2 + hstepA, voffA);
            PG8_WAIT_L(8); PG8_BAR; PG8_WAIT_L(0); PG8_MMA(0, 0, At, B0); PG8_BAR; PG8_SCHED;
            PG8_LDB(B1, 1, 1); PG8_STAGE(PG8_SB(1, 0), b3, voffB);
            PG8_BAR; PG8_WAIT_L(0); PG8_MMA(0, 1, At, B1); PG8_BAR;
            PG8_LDA(At, 1, 1); PG8_STAGE(PG8_SA(1, 0), a3, voffA);
            PG8_BAR; PG8_WAIT_L(0); PG8_MMA(1, 0, At, B0); PG8_BAR; PG8_SCHED;
            PG8_STAGE(PG8_SB(1, 1), b3 + hstepB, voffB);
            PG8_WAIT_V(6); PG8_BAR; PG8_MMA(1, 1, At, B1); PG8_BAR;
            }
        }
        if constexpr (ALIGN_EPI) { if (wr == 0) PG8_BAR; }
        if constexpr (!Epi::AFTER_DRAIN) { E(acc, cur, wr, wc, fr, fq); S.done(cur); }
        if (!has_next) break;
#pragma unroll
        for (int a = 0; a < 2; ++a)
#pragma unroll
            for (int b = 0; b < 2; ++b)
#pragma unroll
                for (int m = 0; m < 4; ++m)
#pragma unroll
                    for (int n = 0; n < 2; ++n) acc[a][b][m][n] = (f32x4){0.f, 0.f, 0.f, 0.f};
        cur = nxt; cA = nA; cB = nB; ++ui;
        if constexpr (ALIGN_EPI) { if (wr == 1) PG8_BAR; }
    }
    PG8_WAIT_V(0);
    if constexpr (!ALIGN_EPI) { if (wr == 0) PG8_BAR; }
    PG8_BAR;
    if constexpr (Epi::AFTER_DRAIN) { E.fused(acc, cur, wr, wc, fr, fq, lds, wid, lane); S.done(cur); }
#undef PG8_SA
#undef PG8_SB
#undef PG8_STAGE
#undef PG8_LDA
#undef PG8_LDB
#undef PG8_MMA
#undef PG8_WAIT_V
#undef PG8_WAIT_L
#undef PG8_BAR
#undef PG8_SCHED
}
}

#ifndef PG8_SP2
#define PG8_SP2 true
#endif
#ifndef PG8_ALIGN
#define PG8_ALIGN true
#endif
#include <hip/hip_bf16.h>
#include <cmath>
namespace attn_body {
using bf16=__hip_bfloat16;
using bf16x8=__attribute__((ext_vector_type(8)))short;
using s16x4=__attribute__((ext_vector_type(4)))short;
using f32x16=__attribute__((ext_vector_type(16)))float;
using u32x4=__attribute__((ext_vector_type(4)))unsigned;
constexpr int BATCH=4,NHEAD=16,SEQ=4096,D=64,DM=NHEAD*D;
constexpr int NW=8,QBLK=32,QB=QBLK*NW,KVBLK=64,NQB=SEQ/QB;
constexpr int ATTN_PITCH=DM, ATTN_UNIT_ROWS=QB;
__device__ __forceinline__ int crow(int r,int hi){return (r&3)+8*(r>>2)+4*hi;}
#define SBAR() __builtin_amdgcn_sched_barrier(0)
__device__ __forceinline__ void cmask(f32x16&p0,f32x16&p1,int jb,int qrel,int hi){
  const float NEG=-INFINITY; int kb=64*jb+4*hi;
  #pragma unroll
  for(int r=0;r<16;++r){int kv=kb+(r&3)+8*(r>>2); if(kv>qrel)p0[r]=NEG; if(kv+32>qrel)p1[r]=NEG;}
}

constexpr int NSLOT=3, SLOTB=8192;
constexpr int LDS_K=0, LDS_V=NSLOT*SLOTB, LDS_WS=2*NSLOT*SLOTB, LDS_OST=LDS_WS+NW*64*4, LDS_BYTES=LDS_OST+NW*4096;
constexpr float C2=0.125f*1.4426950408889634f;
__device__ __forceinline__ void glds16(const void*gsrc,unsigned lds_dst){unsigned keep;
  asm volatile("s_mov_b32 %0, m0\n\ts_mov_b32 m0, %2\n\ts_nop 0\n\tglobal_load_lds_dwordx4 %1, off\n\ts_mov_b32 m0, %0":"=&s"(keep):"v"(gsrc),"s"(lds_dst):"memory");}
__device__ __forceinline__ float max3f(float a,float b,float c){float r;asm("v_max3_f32 %0, %1, %2, %3":"=v"(r):"v"(a),"v"(b),"v"(c));return r;}
__device__ __forceinline__ float max2f(float a,float b){float r;asm("v_max_f32_e32 %0, %1, %2":"=v"(r):"v"(a),"v"(b));return r;}
__device__ __forceinline__ float fadd_s(float a,float b){float r;asm("v_add_f32_e32 %0, %1, %2":"=v"(r):"v"(a),"v"(b));return r;}
__device__ __forceinline__ float fsub_s(float a,float b){float r;asm("v_sub_f32_e32 %0, %1, %2":"=v"(r):"v"(a),"v"(b));return r;}
typedef float f32x2_t __attribute__((ext_vector_type(2))); typedef __bf16 bf16x2_t __attribute__((ext_vector_type(2)));
__device__ __forceinline__ unsigned cvtpk_s(float lo,float hi){f32x2_t v={lo,hi};bf16x2_t b=__builtin_convertvector(v,bf16x2_t);return __builtin_bit_cast(unsigned,b);}
#define WAIT_BAR(N) asm volatile("s_waitcnt vmcnt(" #N ") lgkmcnt(0)\n\ts_barrier":::"memory")

__device__ __forceinline__ void qkt(f32x16&p0,f32x16&p1,const char*Kslot,const bf16x8*qr,int r32,int hi){
  const char*kb=Kslot+hi*1024+r32*16;
  #pragma unroll
  for(int d0=0;d0<4;++d0){
    const bf16x8 b0=*reinterpret_cast<const bf16x8*>(kb+d0*2048);
    const bf16x8 b1=*reinterpret_cast<const bf16x8*>(kb+d0*2048+512);
    {p0=__builtin_amdgcn_mfma_f32_32x32x16_bf16(b0,qr[d0],p0,0,0,0);p1=__builtin_amdgcn_mfma_f32_32x32x16_bf16(b1,qr[d0],p1,0,0,0);}}
}
typedef __attribute__((address_space(3))) const char* lds_cptr;
typedef short v4i16_t __attribute__((ext_vector_type(4)));
__device__ __forceinline__ void kload8(bf16x8*kf,lds_cptr kp){
  kf[0]=*(const __attribute__((address_space(3))) bf16x8*)(kp);      kf[1]=*(const __attribute__((address_space(3))) bf16x8*)(kp+512);
  kf[2]=*(const __attribute__((address_space(3))) bf16x8*)(kp+2048); kf[3]=*(const __attribute__((address_space(3))) bf16x8*)(kp+2560);
  kf[4]=*(const __attribute__((address_space(3))) bf16x8*)(kp+4096); kf[5]=*(const __attribute__((address_space(3))) bf16x8*)(kp+4608);
  kf[6]=*(const __attribute__((address_space(3))) bf16x8*)(kp+6144); kf[7]=*(const __attribute__((address_space(3))) bf16x8*)(kp+6656);
}
__device__ __forceinline__ void kload2(bf16x8*kf,lds_cptr kp,int j){ kf[2*j]=*(const __attribute__((address_space(3))) bf16x8*)(kp+j*2048); kf[2*j+1]=*(const __attribute__((address_space(3))) bf16x8*)(kp+j*2048+512); }
__device__ __forceinline__ s16x4 vtr(lds_cptr p){ return __builtin_bit_cast(s16x4,__builtin_amdgcn_ds_read_tr16_b64_v4i16((__attribute__((address_space(3))) v4i16_t*)p)); }
__device__ __forceinline__ float rowmax(const f32x16&p0,const f32x16&p1){
  float a=max3f(p0[0],p0[1],p1[0]),b=max3f(p0[2],p0[3],p1[1]);a=max3f(a,p1[2],p1[3]);
  #pragma unroll
  for(int r=4;r<16;r+=4){a=max3f(a,p0[r],p0[r+1]);b=max3f(b,p0[r+2],p0[r+3]);a=max3f(a,p1[r],p1[r+1]);b=max3f(b,p1[r+2],p1[r+3]);}
  const float m=max2f(a,b);
  auto rr=__builtin_amdgcn_permlane32_swap(__float_as_uint(m),__float_as_uint(m),false,false);
  return max2f(__uint_as_float(rr[0]),__uint_as_float(rr[1]));
}
__device__ __forceinline__ void pv(f32x16*o,int vb,bf16x8 pa0,bf16x8 pa1,bf16x8 pa2,bf16x8 pa3){
  #pragma unroll
  for(int d0=0;d0<2;++d0){s16x4 lo[4],hi[4];
    #pragma unroll
    for(int ks=0;ks<4;++ks){
      asm volatile("ds_read_b64_tr_b16 %0,%1 offset:%c2":"=&v"(lo[ks]):"v"(vb),"i"(d0*4096+ks*1024):"memory");
      asm volatile("ds_read_b64_tr_b16 %0,%1 offset:%c2":"=&v"(hi[ks]):"v"(vb),"i"(d0*4096+ks*1024+512):"memory");}
    asm volatile("s_waitcnt lgkmcnt(0)":::"memory");SBAR();
    #define PK(k) (bf16x8){lo[k][0],lo[k][1],lo[k][2],lo[k][3],hi[k][0],hi[k][1],hi[k][2],hi[k][3]}
    o[d0]=__builtin_amdgcn_mfma_f32_32x32x16_bf16(pa0,PK(0),o[d0],0,0,0);
    o[d0]=__builtin_amdgcn_mfma_f32_32x32x16_bf16(pa1,PK(1),o[d0],0,0,0);
    o[d0]=__builtin_amdgcn_mfma_f32_32x32x16_bf16(pa2,PK(2),o[d0],0,0,0);
    o[d0]=__builtin_amdgcn_mfma_f32_32x32x16_bf16(pa3,PK(3),o[d0],0,0,0);
    #undef PK
  }
}

#ifndef ATTN_STORE16
#define ATTN_STORE16(p,v) (*(u32x4*)(p)=(v))
#endif
typedef __attribute__((address_space(3))) const float* lds_cfptr;
typedef float f32x4a __attribute__((ext_vector_type(4)));
#define BIASINIT(C0,C1,t) do{ const lds_cfptr cb_=cklt+64*(t)+4*hi; \
    { f32x4a v_[4]; _Pragma("unroll") for(int j_=0;j_<4;++j_) v_[j_]=*(const __attribute__((address_space(3))) f32x4a*)(cb_+8*j_); \
      _Pragma("unroll") for(int j_=0;j_<4;++j_) _Pragma("unroll") for(int i_=0;i_<4;++i_) C0[4*j_+i_]=nm-v_[j_][i_]; } \
    SBAR(); \
    { f32x4a v_[4]; _Pragma("unroll") for(int j_=0;j_<4;++j_) v_[j_]=*(const __attribute__((address_space(3))) f32x4a*)(cb_+32+8*j_); \
      _Pragma("unroll") for(int j_=0;j_<4;++j_) _Pragma("unroll") for(int i_=0;i_<4;++i_) C1[4*j_+i_]=nm-v_[j_][i_]; } }while(0)
template<int THRL> __device__ __forceinline__ void attn_unit(int b,int h,int qb,const bf16*Q,const bf16*__restrict__ K,const bf16*__restrict__ V,bf16*O,char*shm,lds_cfptr ckl,int t0){
  int tid=threadIdx.x; asm volatile("":"+v"(tid)); const int lane=tid&63,r32=lane&31,hi=lane>>5; const int wid=__builtin_amdgcn_readfirstlane(tid>>6);
  const long rowbase=(long)b*SEQ; const int q0=qb*QB;
  const bf16*Qw=Q+(rowbase+q0+wid*QBLK)*DM+h*D;
  const bf16*Kh=K+(rowbase+(long)t0*KVBLK)*DM+h*D,*Vh=V+(rowbase+(long)t0*KVBLK)*DM+h*D; const lds_cfptr cklt=ckl+64*t0;
  const unsigned lds0=(unsigned)(uintptr_t)shm;
  float*wsf=(float*)(shm+LDS_WS)+wid*64;
  const bf16*ksrc=Kh+(long)lane*DM+wid*8;
  const bf16*vsrc=Vh+(long)(16*(wid&3)+(lane>>2))*DM+(wid>>2)*32+(lane&3)*8;
  const unsigned kdst=lds0+LDS_K+wid*1024, vdst=lds0+LDS_V+wid*1024;
  #define DMA_K(t,slot) glds16(ksrc+(long)(t)*KVBLK*DM,(unsigned)__builtin_amdgcn_readfirstlane(kdst+(slot)))
  #define DMA_V(t,slot) glds16(vsrc+(long)(t)*KVBLK*DM,(unsigned)__builtin_amdgcn_readfirstlane(vdst+(slot)))
  const int vb0=(int)(lds0+LDS_V)+((lane>>4)&1)*32+(lane&3)*8+(4*hi+((lane&15)>>2))*64;
  const char*Kbase=shm+LDS_K; bf16x8 kf[8];
  const lds_cptr shm3=(lds_cptr)shm; const lds_cptr kp0=shm3+LDS_K+hi*1024+r32*16; const lds_cptr vp0=shm3+LDS_V+((lane>>4)&1)*32+(lane&3)*8+(4*hi+((lane&15)>>2))*64;
  const int NT=(q0+QB)/KVBLK-t0;
  DMA_K(0,0);DMA_V(0,0);DMA_K(1,SLOTB);
  bf16x8 qr[4];
  #pragma unroll
  for(int d0=0;d0<4;++d0)qr[d0]=*reinterpret_cast<const bf16x8*>(&Qw[(long)r32*DM+d0*16+hi*8]);
  float mhat=0.f,l_reg=0.f;f32x16 o[2];o[0]=f32x16{};o[1]=f32x16{};
  const int qrel=wid*QBLK+r32; float nm=ckl[q0+qrel];
  #define CMASK(P0,P1,t) do{int jb_=(t)-(NT-4); if(jb_>=0)cmask(P0,P1,jb_,qrel,hi);}while(0)
  bool resc=false;
  #define START(P0,P1) do{ const float rm=rowmax(P0,P1); resc=false; \
    { const float dl=__builtin_fmaxf(rm,0.f); mhat=fadd_s(mhat,dl); nm=fsub_s(nm,dl); \
      _Pragma("unroll") for(int r=0;r<16;++r){P0[r]=fsub_s(P0[r],dl);P1[r]=fsub_s(P1[r],dl);} } \
    _Pragma("unroll") for(int r=0;r<16;++r)P0[r]=__builtin_amdgcn_exp2f(P0[r]); }while(0)
  #define RESC() do{ if(resc){ asm volatile("s_waitcnt lgkmcnt(0)":::"memory"); \
      _Pragma("unroll") for(int d_=0;d_<2;++d_) _Pragma("unroll") for(int r=0;r<16;++r)o[d_][r]*=wsf[crow(r,hi)]; } }while(0)
  f32x16 pA0,pA1,pB0,pB1;
  int sl_prev=0,sl_cur=0,sl_next=SLOTB;
  #define ROT() do{sl_prev=sl_cur;sl_cur=sl_next;sl_next=(sl_next==(NSLOT-1)*SLOTB)?0:sl_next+SLOTB;}while(0)
  DMA_K(2,2*SLOTB);
  WAIT_BAR(3);
  BIASINIT(pA0,pA1,0); qkt(pA0,pA1,Kbase,qr,r32,hi);asm volatile("s_nop 15\n\ts_nop 7":"+v"(pA0),"+v"(pA1));CMASK(pA0,pA1,0);
  START(pA0,pA1);
  _Pragma("unroll") for(int r=0;r<16;++r)pA1[r]=__builtin_amdgcn_exp2f(pA1[r]);
  WAIT_BAR(0);
  DMA_K(3,0);DMA_V(1,SLOTB);
  ROT();
  kload8(kf,kp0+sl_cur);
  WAIT_BAR(2);
  s16x4 vlo[8],vhi[8]; u32x4 pw0,pw1,pw2,pw3;
  #define PKW(P,B) cvtpk_s(P[B],P[B+1])
  #define PAF(k) __builtin_bit_cast(bf16x8,pw##k)
  #define VFR(i) (bf16x8){vlo[i][0],vlo[i][1],vlo[i][2],vlo[i][3],vhi[i][0],vhi[i][1],vhi[i][2],vhi[i][3]}
  #define PIN(x) asm volatile("":"+v"(x))
  #define MX3(a,b,c) __builtin_fmaxf(__builtin_fmaxf((a),(b)),(c))
  #define GAPA(MF,A0,A1,A2,A3,W0,W1,PW) do{ MF; sacc+=A0; sacc+=A1; sacc+=A2; sacc+=A3; PIN(sacc); W0; W1; PIN(PW); SBAR(); }while(0)
  #define EX(v) __builtin_amdgcn_exp2f(v)
  #define GAPB(MF,X,B) do{ MF; X[B]=EX(X[B]); X[B+1]=EX(X[B+1]); X[B+2]=EX(X[B+2]); X[B+3]=EX(X[B+3]); PIN(X); SBAR(); }while(0)
  #define VRD(i) do{ vlo[i]=vtr(vp_+(((i)>>2)*4096+((i)&3)*1024)); vhi[i]=vtr(vp_+(((i)>>2)*4096+((i)&3)*1024+512)); }while(0)
  #define KRD(G,j) do{ if(G){ kload2(kf,kp0+sl_next,j); SBAR(); } }while(0)
  #define STEP(C0,C1,P0,P1,t,GK,GV,GL) do{ SBAR(); \
    BIASINIT(C0,C1,t); SBAR(); \
    const lds_cptr vp_=vp0+sl_prev; \
    VRD(0); SBAR(); float sacc=(P0[0]+P0[1]); \
    GAPA(C0=__builtin_amdgcn_mfma_f32_32x32x16_bf16(kf[0],qr[0],C0,0,0,0), P0[2],P0[3],P0[4],P0[5],     pw0[0]=PKW(P0,0), pw0[1]=PKW(P0,2), pw0); \
    VRD(4); SBAR(); GAPA(C1=__builtin_amdgcn_mfma_f32_32x32x16_bf16(kf[1],qr[0],C1,0,0,0), P0[6],P0[7],P0[8],P0[9],     pw0[2]=PKW(P0,4), pw0[3]=PKW(P0,6), pw0); \
    VRD(1); SBAR(); GAPA(C0=__builtin_amdgcn_mfma_f32_32x32x16_bf16(kf[2],qr[1],C0,0,0,0),   P0[10],P0[11],P0[12],P0[13], pw1[0]=PKW(P0,8), pw1[1]=PKW(P0,10), pw1); \
    VRD(5); SBAR(); GAPA(C1=__builtin_amdgcn_mfma_f32_32x32x16_bf16(kf[3],qr[1],C1,0,0,0),   P0[14],P0[15],P1[0],P1[1],   pw1[2]=PKW(P0,12),pw1[3]=PKW(P0,14), pw1); \
    VRD(2); SBAR(); GAPA(C0=__builtin_amdgcn_mfma_f32_32x32x16_bf16(kf[4],qr[2],C0,0,0,0),   P1[2],P1[3],P1[4],P1[5],     pw2[0]=PKW(P1,0), pw2[1]=PKW(P1,2), pw2); \
    VRD(6); SBAR(); GAPA(C1=__builtin_amdgcn_mfma_f32_32x32x16_bf16(kf[5],qr[2],C1,0,0,0),   P1[6],P1[7],P1[8],P1[9],     pw2[2]=PKW(P1,4), pw2[3]=PKW(P1,6), pw2); \
    VRD(3); SBAR(); GAPA(C0=__builtin_amdgcn_mfma_f32_32x32x16_bf16(kf[6],qr[3],C0,0,0,0),   P1[10],P1[11],P1[12],P1[13], pw3[0]=PKW(P1,8), pw3[1]=PKW(P1,10), pw3); \
    VRD(7); SBAR(); GAPA(C1=__builtin_amdgcn_mfma_f32_32x32x16_bf16(kf[7],qr[3],C1,0,0,0),   P1[14],P1[15],0.f,0.f,       pw3[2]=PKW(P1,12),pw3[3]=PKW(P1,14), pw3); \
    l_reg+=sacc; \
    if(GK){DMA_K((t)+3,sl_cur);} if(GV){DMA_V((t)+1,sl_next);} \
    CMASK(C0,C1,t); \
    { float a=MX3(C0[0],C0[1],C1[0]),b=MX3(C0[2],C0[3],C1[1]); a=MX3(a,C1[2],C1[3]); \
      _Pragma("unroll") for(int r=4;r<16;r+=4){a=MX3(a,C0[r],C0[r+1]);b=MX3(b,C0[r+2],C0[r+3]);a=MX3(a,C1[r],C1[r+1]);b=MX3(b,C1[r+2],C1[r+3]);} \
      float rm=__builtin_fmaxf(a,b); { auto rr=__builtin_amdgcn_permlane32_swap(__float_as_uint(rm),__float_as_uint(rm),false,false); rm=__builtin_fmaxf(__uint_as_float(rr[0]),__uint_as_float(rr[1])); } \
      resc=false; \
      if(__builtin_expect(__any(rm>(float)THRL),0)){ const float dl=__builtin_fmaxf(rm,0.f); mhat+=dl; nm-=dl; \
        _Pragma("unroll") for(int r=0;r<16;++r){C0[r]-=dl;C1[r]-=dl;} \
        const float f=__builtin_amdgcn_exp2f(-dl); l_reg*=f; if(hi==0)wsf[r32]=f; resc=true; } } \
    SBAR(); \
    GAPB(o[0]=__builtin_amdgcn_mfma_f32_32x32x16_bf16(PAF(0),VFR(0),o[0],0,0,0), C0,0); \
    GAPB(o[1]=__builtin_amdgcn_mfma_f32_32x32x16_bf16(PAF(0),VFR(4),o[1],0,0,0), C0,4); \
    KRD(GL,0); GAPB(o[0]=__builtin_amdgcn_mfma_f32_32x32x16_bf16(PAF(1),VFR(1),o[0],0,0,0), C0,8); \
    KRD(GL,1); GAPB(o[1]=__builtin_amdgcn_mfma_f32_32x32x16_bf16(PAF(1),VFR(5),o[1],0,0,0), C0,12); \
    KRD(GL,2); GAPB(o[0]=__builtin_amdgcn_mfma_f32_32x32x16_bf16(PAF(2),VFR(2),o[0],0,0,0), C1,0); \
    KRD(GL,3); GAPB(o[1]=__builtin_amdgcn_mfma_f32_32x32x16_bf16(PAF(2),VFR(6),o[1],0,0,0), C1,4); \
    GAPB(o[0]=__builtin_amdgcn_mfma_f32_32x32x16_bf16(PAF(3),VFR(3),o[0],0,0,0), C1,8); \
    GAPB(o[1]=__builtin_amdgcn_mfma_f32_32x32x16_bf16(PAF(3),VFR(7),o[1],0,0,0), C1,12); \
    }while(0)
  int t=1;
  #undef CMASK
  #define CMASK(P0,P1,t) do{}while(0)
  for(;t+5<NT;t+=2){
    STEP(pB0,pB1,pA0,pA1,t,true,true,true);     WAIT_BAR(2); RESC(); ROT();
    STEP(pA0,pA1,pB0,pB1,t+1,true,true,true);   WAIT_BAR(2); RESC(); ROT();
  }
  #undef CMASK
  #define CMASK(P0,P1,t) do{int jb_=(t)-(NT-4); if(jb_>=0)cmask(P0,P1,jb_,qrel,hi);}while(0)
  #define ENDW(tt) do{ if((tt)+3<NT){WAIT_BAR(2);} else if((tt)+2<NT){WAIT_BAR(1);} else {WAIT_BAR(0);} }while(0)
  for(;t+1<NT;t+=2){
    STEP(pB0,pB1,pA0,pA1,t,(t+3<NT),(t+1<NT),(t+1<NT));       ENDW(t);   RESC(); ROT();
    STEP(pA0,pA1,pB0,pB1,t+1,(t+4<NT),(t+2<NT),(t+2<NT));     ENDW(t+1); RESC(); ROT();
  }
  STEP(pB0,pB1,pA0,pA1,NT-1,false,false,false); RESC();
  { float sacc=pB0[0]+pB0[1]; _Pragma("unroll") for(int r=2;r<16;++r)sacc+=pB0[r]; _Pragma("unroll") for(int r=0;r<16;++r)sacc+=pB1[r]; l_reg+=sacc;
    pw0=(u32x4){PKW(pB0,0),PKW(pB0,2),PKW(pB0,4),PKW(pB0,6)};pw1=(u32x4){PKW(pB0,8),PKW(pB0,10),PKW(pB0,12),PKW(pB0,14)};pw2=(u32x4){PKW(pB1,0),PKW(pB1,2),PKW(pB1,4),PKW(pB1,6)};pw3=(u32x4){PKW(pB1,8),PKW(pB1,10),PKW(pB1,12),PKW(pB1,14)};
    SBAR(); pv(o,vb0+sl_cur,PAF(0),PAF(1),PAF(2),PAF(3)); }
  #undef PKW
  #undef PAF
  #undef VFR
  #undef PIN
  #undef MX3
  #undef GAPA
  #undef GAPB
  #undef EX
  #undef VRD
  #undef KRD
  #undef STEP
  #undef ENDW
  {auto rr=__builtin_amdgcn_permlane32_swap(__float_as_uint(l_reg),__float_as_uint(l_reg),false,false);l_reg=__uint_as_float(rr[0])+__uint_as_float(rr[1]);}
  if(hi==0)wsf[32+r32]=l_reg;asm volatile("s_waitcnt lgkmcnt(0)":::"memory");
  float rli[16];
  #pragma unroll
  for(int r=0;r<16;++r)rli[r]=__builtin_amdgcn_rcpf(wsf[32+crow(r,hi)]);
  bf16*Ow=O+(rowbase+q0+wid*QBLK)*DM+h*D;
  { bf16*stg=(bf16*)(shm+LDS_OST)+wid*2048;
    #pragma unroll
    for(int r=0;r<16;++r){const int orow=crow(r,hi);
      #pragma unroll
      for(int d0=0;d0<2;++d0)stg[orow*64+d0*32+r32]=__float2bfloat16(o[d0][r]*rli[r]);}
    asm volatile("s_waitcnt lgkmcnt(0)":::"memory");
    #pragma unroll
    for(int i=0;i<4;++i){const int row=i*8+(lane>>3),ch=lane&7; const u32x4 v=*(const u32x4*)(stg+row*64+ch*8); ATTN_STORE16(Ow+(long)row*DM+ch*8,v);} }
  asm volatile("s_waitcnt lgkmcnt(0)\n\ts_barrier":::"memory");
  #undef DMA_K
  #undef DMA_V
  #undef CMASK
  #undef START
  #undef RESC
  #undef ROT
}
constexpr int ATTN_LDS_BYTES=LDS_BYTES;
struct AttnTensors { const bf16* Q; const bf16* K; const bf16* V; bf16* O; };
struct AttnUnit { int bh; int qb; };
#undef BIASINIT
#undef SBAR
#undef WAIT_BAR
}
namespace cg = cooperative_groups;
constexpr int NWAVES = 8;
constexpr int BATCH = 4, SEQ = 4096, D = 1024, M = BATCH * SEQ, FF = 4096, DEPTH = 4, NIN = 3072, WIN_LD = 3088;
constexpr int N_PHASES = 26;
#ifndef PROBE_DUP
#define PROBE_DUP -1
#endif
#ifndef PROBE_AMP
#define PROBE_AMP 0u
#endif
#define AMP(p) (((PROBE_AMP) >> (p)) & 1u)
#ifndef MK_ONE_LAUNCH
#define MK_ONE_LAUNCH 1
#endif
constexpr size_t MiB = 1u << 20;
constexpr size_t WS_SSQ = 0;
constexpr size_t WS_SMALL = 1 * MiB;
constexpr size_t WS_BAR = 3 * MiB, BAR_ZERO_BYTES = 16384;
constexpr size_t WS_EB = 2 * MiB;
constexpr size_t WS_W = 4 * MiB, W_STRIDE = 25 * MiB;
constexpr size_t W_IN = 0, W_SM = 6 * MiB, W_O = 7 * MiB, W_UP = 9 * MiB, W_DN = 17 * MiB;
constexpr size_t WS_HB = 54 * MiB;
constexpr size_t WS_Q = 86 * MiB, WS_K = 118 * MiB, WS_V = 150 * MiB, WS_LS = 182 * MiB;
constexpr size_t WS_U = 86 * MiB;
constexpr size_t WS_CKLG = 246 * MiB;
constexpr size_t WS_END = 247 * MiB;
constexpr int NORM_WORD0 = 3584;
constexpr int LDS_BYTES = 147456;
constexpr int CKL_OFF = 86016;
static_assert(attn_body::ATTN_LDS_BYTES <= CKL_OFF && CKL_OFF + 16384 <= 131072, "LDS map");

#define LAS __attribute__((address_space(3)))
typedef unsigned short bf16;
typedef unsigned v4u __attribute__((ext_vector_type(4)));
typedef unsigned v2u __attribute__((ext_vector_type(2)));
typedef float f32x4 __attribute__((ext_vector_type(4)));
typedef short bf16x8 __attribute__((ext_vector_type(8)));
#define LDS_WAIT() asm volatile("s_waitcnt lgkmcnt(0)" ::: "memory")
__device__ __forceinline__ unsigned pk2(float lo, float hi) { return pg8::cvt_pk_bf16(lo, hi); }
__device__ __forceinline__ float bf2f(unsigned short v) { return __uint_as_float((unsigned)v << 16); }
__device__ __forceinline__ float bflo(unsigned w) { return __uint_as_float(w << 16); }
__device__ __forceinline__ float bfhi(unsigned w) { return __uint_as_float(w & 0xffff0000u); }
__device__ __forceinline__ float log_sigmoid(float x) { return __builtin_fminf(x, 0.f) - __logf(1.0f + __expf(-__builtin_fabsf(x))); }
__device__ __forceinline__ float wave_sum(float v) {
#pragma unroll
    for (int o = 1; o < 64; o <<= 1) v += __shfl_xor(v, o);
    return v;
}

#define XB_TMO      128
#define XB_XCNT(j)  (256  + 64 * (j))
#define XB_XSUB(j)  (1280 + 64 * (j))
#define XB_XGEN(j)  (2304 + 64 * (j))
#define XB_TOP      3328
#define XB_TOPGEN   3392
#define XCD_BAR_WORDS 3456
#define XB_SPIN_CAP (1u << 18)

__device__ __forceinline__ unsigned xb_ld(unsigned* p)              { return __hip_atomic_load(p, __ATOMIC_RELAXED, __HIP_MEMORY_SCOPE_AGENT); }
__device__ __forceinline__ unsigned xb_add(unsigned* p, unsigned v) { return __hip_atomic_fetch_add(p, v, __ATOMIC_RELAXED, __HIP_MEMORY_SCOPE_AGENT); }
__device__ __forceinline__ unsigned xb_xcc_id() { return (unsigned)__builtin_amdgcn_s_getreg((3 << 11) | 20) & 0xFu; }
#define XB_SPIN(cond, bar) do { unsigned _sp = 0; while (cond) { __builtin_amdgcn_s_sleep(1); \
    if ((++_sp & 255u) == 0u) { if (xb_ld(&(bar)[XB_TMO])) break; if (_sp > XB_SPIN_CAP) { atomicAdd(&(bar)[XB_TMO], 1u); break; } } } } while (0)

struct XcdBarrier {
    unsigned* bar; unsigned x;
    volatile LAS unsigned* st;
};

__device__ __forceinline__ XcdBarrier xcd_barrier_post(unsigned* bar, volatile LAS unsigned* st) {
    XcdBarrier b; b.bar = bar; b.x = xb_xcc_id(); b.st = st;
    if (threadIdx.x == 0) (void)xb_add(&bar[XB_XCNT(b.x)], 1u);
    return b;
}
__device__ __forceinline__ void xcd_barrier_complete(unsigned* bar, unsigned x, unsigned& nloc, unsigned& nx) {
    const unsigned G = gridDim.x * gridDim.y * gridDim.z;
    unsigned sum, cnt, mine, sp = 0u;
    for (;;) {
        sum = 0u; cnt = 0u; mine = 0u;
#pragma unroll
        for (unsigned j = 0; j < 16; ++j) { const unsigned c = xb_ld(&bar[XB_XCNT(j)]); sum += c; cnt += (c > 0u) ? 1u : 0u; mine = (j == x) ? c : mine; }
        if (sum == G) break;
        __builtin_amdgcn_s_sleep(1);
        if ((++sp & 255u) == 0u) { if (xb_ld(&bar[XB_TMO])) break; if (sp > XB_SPIN_CAP) { atomicAdd(&bar[XB_TMO], 1u); break; } }
    }
    nloc = mine > 0u ? mine : 1u; nx = cnt > 0u ? cnt : 1u;
}

__device__ __forceinline__ void xcd_barrier(const XcdBarrier& b) {
    asm volatile("s_waitcnt vmcnt(0)" ::: "memory");
    __syncthreads();
    if (threadIdx.x == 0) {
        unsigned* bar = b.bar;
        __builtin_amdgcn_s_waitcnt(0);
        unsigned nloc = b.st[0], nx = b.st[1];
        if (nloc == 0u) { xcd_barrier_complete(bar, b.x, nloc, nx); b.st[0] = nloc; b.st[1] = nx; }
        const unsigned old = xb_add(&bar[XB_XSUB(b.x)], 1u);
        const unsigned gen = old / nloc;
        if (old + 1u == (gen + 1u) * nloc) {
            __builtin_amdgcn_fence(__ATOMIC_RELEASE, "agent");
            asm volatile("s_waitcnt vmcnt(0)" ::: "memory");
            const unsigned og = xb_add(&bar[XB_TOP], 1u);
            const unsigned tg = og / nx;
            if (og + 1u == (tg + 1u) * nx) xb_add(&bar[XB_TOPGEN], 1u);
            else XB_SPIN(xb_ld(&bar[XB_TOPGEN]) == tg, bar);
            __builtin_amdgcn_fence(__ATOMIC_ACQUIRE, "agent");
            xb_add(&bar[XB_XGEN(b.x)], 1u);
            asm volatile("s_waitcnt vmcnt(0)" ::: "memory");
        } else {
            XB_SPIN(xb_ld(&bar[XB_XGEN(b.x)]) == gen, bar);
            __builtin_amdgcn_fence(__ATOMIC_ACQUIRE, "agent");
            asm volatile("s_waitcnt vmcnt(0)" ::: "memory");
        }
    }
    __syncthreads();
}

struct Args { const float* in[14]; float* out; unsigned char* ws; int ph_lo, ph_hi; };

constexpr int TR_LD = 65, TR_BYTES = 64 * TR_LD * 4;
__device__ __forceinline__ void transpose_item(const float* W, int ldw, int src_col0, const float* gain, bf16* WT, int K, int dst_row0, int nblk, LAS float* scr, int item, int lane, bool blk = false) {
    const int kb = item / nblk, nb = item % nblk, k0 = 64 * kb, n0 = 64 * nb;
#pragma unroll 8
    for (int i = 0; i < 16; ++i) { const int kk = 4 * i + (lane >> 4), c4 = lane & 15; f32x4 w = *(const f32x4*)(W + (size_t)(k0 + kk) * ldw + src_col0 + n0 + 4 * c4); if (gain) w = w * gain[k0 + kk];
        LAS float* d = scr + kk * TR_LD + 4 * c4; d[0] = w[0]; d[1] = w[1]; d[2] = w[2]; d[3] = w[3]; }
    LDS_WAIT(); asm volatile("" ::: "memory");
    const int c = lane & 7;
#pragma unroll
    for (int j = 0; j < 8; ++j) { const int n = (lane >> 3) + 8 * j; const LAS float* s = scr + (8 * c) * TR_LD + n;
        v4u o; o.x = pk2(s[0 * TR_LD], s[1 * TR_LD]); o.y = pk2(s[2 * TR_LD], s[3 * TR_LD]); o.z = pk2(s[4 * TR_LD], s[5 * TR_LD]); o.w = pk2(s[6 * TR_LD], s[7 * TR_LD]);
        const int ng = dst_row0 + n0 + n;
        *(v4u*)(WT + (blk ? ((size_t)((ng >> 8) * (K >> 6) + (k0 >> 6)) * 256 + (ng & 255)) * 64 + 8 * c : (size_t)ng * K + k0 + 8 * c)) = o; }
    LDS_WAIT(); asm volatile("" ::: "memory");
}

__device__ __forceinline__ void convert_layer_weights(const Args& a, int L, LAS unsigned char* lds, int gw, int NGW, int wave, int lane, int rot = 0) {
    LAS float* scr = (LAS float*)(lds + wave * TR_BYTES);
    unsigned char* wb = a.ws + WS_W + (size_t)(L & 1) * W_STRIDE;
    const int j = L >> 1; const bool fox = (L & 1) == 0;
    const float* Win = (fox ? a.in[1] : a.in[4]) + (size_t)j * D * WIN_LD;
    const float* Wo = (fox ? a.in[3] : a.in[8]) + (size_t)j * D * D;
    const float* Wup = a.in[9] + (size_t)L * D * FF; const float* Wdn = a.in[10] + (size_t)L * FF * D;
    const float* gmix = a.in[11] + L * D; const float* gmlp = a.in[12] + L * D;
    const int colB = fox ? 2048 : 2064, colS = fox ? 3072 : 2048;
    constexpr int I_A = 16 * 32, I_B = 16 * 16, I_O = 16 * 16, I_U = 16 * 64, I_D = 64 * 16, NITEMS = I_A + I_B + I_O + I_U + I_D;
    for (int it = (gw + rot) % NGW; it < NITEMS; it += NGW) {
        int r = it;
        if (r < I_A) { transpose_item(Win, WIN_LD, 0, gmix, (bf16*)(wb + W_IN), D, 0, 32, scr, r, lane); continue; } r -= I_A;
        if (r < I_B) { transpose_item(Win, WIN_LD, colB, gmix, (bf16*)(wb + W_IN), D, 2048, 16, scr, r, lane); continue; } r -= I_B;
        if (r < I_O) { transpose_item(Wo, D, 0, nullptr, (bf16*)(wb + W_O), D, 0, 16, scr, r, lane); continue; } r -= I_O;
        if (r < I_U) { transpose_item(Wup, FF, 0, gmlp, (bf16*)(wb + W_UP), D, 0, 64, scr, r, lane); continue; } r -= I_U;
        transpose_item(Wdn, D, 0, nullptr, (bf16*)(wb + W_DN), FF, 0, 16, scr, r, lane, true);
    }
    bf16* wsm = (bf16*)(wb + W_SM);
    for (int e = gw * 64 + lane; e < 16 * D; e += NGW * 64) { const int k = e >> 4, n = e & 15; wsm[n * D + k] = (bf16)(pk2(Win[(size_t)k * WIN_LD + colS + n] * gmix[k], 0.f) & 0xffffu); }
}

namespace gla {
constexpr int H = 4, DK = 128, DV = 256, C = 64, NCH = SEQ / C;
constexpr int VT_LD = 72, KT_LD = 72, QT_LD = 136;
__device__ __forceinline__ f32x4 mfma16(bf16x8 a, bf16x8 b, f32x4 c) { return __builtin_amdgcn_mfma_f32_16x16x32_bf16(a, b, c, 0, 0, 0); }
__device__ __forceinline__ void stage_vT(const bf16* vsrc, LAS bf16* VT, int tid) {
#pragma unroll
    for (int c = 0; c < 2; ++c) { const int item = tid + 512 * c, rest = item >> 6, tp = (rest & 1) * 16 + (item & 15), d8 = (rest >> 1) * 4 + ((item >> 4) & 3);
        const v4u w0 = *(const v4u*)(vsrc + (size_t)(2 * tp) * 1024 + d8 * 8), w1 = *(const v4u*)(vsrc + (size_t)(2 * tp + 1) * 1024 + d8 * 8);
        LAS unsigned* p = (LAS unsigned*)(VT + (d8 * 8) * VT_LD + 2 * tp);
        p[0 * (VT_LD / 2)] = (w0.x & 0xffffu) | (w1.x << 16); p[1 * (VT_LD / 2)] = (w0.x >> 16) | (w1.x & 0xffff0000u);
        p[2 * (VT_LD / 2)] = (w0.y & 0xffffu) | (w1.y << 16); p[3 * (VT_LD / 2)] = (w0.y >> 16) | (w1.y & 0xffff0000u);
        p[4 * (VT_LD / 2)] = (w0.z & 0xffffu) | (w1.z << 16); p[5 * (VT_LD / 2)] = (w0.z >> 16) | (w1.z & 0xffff0000u);
        p[6 * (VT_LD / 2)] = (w0.w & 0xffffu) | (w1.w << 16); p[7 * (VT_LD / 2)] = (w0.w >> 16) | (w1.w & 0xffff0000u); }
}
__device__ __forceinline__ void g1_unit(int u, const bf16* QK, bf16* QKout, const bf16* V, const float* zlr, const float* wg, const float* bg, bf16* LS, float* EB, LAS unsigned char* lds, int tid, int wave, int lane) {
    const int b = u >> 8, j = (u >> 2) & 63, h = u & 3, lsid = (b * 4 + h) * 64 + j; const size_t tok0 = (size_t)b * SEQ + 64 * j;
    LAS bf16* KT = (LAS bf16*)lds; LAS bf16* VT = (LAS bf16*)(lds + 18432); LAS float* ZL = (LAS float*)(lds + 55296); LAS float* TOT = (LAS float*)(lds + 59392); LAS float* EBL = (LAS float*)(lds + 67584);
    const int d4 = tid & 31, tg = tid >> 5;
    const bf16* qp = QK + (tok0 + 4 * tg) * 1024 + h * 128 + 4 * d4; bf16* qo = QKout + (tok0 + 4 * tg) * 1024 + h * 128 + 4 * d4;
    v2u qin[4], kin[4];
#pragma unroll
    for (int i = 0; i < 4; ++i) { qin[i] = *(const v2u*)(qp + (size_t)i * 1024); kin[i] = *(const v2u*)(qp + (size_t)i * 1024 + 512); }
    f32x4 w[16];
#pragma unroll
    for (int r = 0; r < 16; ++r) w[r] = *(const f32x4*)(wg + r * 512 + h * 128 + 4 * d4);
    const f32x4 bgd = *(const f32x4*)(bg + h * 128 + 4 * d4);
    if (tid < 256) ((LAS f32x4*)ZL)[tid] = ((const f32x4*)(zlr + tok0 * 16))[tid];
    stage_vT(V + tok0 * 1024 + h * 256, VT, tid);
    __syncthreads();
    f32x4 bc[4]; f32x4 run = (f32x4){0.f, 0.f, 0.f, 0.f};
#pragma unroll
    for (int i = 0; i < 4; ++i) { const int t = 4 * tg + i; f32x4 z = bgd;
#pragma unroll
        for (int r4 = 0; r4 < 4; ++r4) { const f32x4 zz = ((const LAS f32x4*)ZL)[t * 4 + r4]; z += zz[0] * w[4 * r4] + zz[1] * w[4 * r4 + 1] + zz[2] * w[4 * r4 + 2] + zz[3] * w[4 * r4 + 3]; }
#pragma unroll
        for (int e = 0; e < 4; ++e) run[e] += log_sigmoid(z[e]) * (1.0f / 16.0f);
        bc[i] = run; }
    *(LAS f32x4*)(TOT + tg * 128 + 4 * d4) = run;
    __syncthreads();
    f32x4 pre = (f32x4){0.f, 0.f, 0.f, 0.f}, blast = (f32x4){0.f, 0.f, 0.f, 0.f};
#pragma unroll
    for (int q = 0; q < 16; ++q) { const f32x4 tv = *(const LAS f32x4*)(TOT + q * 128 + 4 * d4); if (q < tg) pre += tv; blast += tv; }
    if (tg == 0) { f32x4 eb; eb[0] = __expf(blast[0]); eb[1] = __expf(blast[1]); eb[2] = __expf(blast[2]); eb[3] = __expf(blast[3]);
        *(f32x4*)(EB + (size_t)lsid * 128 + 4 * d4) = eb; *(LAS f32x4*)(EBL + 4 * d4) = eb; }
    float kt[4][4];
#pragma unroll
    for (int i = 0; i < 4; ++i) { const f32x4 bb = bc[i] + pre; float qv[4] = {bflo(qin[i].x), bfhi(qin[i].x), bflo(qin[i].y), bfhi(qin[i].y)}; float kv[4] = {bflo(kin[i].x), bfhi(kin[i].x), bflo(kin[i].y), bfhi(kin[i].y)}; float qt[4];
#pragma unroll
        for (int e = 0; e < 4; ++e) { const float eb = __expf(bb[e]); qt[e] = qv[e] * eb * 0.08838834764831845f; kt[i][e] = kv[e] * __builtin_amdgcn_rcpf(eb); }
        v2u oq; oq.x = pk2(qt[0], qt[1]); oq.y = pk2(qt[2], qt[3]); *(v2u*)(qo + (size_t)i * 1024) = oq;
        v2u ok; ok.x = pk2(kt[i][0], kt[i][1]); ok.y = pk2(kt[i][2], kt[i][3]); *(v2u*)(qo + (size_t)i * 1024 + 512) = ok; }
#pragma unroll
    for (int e = 0; e < 4; ++e) { v2u o; o.x = pk2(kt[0][e], kt[1][e]); o.y = pk2(kt[2][e], kt[3][e]); *(LAS v2u*)(KT + (4 * d4 + e) * KT_LD + 4 * tg) = o; }
    __syncthreads();
    const int fr = lane & 15, fq = lane >> 4;
    f32x4 acc[2][8];
#pragma unroll
    for (int mt = 0; mt < 2; ++mt)
#pragma unroll
        for (int nt = 0; nt < 8; ++nt) acc[mt][nt] = (f32x4){0.f, 0.f, 0.f, 0.f};
#pragma unroll
    for (int ks = 0; ks < 2; ++ks) { bf16x8 vf[2];
#pragma unroll
        for (int mt = 0; mt < 2; ++mt) vf[mt] = *(const LAS bf16x8*)(VT + (32 * wave + 16 * mt + fr) * VT_LD + ks * 32 + fq * 8);
#pragma unroll
        for (int nt = 0; nt < 8; ++nt) { const bf16x8 kf = *(const LAS bf16x8*)(KT + (16 * nt + fr) * KT_LD + ks * 32 + fq * 8);
#pragma unroll
            for (int mt = 0; mt < 2; ++mt) acc[mt][nt] = mfma16(kf, vf[mt], acc[mt][nt]); } }
    bf16* lsp = LS + (size_t)lsid * 32768;
#pragma unroll
    for (int nt = 0; nt < 8; ++nt) { const f32x4 e4 = *(const LAS f32x4*)(EBL + 16 * nt + 4 * fq);
#pragma unroll
        for (int mt = 0; mt < 2; ++mt) { const f32x4 v = acc[mt][nt] * e4; v2u o; o.x = pk2(v[0], v[1]); o.y = pk2(v[2], v[3]);
            *(v2u*)(lsp + (size_t)(32 * wave + 16 * mt + fr) * 128 + 16 * nt + 4 * fq) = o; } }
    __syncthreads();
}
template <bool DUMMY> __device__ __forceinline__ void g2_scan(const bf16* LS, bf16* OUT, const float* EB, int gtid, int nthreads) {
    for (int e = gtid; e < 16 * 8192; e += nthreads) { const int bh = e >> 13, off = (e & 8191) * 4;
        const bf16* base = LS + (size_t)bh * 64 * 32768 + off; bf16* obase = OUT + (DUMMY ? ((size_t)(bh & 7) * 64 * 32768 + off) : ((size_t)bh * 64 * 32768 + off)); const float* ebp = EB + (size_t)bh * 64 * 128 + (off & 127);
        f32x4 S = (f32x4){0.f, 0.f, 0.f, 0.f};
#pragma unroll 9
        for (int j = 0; j < 63; ++j) { const v2u l = *(const v2u*)(base + (size_t)j * 32768); const f32x4 a = *(const f32x4*)(ebp + j * 128);
            S[0] = a[0] * S[0] + bflo(l.x); S[1] = a[1] * S[1] + bfhi(l.x); S[2] = a[2] * S[2] + bflo(l.y); S[3] = a[3] * S[3] + bfhi(l.y);
            v2u o; o.x = pk2(S[0], S[1]); o.y = pk2(S[2], S[3]); *(v2u*)(obase + (size_t)j * 32768) = o; } }
}
__device__ __forceinline__ void g3_unit(int u, const bf16* QK, const bf16* V, const bf16* R, bf16* Rout, const bf16* LS, const float* gnorm, LAS unsigned char* lds, int tid, int wave, int lane) {
    const int b = u >> 8, j = (u >> 2) & 63, h = u & 3, lsid = (b * 4 + h) * 64 + j; const size_t tok0 = (size_t)b * SEQ + 64 * j;
    LAS bf16* QT = (LAS bf16*)lds; LAS bf16* KT = (LAS bf16*)(lds + 17408); LAS bf16* VT = (LAS bf16*)(lds + 34816); LAS bf16* AT = (LAS bf16*)(lds + 71680); LAS float* RS = (LAS float*)(lds + 80896);
#pragma unroll
    for (int c = 0; c < 2; ++c) { const int idx = tid + 512 * c, t = idx >> 4, c8 = idx & 15; const bf16* src = QK + (tok0 + t) * 1024 + h * 128 + c8 * 8;
        *(LAS v4u*)(QT + t * QT_LD + c8 * 8) = *(const v4u*)src; *(LAS v4u*)(KT + t * QT_LD + c8 * 8) = *(const v4u*)(src + 512); }
    const int fr = lane & 15, fq = lane >> 4, tm = wave >> 1, hh = wave & 1;
    bf16x8 sf[4][8];
    if (j > 0) { const bf16* sp = LS + (size_t)(lsid - 1) * 32768 + (size_t)(128 * hh + fr) * 128 + fq * 8;
#pragma unroll
        for (int ks = 0; ks < 4; ++ks)
#pragma unroll
            for (int nt = 0; nt < 8; ++nt) sf[ks][nt] = *(const bf16x8*)(sp + (size_t)nt * 16 * 128 + ks * 32); }
    const size_t roff = (tok0 + 16 * tm + fr) * 1024 + h * 256 + 128 * hh + 4 * fq; const bf16* rp = R + roff; bf16* ro = Rout + roff;
    v2u rin[8];
#pragma unroll
    for (int nt = 0; nt < 8; ++nt) rin[nt] = *(const v2u*)(rp + 16 * nt);
    stage_vT(V + tok0 * 1024 + h * 256, VT, tid);
    __syncthreads();
#pragma unroll
    for (int e = 0; e < 2; ++e) { const int sn = 2 * hh + e; f32x4 a = (f32x4){0.f, 0.f, 0.f, 0.f};
        if (sn <= tm) {
#pragma unroll
            for (int ks = 0; ks < 4; ++ks) { const bf16x8 qf = *(const LAS bf16x8*)(QT + (16 * tm + fr) * QT_LD + ks * 32 + fq * 8); const bf16x8 kf = *(const LAS bf16x8*)(KT + (16 * sn + fr) * QT_LD + ks * 32 + fq * 8);
                a = mfma16(kf, qf, a); }
#pragma unroll
            for (int i = 0; i < 4; ++i) if (16 * sn + 4 * fq + i > 16 * tm + fr) a[i] = 0.f; }
        v2u o; o.x = pk2(a[0], a[1]); o.y = pk2(a[2], a[3]); *(LAS v2u*)(AT + (16 * tm + fr) * VT_LD + 16 * sn + 4 * fq) = o; }
    __syncthreads();
    f32x4 acc[8];
#pragma unroll
    for (int nt = 0; nt < 8; ++nt) acc[nt] = (f32x4){0.f, 0.f, 0.f, 0.f};
#pragma unroll
    for (int ks = 0; ks < 2; ++ks) { const bf16x8 af = *(const LAS bf16x8*)(AT + (16 * tm + fr) * VT_LD + ks * 32 + fq * 8);
#pragma unroll
        for (int nt = 0; nt < 8; ++nt) { const bf16x8 vf = *(const LAS bf16x8*)(VT + (128 * hh + 16 * nt + fr) * VT_LD + ks * 32 + fq * 8); acc[nt] = mfma16(vf, af, acc[nt]); } }
    if (j > 0) {
#pragma unroll
        for (int ks = 0; ks < 4; ++ks) { const bf16x8 qf = *(const LAS bf16x8*)(QT + (16 * tm + fr) * QT_LD + ks * 32 + fq * 8);
#pragma unroll
            for (int nt = 0; nt < 8; ++nt) acc[nt] = mfma16(sf[ks][nt], qf, acc[nt]); } }
    float ss = 0.f;
#pragma unroll
    for (int nt = 0; nt < 8; ++nt) ss += (acc[nt][0] * acc[nt][0] + acc[nt][1] * acc[nt][1]) + (acc[nt][2] * acc[nt][2] + acc[nt][3] * acc[nt][3]);
    ss += __shfl_xor(ss, 16); ss += __shfl_xor(ss, 32);
    if (fq == 0) RS[(16 * tm + fr) * 2 + hh] = ss;
    __syncthreads();
    const float rinv = __builtin_amdgcn_rsqf((RS[(16 * tm + fr) * 2] + RS[(16 * tm + fr) * 2 + 1]) * (1.0f / 256.0f) + 1e-6f);
#pragma unroll
    for (int nt = 0; nt < 8; ++nt) { const f32x4 gn = *(const f32x4*)(gnorm + 128 * hh + 16 * nt + 4 * fq); const v2u rw = rin[nt];
        const float r0 = bflo(rw.x), r1 = bfhi(rw.x), r2 = bflo(rw.y), r3 = bfhi(rw.y);
        const float o0 = acc[nt][0] * rinv * gn[0] * r0 * __builtin_amdgcn_rcpf(1.f + __expf(-r0)), o1 = acc[nt][1] * rinv * gn[1] * r1 * __builtin_amdgcn_rcpf(1.f + __expf(-r1));
        const float o2 = acc[nt][2] * rinv * gn[2] * r2 * __builtin_amdgcn_rcpf(1.f + __expf(-r2)), o3 = acc[nt][3] * rinv * gn[3] * r3 * __builtin_amdgcn_rcpf(1.f + __expf(-r3));
        v2u o; o.x = pk2(o0, o1); o.y = pk2(o2, o3); *(v2u*)(ro + 16 * nt) = o; }
    __syncthreads();
}
}

#define SEAM() do { if (ph + 1 < hi) { if (hi > 1000) grid.sync(); else xcd_barrier(bar); if (AMP(ph)) { const unsigned long long t1_ = __builtin_amdgcn_s_memrealtime(); while (__builtin_amdgcn_s_memrealtime() < t1_ + 3ull * (t1_ - t0_)) __builtin_amdgcn_s_sleep(8); xcd_barrier(bar); } } } while (0)
template <int L> __device__ __forceinline__ void run_layer(const Args& args, cg::grid_group& grid, const XcdBarrier& bar, LAS unsigned char* lds, unsigned char* lds_raw, int lo, int hi) {
    const int G = gridDim.x, bx = blockIdx.x, vcu = (G % 8 == 0) ? (bx % 8) * (G / 8) + bx / 8 : bx, NGW = G * NWAVES;
    unsigned char* ws = args.ws;
    float* ssqp = (float*)(ws + WS_SSQ); float* smallb = (float*)(ws + WS_SMALL); float* EB = (float*)(ws + WS_EB);
    bf16* HB = (bf16*)(ws + WS_HB); bf16* QB = (bf16*)(ws + WS_Q); bf16* KB = (bf16*)(ws + WS_K); bf16* VB = (bf16*)(ws + WS_V); bf16* LS = (bf16*)(ws + WS_LS); bf16* UB = (bf16*)(ws + WS_U);
    int ph = 1 + (L / 2) * 12 + (L % 2) * 5;
#define THREAD_VARS() const unsigned long long t0_ = AMP(ph) ? __builtin_amdgcn_s_memrealtime() : 0ull; (void)t0_; int tid = threadIdx.x; asm volatile("" : "+v"(tid)); const int lane = tid & 63, wave = __builtin_amdgcn_readfirstlane(tid >> 6), gw = vcu * NWAVES + wave; (void)lane; (void)gw

        const bool fox = (L & 1) == 0; const int jl = L >> 1;
        unsigned char* wb = ws + WS_W + (size_t)(L & 1) * W_STRIDE;
        if (ph >= lo && ph < hi) { THREAD_VARS();
            if (L == 1 || L == 2) { convert_layer_weights(args, L + 1, lds, gw, NGW, wave, lane); __syncthreads(); }
            const pg8::Gemm g = pg8::make_gemm(HB, (const bf16*)(wb + W_IN), M, NIN, D, false, false); pg8::StaticOrder S; S.init(M, NIN, G, bx);
            pg8::EpiScaleBf16<0> E{QB, D, ssqp, D, (size_t)(WS_K - WS_Q) / 2, fox ? attn_body::C2 : 1.0f, fox ? (unsigned*)(ws + WS_BAR) + NORM_WORD0 + jl * 128 : nullptr};
            for (int rep_ = 0; rep_ < (ph == PROBE_DUP ? 2 : 1); ++rep_)
            pg8::gemm_phase<pg8::EpiScaleBf16<0>, pg8::StaticOrder, PG8_ALIGN, PG8_SP2>(lds, g, S, E);
            { const bf16* wsm = (const bf16*)(wb + W_SM); const int fr = lane & 15, fq = lane >> 4, half = wave & 1;
              LAS bf16* WL = (LAS bf16*)lds; LAS f32x4* RED = (LAS f32x4*)(lds + 40960);
              for (int idx = tid; idx < 16 * 128; idx += NWAVES * 64) { const int n = idx >> 7, c8 = idx & 127; *(LAS v4u*)(WL + n * 1032 + c8 * 8) = *(const v4u*)(wsm + n * D + c8 * 8); }
              __syncthreads();
              for (int rep_ = 0; rep_ < (100 + ph == PROBE_DUP ? 2 : 1); ++rep_)
              for (int tb = 0; tb < M / 16; tb += NGW / 2) { const int task = tb + (gw >> 1); const bool live = task < M / 16; const int row = (live ? task : 0) * 16 + fr;
                  const bf16* ap = HB + (size_t)row * D + half * 512 + fq * 8; bf16x8 av[16];
#pragma unroll
                  for (int s = 0; s < 16; ++s) av[s] = *(const bf16x8*)(ap + s * 32);
                  f32x4 acc = (f32x4){0.f, 0.f, 0.f, 0.f};
#pragma unroll
                  for (int s = 0; s < 16; ++s) { const bf16x8 bv = *(const LAS bf16x8*)(WL + fr * 1032 + half * 512 + s * 32 + fq * 8); acc = __builtin_amdgcn_mfma_f32_16x16x32_bf16(bv, av[s], acc, 0, 0, 0); }
                  if (half) RED[(wave >> 1) * 64 + lane] = acc;
                  __syncthreads();
                  if (!half && live) { acc += RED[(wave >> 1) * 64 + lane]; const float rs = pg8::row_rstd(ssqp, row); *(f32x4*)(smallb + (size_t)row * 16 + 4 * fq) = acc * rs; }
                  __syncthreads(); } }
            SEAM();
        }
        ++ph;
        if (fox) {
            if (ph >= lo && ph < hi) { THREAD_VARS();
                LAS float* ckl = (LAS float*)(lds + CKL_OFF); LAS float* wtot = (LAS float*)(lds + CKL_OFF + 16384);
                LAS float* red = wtot + 16; LAS int* sch = (LAS int*)(wtot + 64); LAS int* nh = (LAS int*)(wtot + 96); LAS int* cost = (LAS int*)(wtot + 112); LAS float* smh = wtot + 128;
                LAS float* cq = wtot + 256; LAS float* ce = wtot + 512; LAS int* T0 = (LAS int*)(wtot + 1536);
                const float* bf_ = args.in[2] + jl * 16;
                float* CKLG = (float*)(ws + WS_CKLG); unsigned* NORMS = (unsigned*)(ws + WS_BAR) + NORM_WORD0 + jl * 128;
                for (int rep_ = 0; rep_ < (ph == PROBE_DUP ? 2 : 1); ++rep_) {
                for (int w = vcu; w < 256; w += G) { const int bh = w >> 2, part = w & 3, b = bh >> 4, h = bh & 15;
                    __syncthreads();
                    { const float bfh = bf_[h]; const float* fp = smallb + ((size_t)b * SEQ + 8 * tid) * 16 + h; float v[8]; float run = 0.f;
#pragma unroll
                        for (int i = 0; i < 8; ++i) { run += log_sigmoid(fp[i * 16] + bfh); v[i] = run; }
                        float tot = run;
#pragma unroll
                        for (int o = 1; o < 64; o <<= 1) { const float t = __shfl_up(tot, o); if (lane >= o) tot += t; }
                        if (lane == 63) wtot[wave] = tot;
                        __syncthreads();
                        float basev = tot - run;
                        for (int w2 = 0; w2 < wave; ++w2) basev += wtot[w2];
                        if ((tid >> 7) == part) {
#pragma unroll
                            for (int i = 0; i < 8; i += 4) *(f32x4*)(CKLG + (size_t)bh * SEQ + 8 * tid + i) = (f32x4){(basev + v[i]) * 1.4426950408889634f, (basev + v[i + 1]) * 1.4426950408889634f, (basev + v[i + 2]) * 1.4426950408889634f, (basev + v[i + 3]) * 1.4426950408889634f}; } }
                    }
                xcd_barrier(bar);
                for (int w = vcu; w < 256; w += G) { const int b = w >> 6, i64 = w & 63;
                    __syncthreads();
                    for (int e = tid; e < 16 * 80; e += NWAVES * 64) { const int hh = e / 80, r = e % 80; const float* src = CKLG + (size_t)(b * 16 + hh) * SEQ;
                        if (r < 16) cq[hh * 16 + r] = src[256 * r]; else ce[hh * 64 + (r - 16)] = src[64 * (r - 16) + 63]; }
                    if (tid < 16) { const unsigned kb = __hip_atomic_load(NORMS + 2 * (b * 16 + tid), __ATOMIC_RELAXED, __HIP_MEMORY_SCOPE_AGENT), qb2 = __hip_atomic_load(NORMS + 2 * (b * 16 + tid) + 1, __ATOMIC_RELAXED, __HIP_MEMORY_SCOPE_AGENT);
                        smh[tid] = __builtin_sqrtf(__uint_as_float(kb) * __uint_as_float(qb2)) * 1.01f + 0.5f; }
                    __syncthreads();
#pragma nounroll
                    for (int k = 0; k < 2; ++k) { const int hh = 2 * wave + k; const float sm = smh[hh]; int c = 0;
                        for (int qb = 0; qb < 16; ++qb) { const bool dead = (lane < 4 * qb) && (sm + cq[hh * 16 + qb] - ce[hh * 64 + lane] < -152.0f);
                            const int t0 = __builtin_popcountll(__ballot(dead)) & ~1; c += 4 * qb + 4 - t0 + 6;
                            if (lane == 0) T0[hh * 16 + qb] = t0; }
                        if (lane == 0) cost[hh] = c; }
                    __syncthreads();
                    if (tid == 0) { int total = 0; for (int hh = 0; hh < 16; ++hh) total += cost[hh];
                        const float ideal = (float)total * (1.f / 64.f); int sum = 0;
                        for (int hh = 0; hh < 16; ++hh) { int n = (int)((float)cost[hh] / ideal + 0.5f); n = min(max(n, 1), 16); nh[hh] = n; sum += n; }
                        while (sum > 64) { int best = 0; float bv = 1e30f; for (int hh = 0; hh < 16; ++hh) if (nh[hh] > 1) { const float v = (float)cost[hh] / (float)nh[hh]; if (v < bv) { bv = v; best = hh; } } nh[best] -= 1; --sum; }
                        while (sum < 64) { int best = 0; float bv = -1.f; for (int hh = 0; hh < 16; ++hh) if (nh[hh] < 16) { const float v = (float)cost[hh] / (float)nh[hh]; if (v > bv) { bv = v; best = hh; } } nh[best] += 1; ++sum; }
                        int acc = 0, myh = 15, slot = 0;
                        for (int hh = 0; hh < 16; ++hh) { if (i64 < acc + nh[hh]) { myh = hh; slot = i64 - acc; break; } acc += nh[hh]; }
                        const int nbins = nh[myh]; int mask = 0;
                        for (int k = 0; k < 16; ++k) sch[16 + k] = 0;
                        for (int qb = 15; qb >= 0; --qb) { const int cu = 4 * qb + 4 - T0[myh * 16 + qb] + 6; int best = 0, bl = sch[16];
                            for (int k = 1; k < nbins; ++k) { const int l = sch[16 + k]; if (l < bl) { bl = l; best = k; } }
                            sch[16 + best] = bl + cu; if (best == slot) mask |= 1 << qb; }
                        sch[0] = myh; sch[1] = mask; }
                    __syncthreads();
                    const int h = sch[0], mask = sch[1];
                    { const f32x4* src = (const f32x4*)(CKLG + (size_t)(b * 16 + h) * SEQ); ((LAS f32x4*)ckl)[tid] = src[tid]; ((LAS f32x4*)ckl)[tid + 512] = src[tid + 512]; }
                    __syncthreads();
#pragma nounroll
                    for (int qb = 15; qb >= 0; --qb) { if (!((mask >> qb) & 1)) continue; const int t0 = T0[h * 16 + qb];
                        attn_body::attn_unit<8>(b, h, qb, (const attn_body::bf16*)QB, (const attn_body::bf16*)KB, (const attn_body::bf16*)VB, (attn_body::bf16*)((ph == PROBE_DUP && rep_ == 0) ? HB : QB), (char*)lds_raw, (attn_body::lds_cfptr)ckl, t0); } } }
                SEAM();
            }
            ++ph;
        } else {
            if (ph >= lo && ph < hi) { THREAD_VARS();
                for (int rep_ = 0; rep_ < (ph == PROBE_DUP ? 2 : 1); ++rep_)
                for (int u = bx; u < 1024; u += G) gla::g1_unit(u, QB, (ph == PROBE_DUP && rep_ == 0) ? HB : QB, KB, smallb, args.in[5] + (size_t)jl * 16 * 512, args.in[6] + jl * 512, LS, EB, lds, tid, wave, lane);
                SEAM();
            }
            ++ph;
            if (ph >= lo && ph < hi) { THREAD_VARS(); if (ph == PROBE_DUP) gla::g2_scan<true>(LS, HB, EB, bx * 512 + tid, G * 512); gla::g2_scan<false>(LS, LS, EB, bx * 512 + tid, G * 512); SEAM(); }
            ++ph;
            if (ph >= lo && ph < hi) { THREAD_VARS();
                for (int rep_ = 0; rep_ < (ph == PROBE_DUP ? 2 : 1); ++rep_)
                for (int u = bx; u < 1024; u += G) gla::g3_unit(u, QB, KB, VB, (ph == PROBE_DUP && rep_ == 0) ? HB : VB, LS, args.in[7] + jl * 256, lds, tid, wave, lane);
                SEAM();
            }
            ++ph;
        }
        if (ph >= lo && ph < hi) { THREAD_VARS();
            const pg8::Gemm g = pg8::make_gemm(fox ? QB : VB, (const bf16*)(wb + W_O), M, D, D, false, false); pg8::StaticOrder S; S.init(M, D, G, bx);
            pg8::EpiRes E{HB, ssqp, D};
            pg8::gemm_phase<pg8::EpiRes, pg8::StaticOrder, false, PG8_SP2>(lds, g, S, E);
            SEAM();
        }
        ++ph;
        if (ph >= lo && ph < hi) { THREAD_VARS();
            const pg8::Gemm g = pg8::make_gemm(HB, (const bf16*)(wb + W_UP), M, FF, D, false, false); pg8::StaticOrder S; S.init(M, FF, G, bx);
            pg8::EpiScaleBf16<2, true> E{UB, FF, ssqp, 0, 0, 1.f, nullptr};
            for (int rep_ = 0; rep_ < (ph == PROBE_DUP ? 2 : 1); ++rep_)
            pg8::gemm_phase<pg8::EpiScaleBf16<2, true>, pg8::StaticOrder, PG8_ALIGN, PG8_SP2>(lds, g, S, E);
            SEAM();
        }
        ++ph;
        if (ph >= lo && ph < hi) { THREAD_VARS();
            const pg8::Gemm g = pg8::make_gemm(UB, (const bf16*)(wb + W_DN), M, D, FF, true, true); pg8::StaticOrder S; S.init(M, D, G, bx);
            pg8::EpiRes E{HB, ssqp, D};
            pg8::gemm_phase<pg8::EpiRes, pg8::StaticOrder, false, PG8_SP2>(lds, g, S, E);
            SEAM();
        }
        ++ph;
    }
#undef SEAM
#undef THREAD_VARS
__global__ void __launch_bounds__(NWAVES * 64, 2) fwd_megakernel(Args args) {
    extern __shared__ __attribute__((aligned(16))) unsigned char lds_raw[];
    cg::grid_group grid = cg::this_grid();
    LAS unsigned char* lds = (LAS unsigned char*)lds_raw;
    const int tid = threadIdx.x, lane = tid & 63, wave = __builtin_amdgcn_readfirstlane(tid >> 6);
    const int G = gridDim.x, bx = blockIdx.x, vcu = (G % 8 == 0) ? (bx % 8) * (G / 8) + bx / 8 : bx;
    const int gw = vcu * NWAVES + wave, NGW = G * NWAVES;
    unsigned char* ws = args.ws;
    float* ssqp = (float*)(ws + WS_SSQ); float* smallb = (float*)(ws + WS_SMALL); float* EB = (float*)(ws + WS_EB);
    bf16* HB = (bf16*)(ws + WS_HB); bf16* QB = (bf16*)(ws + WS_Q); bf16* KB = (bf16*)(ws + WS_K); bf16* VB = (bf16*)(ws + WS_V); bf16* LS = (bf16*)(ws + WS_LS); bf16* UB = (bf16*)(ws + WS_U);
    float* Hres = args.out;
    const int lo = args.ph_lo, hi = args.ph_hi;
    int ph = 0;
    volatile LAS unsigned* bst = (volatile LAS unsigned*)(lds + LDS_BYTES - 128);
    if (tid < 2) bst[tid] = 0u;
    __syncthreads();
    const XcdBarrier bar = xcd_barrier_post((unsigned*)(ws + WS_BAR), bst);
#define SEAM() do { if (ph + 1 < hi) { if (hi > 1000) grid.sync(); else xcd_barrier(bar); if (AMP(ph)) { const unsigned long long t1_ = __builtin_amdgcn_s_memrealtime(); while (__builtin_amdgcn_s_memrealtime() < t1_ + 3ull * (t1_ - t0_)) __builtin_amdgcn_s_sleep(8); xcd_barrier(bar); } } } while (0)

    if (ph >= lo && ph < hi) {
        const unsigned long long t0_ = AMP(0) ? __builtin_amdgcn_s_memrealtime() : 0ull; (void)t0_;
        for (int rep_ = 0; rep_ < (PROBE_DUP == 0 ? 2 : 1); ++rep_) {
        convert_layer_weights(args, 0, lds, gw, NGW, wave, lane);
        convert_layer_weights(args, 1, lds, gw, NGW, wave, lane, NGW / 2);
        const float* x = args.in[0];
        for (int m = gw; m < M; m += NGW) { const f32x4* xr = (const f32x4*)(x + (size_t)m * D) + lane; f32x4 v[4]; float s = 0.f;
#pragma unroll
            for (int jj = 0; jj < 4; ++jj) { v[jj] = xr[64 * jj]; s += (v[jj][0] * v[jj][0] + v[jj][1] * v[jj][1]) + (v[jj][2] * v[jj][2] + v[jj][3] * v[jj][3]); }
            s = wave_sum(s);
            v2u* o8 = (v2u*)(HB + (size_t)m * D) + lane;
#pragma unroll
            for (int jj = 0; jj < 4; ++jj) { v2u o; o.x = pk2(v[jj][0], v[jj][1]); o.y = pk2(v[jj][2], v[jj][3]); o8[64 * jj] = o; }
            if (lane < 16) ssqp[(size_t)m * 16 + lane] = (lane == 0) ? s : 0.f; } }
        SEAM();
    }
    ++ph;

    run_layer<0>(args, grid, bar, lds, lds_raw, lo, hi); run_layer<1>(args, grid, bar, lds, lds_raw, lo, hi); run_layer<2>(args, grid, bar, lds, lds_raw, lo, hi); run_layer<3>(args, grid, bar, lds, lds_raw, lo, hi);
    ph = N_PHASES - 1;
    if (ph >= lo && ph < hi) {
        const unsigned long long t0_ = AMP(25) ? __builtin_amdgcn_s_memrealtime() : 0ull;
        const float* gf = args.in[13];
        for (int m = gw; m < M; m += NGW) { f32x4* xr = (f32x4*)(Hres + (size_t)m * D) + lane; const v2u* hr = (const v2u*)(HB + (size_t)m * D) + lane; const float rs = pg8::row_rstd(ssqp, m);
#pragma unroll
            for (int jj = 0; jj < 4; ++jj) { const f32x4 gv = ((const f32x4*)gf)[64 * jj + lane]; const v2u hv = hr[64 * jj];
                xr[64 * jj] = (f32x4){bflo(hv.x), bfhi(hv.x), bflo(hv.y), bfhi(hv.y)} * rs * gv; } }
        if (AMP(25)) { asm volatile("s_waitcnt vmcnt(0)" ::: "memory"); const unsigned long long t1_ = __builtin_amdgcn_s_memrealtime(); while (__builtin_amdgcn_s_memrealtime() < t1_ + 3ull * (t1_ - t0_)) __builtin_amdgcn_s_sleep(8); }
    }
#undef SEAM
}

extern "C" void kernel_launch(void* const* d_in, const int* in_sizes, int n_in, void* d_out, int out_size, void* d_ws, size_t ws_size, hipStream_t stream) {
    static int grid = 0;
    if (grid == 0) {
        if (n_in != 14 || out_size != M * D || ws_size < WS_END) { fprintf(stderr, "kernel_launch: unexpected shapes (n_in %d, out %d, ws %zu)\n", n_in, out_size, ws_size); grid = -1; return; }
        int dev = 0, cus = 0, per_cu = 0;
        (void)hipGetDevice(&dev); (void)hipDeviceGetAttribute(&cus, hipDeviceAttributeMultiprocessorCount, dev);
        if (hipFuncSetAttribute((const void*)fwd_megakernel, hipFuncAttributeMaxDynamicSharedMemorySize, LDS_BYTES) != hipSuccess) { fprintf(stderr, "kernel_launch: hipFuncSetAttribute failed\n"); grid = -1; return; }
        if (hipOccupancyMaxActiveBlocksPerMultiprocessor(&per_cu, (const void*)fwd_megakernel, NWAVES * 64, LDS_BYTES) != hipSuccess || per_cu < 1) { fprintf(stderr, "kernel_launch: occupancy query says %d blocks per CU\n", per_cu); per_cu = 1; }
        (void)hipGetLastError();
        grid = cus * (per_cu < 1 ? 1 : per_cu);
        if (grid > 256) grid = 256;
    }
    if (grid < 0) return;
    (void)hipMemsetAsync((char*)d_ws + WS_BAR, 0, BAR_ZERO_BYTES, stream);
    Args a{};
    for (int i = 0; i < 14; ++i) a.in[i] = (const float*)d_in[i];
    a.out = (float*)d_out; a.ws = (unsigned char*)d_ws;
#if MK_ONE_LAUNCH
    a.ph_lo = 0; a.ph_hi = N_PHASES;
    void* kargs[] = {&a};
    hipError_t e = hipLaunchCooperativeKernel((const void*)fwd_megakernel, dim3(grid), dim3(NWAVES * 64), kargs, LDS_BYTES, stream);
    if (e != hipSuccess) fprintf(stderr, "kernel_launch: cooperative launch failed: %s (grid %d)\n", hipGetErrorString(e), grid);
#else
    for (int p = 0; p < N_PHASES; ++p) { a.ph_lo = p; a.ph_hi = p + 1; hipLaunchKernelGGL(fwd_megakernel, dim3(grid), dim3(NWAVES * 64), LDS_BYTES, stream, a); }
#endif
}
```
